# Optimizing an MI355X kernel written in HIP

```python
import jax
import jax.numpy as jnp
from jax import lax
import numpy as np

D_MODEL = 1024
BATCH = 8
SEQ = 4096
DEPTH = 2

GRID_W = 64
CTX_LEN = 256
CHUNK = 64
GLA_HEADS = 4
GLA_DK = 64
GLA_DV = 128
GLA_GATE_RANK = 16
GLA_GATE_TAU = 16.0
ATT_Q_HEADS = 8
ATT_KV_HEADS = 2
ATT_HEAD_DIM = 64
ATT_GROUP = ATT_Q_HEADS // ATT_KV_HEADS
ROPE_AXIS_DIM = ATT_HEAD_DIM // 2
ROPE_THETA = 10000.0
Q_BLOCK = 128
HGRN_HEADS = 8
HGRN_DF = 128
HGRN_DV = D_MODEL // HGRN_HEADS
D_FF = ((8 * D_MODEL + 3 * 256 - 1) // (3 * 256)) * 256

EVEN_SIZES = (GLA_HEADS * GLA_DK, GLA_HEADS * GLA_DK, GLA_HEADS * GLA_DV, GLA_HEADS * GLA_DV, 2 * GLA_GATE_RANK,
              ATT_Q_HEADS * ATT_HEAD_DIM, ATT_KV_HEADS * ATT_HEAD_DIM, ATT_KV_HEADS * ATT_HEAD_DIM)
ODD_SIZES = (HGRN_HEADS * HGRN_DF,) * 3 + (HGRN_HEADS * HGRN_DV,) * 2
EVEN_MIX = GLA_HEADS * GLA_DV + ATT_Q_HEADS * ATT_HEAD_DIM
ODD_MIX = HGRN_HEADS * HGRN_DV

kernel_name = 'hybrid_gla_gqa_hgrn2_prefix_dit'


def _rms(x, gain, eps=1e-6):
    xf = x.astype(jnp.float32)
    y = xf * lax.rsqrt(jnp.mean(xf * xf, axis=-1, keepdims=True) + eps)
    return (y * gain.astype(jnp.float32)).astype(x.dtype)


def _modulate(h, shift, scale):
    return h * (1 + scale) + shift


def _split(a, sizes):
    return jnp.split(a, np.cumsum(sizes)[:-1].tolist(), axis=-1)


def _heads(a, n_heads):
    B, N, _ = a.shape
    return a.reshape(B, N, n_heads, -1).transpose(0, 2, 1, 3)


def _merge(a):
    B, H, N, d = a.shape
    return a.transpose(0, 2, 1, 3).reshape(B, N, H * d)


def _gated_readout(o, og, gain):
    return _merge(_rms(o, gain) * jax.nn.silu(og))


def _swiglu(h, w_gate, w_up, w_down):
    return (jax.nn.silu(h @ w_gate) * (h @ w_up)) @ w_down


def _chunk_gla(q, k, v, g, s0):
    B, H, T, K = q.shape
    V = v.shape[-1]
    n = T // CHUNK

    def blocks(a):
        return jnp.moveaxis(a.astype(jnp.float32).reshape(B, H, n, CHUNK, a.shape[-1]), 2, 0)

    tri = jnp.tril(jnp.ones((CHUNK, CHUNK), dtype=bool))[:, :, None]

    def step(s, blk):
        qc, kc, vc, gc = blk
        G = jnp.cumsum(gc, axis=2)
        decay = jnp.exp(jnp.where(tri, G[:, :, :, None, :] - G[:, :, None, :, :], -jnp.inf))
        scores = jnp.einsum('bhik,bhjk,bhijk->bhij', qc, kc, decay)
        o = jnp.einsum('bhij,bhjv->bhiv', scores, vc) + jnp.einsum('bhik,bhkv->bhiv', qc * jnp.exp(G), s)
        G_last = G[:, :, -1:, :]
        s = s * jnp.exp(G_last)[:, :, 0, :, None] + jnp.einsum('bhjk,bhjv->bhkv', kc * jnp.exp(G_last - G), vc)
        return s, o

    s, o = lax.scan(step, s0, (blocks(q), blocks(k), blocks(v), blocks(g)))
    return jnp.moveaxis(o, 0, 2).reshape(B, H, T, V).astype(v.dtype), s


def _directional_scan(q, k, v, g, n_ctx, reverse):
    def seg(a, sl):
        a = a[:, :, sl]
        return jnp.flip(a, 2) if reverse else a
    c_sl, t_sl = slice(0, n_ctx), slice(n_ctx, None)
    B, H, _, K = q.shape
    s0 = jnp.zeros((B, H, K, v.shape[-1]), jnp.float32)
    o_ctx, s_ctx = _chunk_gla(seg(q, c_sl), seg(k, c_sl), seg(v, c_sl), seg(g, c_sl), s0)
    o_lat, _ = _chunk_gla(seg(q, t_sl), seg(k, t_sl), seg(v, t_sl), seg(g, t_sl), s_ctx)
    if reverse:
        o_ctx, o_lat = jnp.flip(o_ctx, 2), jnp.flip(o_lat, 2)
    return o_ctx, o_lat


def _axial_rope_tables(n_tokens):
    rows_n = n_tokens // GRID_W
    row = jnp.repeat(jnp.arange(rows_n), GRID_W).astype(jnp.float32)
    col = jnp.tile(jnp.arange(GRID_W), rows_n).astype(jnp.float32)
    inv = ROPE_THETA ** (-jnp.arange(0, ROPE_AXIS_DIM, 2, dtype=jnp.float32) / ROPE_AXIS_DIM)
    ang = jnp.concatenate([row[:, None] * inv, col[:, None] * inv], axis=-1)
    return jnp.cos(ang), jnp.sin(ang)


def _rope(x, cos, sin):
    xf = x.astype(jnp.float32).reshape(x.shape[:-1] + (-1, 2))
    x0, x1 = xf[..., 0], xf[..., 1]
    out = jnp.stack([x0 * cos - x1 * sin, x0 * sin + x1 * cos], axis=-1)
    return out.reshape(x.shape).astype(x.dtype)


def _softmax_attend(q, k, v):
    s = jnp.einsum('bhgqd,bhkd->bhgqk', q, k, preferred_element_type=jnp.float32) * (ATT_HEAD_DIM ** -0.5)
    p = jax.nn.softmax(s, axis=-1).astype(v.dtype)
    return jnp.einsum('bhgqk,bhkd->bhgqd', p, v)


def _even_mixer(h_ctx, h_lat, w_in, gla_w_gate, gla_b_gate, gla_out_norm, att_q_norm, att_k_norm, cos, sin, ctx_out):
    B, n_ctx, _ = h_ctx.shape
    h = jnp.concatenate([h_ctx, h_lat], axis=1)
    N = h.shape[1]
    T = N - n_ctx
    gq, gk, gv, gog, gz, aq, ak, av = _split(h @ w_in, EVEN_SIZES)

    q = _heads(gq, GLA_HEADS) * (GLA_DK ** -0.5)
    k = _heads(gk, GLA_HEADS)
    v = _heads(gv, GLA_HEADS)
    og = _heads(gog, GLA_HEADS)
    dirs = []
    for d, z in enumerate(jnp.split(gz, 2, axis=-1)):
        logit = (z @ gla_w_gate[d] + gla_b_gate[d]).astype(jnp.float32)
        g = _heads(jax.nn.log_sigmoid(logit) / GLA_GATE_TAU, GLA_HEADS)
        dirs.append(_directional_scan(q, k, v, g, n_ctx, reverse=(d == 1)))
    a_lat = _gated_readout(dirs[0][1] + dirs[1][1], og[:, :, n_ctx:], gla_out_norm)

    qa = _rms(aq.reshape(B, N, ATT_KV_HEADS, ATT_GROUP, ATT_HEAD_DIM), att_q_norm).transpose(0, 2, 3, 1, 4)
    ka = _rms(ak.reshape(B, N, ATT_KV_HEADS, ATT_HEAD_DIM), att_k_norm).transpose(0, 2, 1, 3)
    va = av.reshape(B, N, ATT_KV_HEADS, ATT_HEAD_DIM).transpose(0, 2, 1, 3)
    q_lat = _rope(qa[:, :, :, n_ctx:], cos, sin)
    k_all = jnp.concatenate([ka[:, :, :n_ctx], _rope(ka[:, :, n_ctx:], cos, sin)], axis=2)
    q_blocks = jnp.moveaxis(q_lat.reshape(B, ATT_KV_HEADS, ATT_GROUP, T // Q_BLOCK, Q_BLOCK, ATT_HEAD_DIM), 3, 0)
    o_blocks = lax.map(lambda qb: _softmax_attend(qb, k_all, va), q_blocks)
    b_lat = jnp.moveaxis(o_blocks, 0, 3).reshape(B, ATT_KV_HEADS, ATT_GROUP, T, ATT_HEAD_DIM)
    b_lat = b_lat.transpose(0, 3, 1, 2, 4).reshape(B, T, ATT_Q_HEADS * ATT_HEAD_DIM)
    o_lat = jnp.concatenate([a_lat, b_lat], axis=-1)
    if not ctx_out:
        return None, o_lat
    a_ctx = _gated_readout(dirs[0][0] + dirs[1][0], og[:, :, :n_ctx], gla_out_norm)
    b_ctx = _softmax_attend(qa[:, :, :, :n_ctx], ka[:, :, :n_ctx], va[:, :, :n_ctx])
    b_ctx = b_ctx.transpose(0, 3, 1, 2, 4).reshape(B, n_ctx, ATT_Q_HEADS * ATT_HEAD_DIM)
    return jnp.concatenate([a_ctx, b_ctx], axis=-1), o_lat


def _odd_mixer(h_ctx, h_lat, w_in, lower_bounds, layer, out_norm, ctx_out):
    n_ctx = h_ctx.shape[1]
    h = jnp.concatenate([h_ctx, h_lat], axis=1)
    fq, f_fwd, f_bwd, fi, fog = _split(h @ w_in, ODD_SIZES)
    q = _heads(jax.nn.silu(fq), HGRN_HEADS)
    i = _heads(fi, HGRN_HEADS)
    og = _heads(fog, HGRN_HEADS)
    lbs = jnp.cumsum(jax.nn.softmax(lower_bounds.astype(jnp.float32), axis=1), axis=1)
    lb = (lbs[:, layer] - lbs[:, 0]).reshape(2, HGRN_HEADS, 1, HGRN_DF)
    dirs = []
    for d, f in enumerate((f_fwd, f_bwd)):
        log_f = jnp.logaddexp(jnp.log(lb[d]), jnp.log1p(-lb[d]) + jax.nn.log_sigmoid(_heads(f, HGRN_HEADS).astype(jnp.float32)))
        k = -jnp.expm1(log_f)
        dirs.append(_directional_scan(q, k, i, log_f, n_ctx, reverse=(d == 1)))
    o_lat = _gated_readout(dirs[0][1] + dirs[1][1], og[:, :, n_ctx:], out_norm)
    if not ctx_out:
        return None, o_lat
    return _gated_readout(dirs[0][0] + dirs[1][0], og[:, :, :n_ctx], out_norm), o_lat


def setup_inputs(seed: int = 0) -> dict:
    key = jax.random.key(seed)
    ks = iter(jax.random.split(key, 32))
    n_even, n_odd = (DEPTH + 1) // 2, DEPTH // 2
    D = D_MODEL

    def nrm(shape, scale):
        return scale * jax.random.normal(next(ks), shape, jnp.float32)

    def gain(shape):
        return 1.0 + nrm(shape, 0.02)

    return {
        'x': nrm((BATCH, SEQ, D), 1.0),
        'c': nrm((BATCH, D), 1.0),
        'ctx': nrm((BATCH, CTX_LEN, D), 1.0),
        'c_ctx': nrm((D,), 1.0),
        'mod_w': nrm((DEPTH, D, 6 * D), D ** -0.5),
        'mod_b': nrm((DEPTH, 6 * D), 0.02),
        'norm_pre_mix': gain((DEPTH, D)),
        'norm_post_mix': gain((DEPTH, D)),
        'norm_pre_ffn': gain((DEPTH, D)),
        'norm_post_ffn': gain((DEPTH, D)),
        'even_w_in': nrm((n_even, D, sum(EVEN_SIZES)), D ** -0.5),
        'gla_w_gate': nrm((n_even, 2, GLA_GATE_RANK, GLA_HEADS * GLA_DK), GLA_GATE_RANK ** -0.5),
        'gla_b_gate': nrm((n_even, 2, GLA_HEADS * GLA_DK), 0.02),
        'gla_out_norm': gain((n_even, GLA_DV)),
        'att_q_norm': gain((n_even, ATT_HEAD_DIM)),
        'att_k_norm': gain((n_even, ATT_HEAD_DIM)),
        'even_w_out': nrm((n_even, EVEN_MIX, D), EVEN_MIX ** -0.5),
        'odd_w_in': nrm((n_odd, D, sum(ODD_SIZES)), D ** -0.5),
        'hgrn_lower_bounds': nrm((2, DEPTH, HGRN_HEADS * HGRN_DF), 0.1),
        'hgrn_out_norm': gain((n_odd, HGRN_DV)),
        'odd_w_out': nrm((n_odd, ODD_MIX, D), ODD_MIX ** -0.5),
        'ffn_w_gate': nrm((DEPTH, D, D_FF), D ** -0.5),
        'ffn_w_up': nrm((DEPTH, D, D_FF), D ** -0.5),
        'ffn_w_down': nrm((DEPTH, D_FF, D), D_FF ** -0.5),
    }


def reference(x, c, ctx, c_ctx, mod_w, mod_b, norm_pre_mix, norm_post_mix, norm_pre_ffn, norm_post_ffn,
              even_w_in, gla_w_gate, gla_b_gate, gla_out_norm, att_q_norm, att_k_norm, even_w_out,
              odd_w_in, hgrn_lower_bounds, hgrn_out_norm, odd_w_out, ffn_w_gate, ffn_w_up, ffn_w_down):
    cos, sin = _axial_rope_tables(x.shape[1])
    sc = jax.nn.silu(c)
    scc = jax.nn.silu(c_ctx)
    x_ctx, x_lat = ctx, x
    for l in range(DEPTH):
        last = l == DEPTH - 1
        j = l // 2
        m_lat = jnp.split((sc @ mod_w[l] + mod_b[l])[:, None, :], 6, axis=-1)
        m_ctx = jnp.split((scc @ mod_w[l] + mod_b[l])[None, None, :], 6, axis=-1)
        h_ctx = _modulate(_rms(x_ctx, norm_pre_mix[l]), m_ctx[0], m_ctx[1])
        h_lat = _modulate(_rms(x_lat, norm_pre_mix[l]), m_lat[0], m_lat[1])
        if l % 2 == 0:
            o_ctx, o_lat = _even_mixer(h_ctx, h_lat, even_w_in[j], gla_w_gate[j], gla_b_gate[j], gla_out_norm[j],
                                       att_q_norm[j], att_k_norm[j], cos, sin, not last)
            w_out = even_w_out[j]
        else:
            o_ctx, o_lat = _odd_mixer(h_ctx, h_lat, odd_w_in[j], hgrn_lower_bounds, l, hgrn_out_norm[j], not last)
            w_out = odd_w_out[j]
        x_lat = x_lat + m_lat[2] * _rms(o_lat @ w_out, norm_post_mix[l])
        h_lat = _modulate(_rms(x_lat, norm_pre_ffn[l]), m_lat[3], m_lat[4])
        x_lat = x_lat + m_lat[5] * _rms(_swiglu(h_lat, ffn_w_gate[l], ffn_w_up[l], ffn_w_down[l]), norm_post_ffn[l])
        if not last:
            x_ctx = x_ctx + m_ctx[2] * _rms(o_ctx @ w_out, norm_post_mix[l])
            h_ctx = _modulate(_rms(x_ctx, norm_pre_ffn[l]), m_ctx[3], m_ctx[4])
            x_ctx = x_ctx + m_ctx[5] * _rms(_swiglu(h_ctx, ffn_w_gate[l], ffn_w_up[l], ffn_w_down[l]), norm_post_ffn[l])
    return x_lat
```

```cpp
#include <hip/hip_runtime.h>
#include <hip/hip_cooperative_groups.h>
#include <hip/hip_bf16.h>
#include <cstdio>
#include <cstdint>
#include <cmath>
namespace cg = cooperative_groups;
__device__ __forceinline__ int tid_fresh() { int t = threadIdx.x; asm volatile("" : "+v"(t)); return t; }
namespace pg8 {
#define PG8_LAS __attribute__((address_space(3)))
typedef unsigned short bf16_t;
typedef short bf16x8 __attribute__((ext_vector_type(8)));
typedef float f32x4 __attribute__((ext_vector_type(4)));
typedef unsigned u32x4 __attribute__((ext_vector_type(4)));
constexpr int BM = 256, BK = 64, HALF = 128, HTB = HALF * BK * 2  , STAGE_BYTES = 8 * HTB, NXCD = 8, WGM = 8;

__host__ __device__ __forceinline__ int lds_byte(int r, int c) { const int st = (r >> 4) * 2 + (c >> 5), rr = r & 15, cc = c & 31, ob = rr * 64 + cc * 2; return st * 1024 + (ob ^ (((ob >> 9) & 1) << 5)); }
__host__ __device__ __forceinline__ void stage_rc(int b, int& R, int& C) { const int st = b / 1024, sb = b % 1024, swz = sb ^ (((sb >> 9) & 1) << 5); R = (st >> 1) * 16 + swz / 64; C = (st & 1) * 32 + (swz % 64) / 2; }
__host__ __device__ __forceinline__ int perm32(int rho) { const int n = rho >> 4, i = rho & 15; return 8 * (i >> 2) + 4 * n + (i & 3); }

struct Unit { int pm, pn; };
struct Gemm { const bf16_t* A; const bf16_t* Bt; int M, N, K; };

struct StaticOrder {
    int nM, nN, nwg, G, c;
    __host__ __device__ void init(int M, int N, int G_, int c_) { nM = M / BM; nN = N / BM; nwg = nM * nN; G = G_; c = c_; }
    __host__ __device__ bool next(int i, Unit& u) const {
        const long L = (long)i * G + c; if (L >= nwg) return false;
        int wgid = (int)L; { const int q = nwg / NXCD, r = nwg % NXCD, xcd = wgid % NXCD, off = wgid / NXCD; wgid = (xcd < r ? xcd * (q + 1) : r * (q + 1) + (xcd - r) * q) + off; }
        const int nig = WGM * nN, gid = wgid / nig, fm = gid * WGM, gsz = (nM - fm) < WGM ? (nM - fm) : WGM;
        u.pm = fm + ((wgid % nig) % gsz); u.pn = (wgid % nig) / gsz; return true;
    }
    __device__ __forceinline__ void a_ready(const Unit&) const {}
    __device__ __forceinline__ void done(const Unit&) const {}
};

__device__ __forceinline__ unsigned cvt_pk_bf16(float lo, float hi) { unsigned r; asm volatile("v_cvt_pk_bf16_f32 %0, %1, %2" : "=v"(r) : "v"(lo), "v"(hi)); return r; }
typedef float f32x2 __attribute__((ext_vector_type(2)));
typedef float f32x2 __attribute__((ext_vector_type(2)));
struct EpiStore {
    static constexpr bool PERM = true, AFTER_DRAIN = false;
    bf16_t* O; int ldc; int mode; const float* lb;
    __device__ __forceinline__ void operator()(const f32x4 (&acc)[2][2][4][2], const Unit& u, int wr, int wc, int fr, int fq) const {
        const int row0 = u.pm * BM + wr * 64 + fr; const int col0 = u.pn * BM + wc * 32 + 8 * fq;
#pragma unroll
        for (int bj = 0; bj < 2; ++bj) {
            const int col = col0 + bj * HALF;
            int cls = 0; f32x4 l0 = (f32x4){0.f,0.f,0.f,0.f}, l1 = l0;
            if (mode == 1) { if (col < 1024) cls = 1; else if (col < 3072) { cls = 2; l0 = *(const f32x4*)(lb + col - 1024); l1 = *(const f32x4*)(lb + col - 1024 + 4); } }
#pragma unroll
            for (int ai = 0; ai < 2; ++ai)
#pragma unroll
                for (int m = 0; m < 4; ++m) {
                    f32x4 v0 = acc[ai][bj][m][0], v1 = acc[ai][bj][m][1];
                    if (cls == 1) {
#pragma unroll
                        for (int e = 0; e < 4; ++e) { v0[e] = v0[e] / (1.f + __expf(-v0[e])); v1[e] = v1[e] / (1.f + __expf(-v1[e])); }
                    } else if (cls == 2) {
#pragma unroll
                        for (int e = 0; e < 4; ++e) { const float s0 = 1.f / (1.f + __expf(-v0[e])), s1 = 1.f / (1.f + __expf(-v1[e]));
                            v0[e] = __logf(l0[e] + (1.f - l0[e]) * s0); v1[e] = __logf(l1[e] + (1.f - l1[e]) * s1); }
                    }
                    u32x4 w; w.x = cvt_pk_bf16(v0[0], v0[1]); w.y = cvt_pk_bf16(v0[2], v0[3]); w.z = cvt_pk_bf16(v1[0], v1[1]); w.w = cvt_pk_bf16(v1[2], v1[3]);
                    *(u32x4*)(O + (size_t)(row0 + ai * HALF + m * 16) * ldc + col) = w;
                }
        }
    }
};
struct EpiSwiGLU {
    static constexpr bool PERM = true, AFTER_DRAIN = false;
    bf16_t* O; int ldc;
    __device__ __forceinline__ void operator()(const f32x4 (&acc)[2][2][4][2], const Unit& u, int wr, int wc, int fr, int fq) const {
        const int row0 = u.pm * BM + wr * 64 + fr; const int col = u.pn * HALF + wc * 32 + 8 * fq;
#pragma unroll
        for (int ai = 0; ai < 2; ++ai)
#pragma unroll
            for (int m = 0; m < 4; ++m) {
                f32x4 g0 = acc[ai][0][m][0], g1 = acc[ai][0][m][1]; const f32x4 u0 = acc[ai][1][m][0], u1 = acc[ai][1][m][1];
#pragma unroll
                for (int e = 0; e < 4; ++e) { g0[e] = g0[e] / (1.f + __expf(-g0[e])) * u0[e]; g1[e] = g1[e] / (1.f + __expf(-g1[e])) * u1[e]; }
                u32x4 w; w.x = cvt_pk_bf16(g0[0], g0[1]); w.y = cvt_pk_bf16(g0[2], g0[3]); w.z = cvt_pk_bf16(g1[0], g1[1]); w.w = cvt_pk_bf16(g1[2], g1[3]);
                *(u32x4*)(O + (size_t)(row0 + ai * HALF + m * 16) * ldc + col) = w;
            }
    }
};
template <class Epi, class Sched, bool ALIGN_EPI = false, bool SP2 = false>
__device__ __forceinline__ void gemm_phase(PG8_LAS unsigned char* lds, const Gemm g, const Sched& S, const Epi& E) {
    const int tid = tid_fresh(), wid = __builtin_amdgcn_readfirstlane(tid >> 6), lane = tid & 63, wr = wid >> 2, wc = wid & 3, fr = lane & 15, fq = lane >> 4;
    const int K = g.K, nt = K / BK;
    unsigned voffA[2], voffB[2];
#pragma unroll
    for (int i = 0; i < 2; ++i) { int R, C; stage_rc(tid * 16 + i * 8192, R, C); const int Rb = Epi::PERM ? ((R & ~31) + perm32(R & 31)) : R;
        voffA[i] = (unsigned)(R * K + C) * 2u; voffB[i] = (unsigned)(Rb * K + C) * 2u; }
    const size_t kstep = (size_t)(BK * 2);
    const size_t hstep = (size_t)HALF * K * 2;
    const size_t tstep = 2 * hstep;
    const unsigned ldsw = (unsigned)wid * 1024u;
    const int aoff = lds_byte(wr * 64 + fr, fq * 8), boff = lds_byte(wc * 32 + fr, fq * 8);
#define PG8_SA(b, h) (((b) * 2 + (h)) * HTB)
#define PG8_SB(b, h) ((4 + (b) * 2 + (h)) * HTB)
#define PG8_STAGE(bufoff, gbase, voff) do { _Pragma("unroll") for (int _i = 0; _i < 2; ++_i) \
        __builtin_amdgcn_global_load_lds((const unsigned*)((const char*)(gbase) + (voff)[_i]), (PG8_LAS unsigned*)(lds + (bufoff) + ldsw + _i * 8192), 16, 0, 0); } while (0)
#define PG8_LDA(dst, b, h) do { _Pragma("unroll") for (int m = 0; m < 4; ++m) _Pragma("unroll") for (int k = 0; k < 2; ++k) dst[m][k] = *(const PG8_LAS bf16x8*)(lds + PG8_SA(b, h) + aoff + m * 2048 + k * 1024); } while (0)
#define PG8_LDB(dst, b, h) do { _Pragma("unroll") for (int n = 0; n < 2; ++n) _Pragma("unroll") for (int k = 0; k < 2; ++k) dst[n][k] = *(const PG8_LAS bf16x8*)(lds + PG8_SB(b, h) + boff + n * 2048 + k * 1024); } while (0)
#define PG8_MMA(ai, bj, At, Bt) do { __builtin_amdgcn_s_setprio(1); _Pragma("unroll") for (int m = 0; m < 4; ++m) _Pragma("unroll") for (int n = 0; n < 2; ++n) _Pragma("unroll") for (int k = 0; k < 2; ++k) \
        acc[ai][bj][m][n] = __builtin_amdgcn_mfma_f32_16x16x32_bf16(Bt[n][k], At[m][k], acc[ai][bj][m][n], 0, 0, 0); __builtin_amdgcn_s_setprio(0); } while (0)
#define PG8_WAIT_V(n) asm volatile("s_waitcnt vmcnt(" #n ")" ::: "memory")
#define PG8_WAIT_L(n) asm volatile("s_waitcnt lgkmcnt(" #n ")" ::: "memory")
#define PG8_BAR __builtin_amdgcn_s_barrier()
#define PG8_SCHED __builtin_amdgcn_sched_barrier(0)
    Unit cur, nxt; int ui = 0;
    if (!S.next(0, cur)) return;
    f32x4 acc[2][2][4][2];
#pragma unroll
    for (int a = 0; a < 2; ++a)
#pragma unroll
        for (int b = 0; b < 2; ++b)
#pragma unroll
            for (int m = 0; m < 4; ++m)
#pragma unroll
                for (int n = 0; n < 2; ++n) acc[a][b][m][n] = (f32x4){0.f, 0.f, 0.f, 0.f};
    bf16x8 At[4][2], B0[2][2], B1[2][2];
    const char* cA = (const char*)g.A + (size_t)cur.pm * tstep; const char* cB = (const char*)g.Bt + (size_t)cur.pn * tstep;
    S.a_ready(cur);
    if constexpr (SP2) {
        PG8_STAGE(PG8_SB(0, 0), cB, voffB); PG8_STAGE(PG8_SB(0, 1), cB + hstep, voffB); PG8_STAGE(PG8_SA(0, 0), cA, voffA); PG8_STAGE(PG8_SA(0, 1), cA + hstep, voffA);
        if (wr == 1) PG8_BAR;
        PG8_WAIT_V(2); PG8_BAR;
        PG8_STAGE(PG8_SB(1, 0), cB + kstep, voffB); PG8_STAGE(PG8_SA(1, 0), cA + kstep, voffA); PG8_STAGE(PG8_SB(1, 1), cB + hstep + kstep, voffB);
        PG8_WAIT_V(6); PG8_BAR;
    } else {
        PG8_STAGE(PG8_SB(0, 0), cB, voffB); PG8_STAGE(PG8_SA(0, 0), cA, voffA); PG8_STAGE(PG8_SB(0, 1), cB + hstep, voffB); PG8_STAGE(PG8_SA(0, 1), cA + hstep, voffA);
        if (wr == 1) PG8_BAR;
        PG8_WAIT_V(4); PG8_BAR;
        PG8_STAGE(PG8_SB(1, 0), cB + kstep, voffB); PG8_STAGE(PG8_SA(1, 0), cA + kstep, voffA); PG8_STAGE(PG8_SB(1, 1), cB + hstep + kstep, voffB);
        PG8_WAIT_V(6); PG8_BAR;
    }
    for (;;) {
        const bool has_next = S.next(ui + 1, nxt);
        const char* nA = has_next ? (const char*)g.A + (size_t)nxt.pm * tstep : cA; const char* nB = has_next ? (const char*)g.Bt + (size_t)nxt.pn * tstep : cB;
        for (int t = 0; t < nt; t += 2) {
            const bool last = (t == nt - 2);
            const char* a1 = cA + (size_t)(t + 1) * kstep;
            const char* a2 = last ? nA : cA + (size_t)(t + 2) * kstep; const char* b2 = last ? nB : cB + (size_t)(t + 2) * kstep;
            const char* a3 = a2 + kstep; const char* b3 = b2 + kstep;
            if (last && has_next) S.a_ready(nxt);
            if constexpr (SP2) {
            PG8_LDB(B0, 0, 0); PG8_LDB(B1, 0, 1); PG8_SCHED; PG8_LDA(At, 0, 0); PG8_STAGE(PG8_SA(1, 1), a1 + hstep, voffA);
            PG8_WAIT_V(8); PG8_WAIT_L(0); PG8_BAR; PG8_MMA(0, 0, At, B0); PG8_MMA(0, 1, At, B1); PG8_BAR; PG8_SCHED;
            PG8_LDA(At, 0, 1); PG8_STAGE(PG8_SB(0, 0), b2, voffB); PG8_STAGE(PG8_SB(0, 1), b2 + hstep, voffB); PG8_STAGE(PG8_SA(0, 0), a2, voffA);
            PG8_WAIT_V(8); PG8_WAIT_L(0); PG8_BAR; PG8_MMA(1, 0, At, B0); PG8_MMA(1, 1, At, B1); PG8_BAR; PG8_SCHED;
            PG8_LDB(B0, 1, 0); PG8_LDB(B1, 1, 1); PG8_SCHED; PG8_LDA(At, 1, 0); PG8_STAGE(PG8_SA(0, 1), a2 + hstep, voffA);
            PG8_WAIT_V(8); PG8_WAIT_L(0); PG8_BAR; PG8_MMA(0, 0, At, B0); PG8_MMA(0, 1, At, B1); PG8_BAR; PG8_SCHED;
            PG8_LDA(At, 1, 1); PG8_STAGE(PG8_SB(1, 0), b3, voffB); PG8_STAGE(PG8_SB(1, 1), b3 + hstep, voffB); PG8_STAGE(PG8_SA(1, 0), a3, voffA);
            PG8_WAIT_V(8); PG8_WAIT_L(0); PG8_BAR; PG8_MMA(1, 0, At, B0); PG8_MMA(1, 1, At, B1); PG8_BAR; PG8_SCHED;
            } else {
            PG8_LDB(B0, 0, 0); PG8_SCHED; PG8_LDA(At, 0, 0); PG8_STAGE(PG8_SA(1, 1), a1 + hstep, voffA);
            PG8_WAIT_L(8); PG8_BAR; PG8_WAIT_L(0); PG8_MMA(0, 0, At, B0); PG8_BAR; PG8_SCHED;
            PG8_LDB(B1, 0, 1); PG8_STAGE(PG8_SB(0, 0), b2, voffB);
            PG8_BAR; PG8_WAIT_L(0); PG8_MMA(0, 1, At, B1); PG8_BAR;
            PG8_LDA(At, 0, 1); PG8_STAGE(PG8_SA(0, 0), a2, voffA);
            PG8_BAR; PG8_WAIT_L(0); PG8_MMA(1, 0, At, B0); PG8_BAR; PG8_SCHED;
            PG8_STAGE(PG8_SB(0, 1), b2 + hstep, voffB);
            PG8_WAIT_V(6); PG8_BAR; PG8_MMA(1, 1, At, B1); PG8_BAR;
            PG8_LDB(B0, 1, 0); PG8_SCHED; PG8_LDA(At, 1, 0); PG8_STAGE(PG8_SA(0, 1), a2 + hstep, voffA);
            PG8_WAIT_L(8); PG8_BAR; PG8_WAIT_L(0); PG8_MMA(0, 0, At, B0); PG8_BAR; PG8_SCHED;
            PG8_LDB(B1, 1, 1); PG8_STAGE(PG8_SB(1, 0), b3, voffB);
            PG8_BAR; PG8_WAIT_L(0); PG8_MMA(0, 1, At, B1); PG8_BAR;
            PG8_LDA(At, 1, 1); PG8_STAGE(PG8_SA(1, 0), a3, voffA);
            PG8_BAR; PG8_WAIT_L(0); PG8_MMA(1, 0, At, B0); PG8_BAR; PG8_SCHED;
            PG8_STAGE(PG8_SB(1, 1), b3 + hstep, voffB);
            PG8_WAIT_V(6); PG8_BAR; PG8_MMA(1, 1, At, B1); PG8_BAR;
            }
        }
        if constexpr (ALIGN_EPI) { if (wr == 0) PG8_BAR; }
        if constexpr (!Epi::AFTER_DRAIN) { E(acc, cur, wr, wc, fr, fq); S.done(cur); }
        if (!has_next) break;
#pragma unroll
        for (int a = 0; a < 2; ++a)
#pragma unroll
            for (int b = 0; b < 2; ++b)
#pragma unroll
                for (int m = 0; m < 4; ++m)
#pragma unroll
                    for (int n = 0; n < 2; ++n) acc[a][b][m][n] = (f32x4){0.f, 0.f, 0.f, 0.f};
        cur = nxt; cA = nA; cB = nB; ++ui;
        if constexpr (ALIGN_EPI) { if (wr == 1) PG8_BAR; }
    }
    PG8_WAIT_V(0);
    if constexpr (!ALIGN_EPI) { if (wr == 0) PG8_BAR; }
    PG8_BAR;
    if constexpr (Epi::AFTER_DRAIN) { E.fused(acc, cur, wr, wc, fr, fq, lds, wid, lane); S.done(cur); }
#undef PG8_SA
#undef PG8_SB
#undef PG8_STAGE
#undef PG8_LDA
#undef PG8_LDB
#undef PG8_MMA
#undef PG8_WAIT_V
#undef PG8_WAIT_L
#undef PG8_BAR
#undef PG8_SCHED
}
}
#include <hip/hip_bf16.h>
#include <cmath>
namespace attn_body {
using bf16=__hip_bfloat16;
using bf16x8=__attribute__((ext_vector_type(8)))short;
using s16x4=__attribute__((ext_vector_type(4)))short;
using f32x16=__attribute__((ext_vector_type(16)))float;
using u32x4=__attribute__((ext_vector_type(4)))unsigned;
constexpr int D=64;
constexpr int NW=8,QBLK=32,QB=QBLK*NW,KVBLK=64;
__device__ __forceinline__ int crow(int r,int hi){return (r&3)+8*(r>>2)+4*hi;}
#define SBAR() __builtin_amdgcn_sched_barrier(0)
__device__ __forceinline__ void cmask(f32x16&p0,f32x16&p1,int jb,int qrel,int hi){
  const float NEG=-INFINITY; int kb=64*jb+4*hi;
  #pragma unroll
  for(int r=0;r<16;++r){int kv=kb+(r&3)+8*(r>>2); if(kv>qrel)p0[r]=NEG; if(kv+32>qrel)p1[r]=NEG;}
}

constexpr int NSLOT=3, SLOTB=8192;
constexpr int LDS_K=0, LDS_V=NSLOT*SLOTB, LDS_WS=2*NSLOT*SLOTB, LDS_OST=LDS_WS+NW*64*4, LDS_BYTES=LDS_OST+NW*4096;
constexpr float C2=0.125f*1.4426950408889634f;
__device__ __forceinline__ void glds16(const void*gsrc,unsigned lds_dst){unsigned keep;
  asm volatile("s_mov_b32 %0, m0\n\ts_mov_b32 m0, %2\n\ts_nop 0\n\tglobal_load_lds_dwordx4 %1, off\n\ts_mov_b32 m0, %0":"=&s"(keep):"v"(gsrc),"s"(lds_dst):"memory");}
__device__ __forceinline__ float max3f(float a,float b,float c){float r;asm("v_max3_f32 %0, %1, %2, %3":"=v"(r):"v"(a),"v"(b),"v"(c));return r;}
__device__ __forceinline__ float max2f(float a,float b){float r;asm("v_max_f32_e32 %0, %1, %2":"=v"(r):"v"(a),"v"(b));return r;}
__device__ __forceinline__ float fadd_s(float a,float b){float r;asm("v_add_f32_e32 %0, %1, %2":"=v"(r):"v"(a),"v"(b));return r;}
__device__ __forceinline__ float fsub_s(float a,float b){float r;asm("v_sub_f32_e32 %0, %1, %2":"=v"(r):"v"(a),"v"(b));return r;}
typedef float f32x2_t __attribute__((ext_vector_type(2))); typedef __bf16 bf16x2_t __attribute__((ext_vector_type(2)));
__device__ __forceinline__ unsigned cvtpk_s(float lo,float hi){f32x2_t v={lo,hi};bf16x2_t b=__builtin_convertvector(v,bf16x2_t);return __builtin_bit_cast(unsigned,b);}
#define WAIT_BAR(N) asm volatile("s_waitcnt vmcnt(" #N ") lgkmcnt(0)\n\ts_barrier":::"memory")

__device__ __forceinline__ void qkt(f32x16&p0,f32x16&p1,const char*Kslot,const bf16x8*qr,const f32x16&negm,int r32,int hi){
  const char*kb=Kslot+hi*1024+r32*16;
  #pragma unroll
  for(int d0=0;d0<4;++d0){
    const bf16x8 b0=*reinterpret_cast<const bf16x8*>(kb+d0*2048);
    const bf16x8 b1=*reinterpret_cast<const bf16x8*>(kb+d0*2048+512);
    if(d0==0){p0=__builtin_amdgcn_mfma_f32_32x32x16_bf16(b0,qr[0],negm,0,0,0);p1=__builtin_amdgcn_mfma_f32_32x32x16_bf16(b1,qr[0],negm,0,0,0);}
    else{p0=__builtin_amdgcn_mfma_f32_32x32x16_bf16(b0,qr[d0],p0,0,0,0);p1=__builtin_amdgcn_mfma_f32_32x32x16_bf16(b1,qr[d0],p1,0,0,0);}}
}
typedef __attribute__((address_space(3))) const char* lds_cptr;
typedef short v4i16_t __attribute__((ext_vector_type(4)));
__device__ __forceinline__ void kload8(bf16x8*kf,lds_cptr kp){
  kf[0]=*(const __attribute__((address_space(3))) bf16x8*)(kp);      kf[1]=*(const __attribute__((address_space(3))) bf16x8*)(kp+512);
  kf[2]=*(const __attribute__((address_space(3))) bf16x8*)(kp+2048); kf[3]=*(const __attribute__((address_space(3))) bf16x8*)(kp+2560);
  kf[4]=*(const __attribute__((address_space(3))) bf16x8*)(kp+4096); kf[5]=*(const __attribute__((address_space(3))) bf16x8*)(kp+4608);
  kf[6]=*(const __attribute__((address_space(3))) bf16x8*)(kp+6144); kf[7]=*(const __attribute__((address_space(3))) bf16x8*)(kp+6656);
}
__device__ __forceinline__ void kload2(bf16x8*kf,lds_cptr kp,int j){ kf[2*j]=*(const __attribute__((address_space(3))) bf16x8*)(kp+j*2048); kf[2*j+1]=*(const __attribute__((address_space(3))) bf16x8*)(kp+j*2048+512); }
__device__ __forceinline__ s16x4 vtr(lds_cptr p){ return __builtin_bit_cast(s16x4,__builtin_amdgcn_ds_read_tr16_b64_v4i16((__attribute__((address_space(3))) v4i16_t*)p)); }
__device__ __forceinline__ float rowmax(const f32x16&p0,const f32x16&p1){
  float a=max3f(p0[0],p0[1],p1[0]),b=max3f(p0[2],p0[3],p1[1]);a=max3f(a,p1[2],p1[3]);
  #pragma unroll
  for(int r=4;r<16;r+=4){a=max3f(a,p0[r],p0[r+1]);b=max3f(b,p0[r+2],p0[r+3]);a=max3f(a,p1[r],p1[r+1]);b=max3f(b,p1[r+2],p1[r+3]);}
  const float m=max2f(a,b);
  auto rr=__builtin_amdgcn_permlane32_swap(__float_as_uint(m),__float_as_uint(m),false,false);
  return max2f(__uint_as_float(rr[0]),__uint_as_float(rr[1]));
}
__device__ __forceinline__ void pv(f32x16*o,int vb,bf16x8 pa0,bf16x8 pa1,bf16x8 pa2,bf16x8 pa3){
  #pragma unroll
  for(int d0=0;d0<2;++d0){s16x4 lo[4],hi[4];
    #pragma unroll
    for(int ks=0;ks<4;++ks){
      asm volatile("ds_read_b64_tr_b16 %0,%1 offset:%c2":"=&v"(lo[ks]):"v"(vb),"i"(d0*4096+ks*1024):"memory");
      asm volatile("ds_read_b64_tr_b16 %0,%1 offset:%c2":"=&v"(hi[ks]):"v"(vb),"i"(d0*4096+ks*1024+512):"memory");}
    asm volatile("s_waitcnt lgkmcnt(0)":::"memory");SBAR();
    #define PK(k) (bf16x8){lo[k][0],lo[k][1],lo[k][2],lo[k][3],hi[k][0],hi[k][1],hi[k][2],hi[k][3]}
    o[d0]=__builtin_amdgcn_mfma_f32_32x32x16_bf16(pa0,PK(0),o[d0],0,0,0);
    o[d0]=__builtin_amdgcn_mfma_f32_32x32x16_bf16(pa1,PK(1),o[d0],0,0,0);
    o[d0]=__builtin_amdgcn_mfma_f32_32x32x16_bf16(pa2,PK(2),o[d0],0,0,0);
    o[d0]=__builtin_amdgcn_mfma_f32_32x32x16_bf16(pa3,PK(3),o[d0],0,0,0);
    #undef PK
  }
}

#ifndef ATTN_STORE16
#define ATTN_STORE16(p,v) (*(u32x4*)(p)=(v))
#endif
template<int THRL> __device__ __forceinline__ void attn_unit(const int b,const int NT,const bf16*Qw0,const int qpitch,const bf16*__restrict__ Kh,const bf16*__restrict__ Vh,const int kvpitch,bf16*Ow0,const int opitch,char*shm){
  const int tid=tid_fresh(),lane=tid&63,r32=lane&31,hi=lane>>5; const int wid=__builtin_amdgcn_readfirstlane(tid>>6);
  const bf16*Qw=Qw0+(long)(wid*QBLK)*qpitch;
  const unsigned lds0=(unsigned)(uintptr_t)shm;
  float*wsf=(float*)(shm+LDS_WS)+wid*64;
  const bf16*ksrc=Kh+(long)lane*kvpitch+wid*8;
  const bf16*vsrc=Vh+(long)(16*(wid&3)+(lane>>2))*kvpitch+(wid>>2)*32+(lane&3)*8;
  const unsigned kdst=lds0+LDS_K+wid*1024, vdst=lds0+LDS_V+wid*1024;
  #define KROW(t) ((long)((t)<4 ? b*256+64*(t) : 2048+b*4096+64*((t)-4)))
  #define DMA_K(t,slot) glds16(ksrc+KROW(t)*kvpitch,(unsigned)__builtin_amdgcn_readfirstlane(kdst+(slot)))
  #define DMA_V(t,slot) glds16(vsrc+KROW(t)*kvpitch,(unsigned)__builtin_amdgcn_readfirstlane(vdst+(slot)))
  const int vb0=(int)(lds0+LDS_V)+((lane>>4)&1)*32+(lane&3)*8+(4*hi+((lane&15)>>2))*64;
  const char*Kbase=shm+LDS_K; bf16x8 kf[8];
  const lds_cptr shm3=(lds_cptr)shm; const lds_cptr kp0=shm3+LDS_K+hi*1024+r32*16; const lds_cptr vp0=shm3+LDS_V+((lane>>4)&1)*32+(lane&3)*8+(4*hi+((lane&15)>>2))*64;
  DMA_K(0,0);DMA_V(0,0);DMA_K(1,SLOTB);
  bf16x8 qr[4];
  #pragma unroll
  for(int d0=0;d0<4;++d0)qr[d0]=*reinterpret_cast<const bf16x8*>(&Qw[(long)r32*qpitch+d0*16+hi*8]);
  float mhat=0.f,l_reg=0.f;f32x16 o[2];o[0]=f32x16{};o[1]=f32x16{};f32x16 negm=f32x16{};asm volatile("":"+v"(negm));
  #define CMASK(P0,P1,t) do{}while(0)
  bool resc=false;
  #define START(P0,P1) do{ const float rm=rowmax(P0,P1); resc=false; \
    { const float dl=rm; mhat=fadd_s(mhat,dl); \
      _Pragma("unroll") for(int r=0;r<16;++r){P0[r]=fsub_s(P0[r],dl);P1[r]=fsub_s(P1[r],dl);} \
      _Pragma("unroll") for(int r=0;r<16;++r)negm[r]=-mhat; asm volatile("":"+v"(negm)); } \
    _Pragma("unroll") for(int r=0;r<16;++r)P0[r]=__builtin_amdgcn_exp2f(P0[r]); }while(0)
  #define RESC() do{ if(resc){ asm volatile("s_waitcnt lgkmcnt(0)":::"memory"); \
      _Pragma("unroll") for(int d_=0;d_<2;++d_) _Pragma("unroll") for(int r=0;r<16;++r)o[d_][r]*=wsf[crow(r,hi)]; } }while(0)
  f32x16 pA0,pA1,pB0,pB1;
  int sl_prev=0,sl_cur=0,sl_next=SLOTB;
  #define ROT() do{sl_prev=sl_cur;sl_cur=sl_next;sl_next=(sl_next==(NSLOT-1)*SLOTB)?0:sl_next+SLOTB;}while(0)
  DMA_K(2,2*SLOTB);
  WAIT_BAR(3);
  qkt(pA0,pA1,Kbase,qr,negm,r32,hi);asm volatile("s_nop 15\n\ts_nop 7":"+v"(pA0),"+v"(pA1));CMASK(pA0,pA1,0);
  START(pA0,pA1);
  _Pragma("unroll") for(int r=0;r<16;++r)pA1[r]=__builtin_amdgcn_exp2f(pA1[r]);
  WAIT_BAR(0);
  DMA_K(3,0);DMA_V(1,SLOTB);
  ROT();
  kload8(kf,kp0+sl_cur);
  WAIT_BAR(2);
  s16x4 vlo[8],vhi[8]; u32x4 pw0,pw1,pw2,pw3;
  #define PKW(P,B) cvtpk_s(P[B],P[B+1])
  #define PAF(k) __builtin_bit_cast(bf16x8,pw##k)
  #define VFR(i) (bf16x8){vlo[i][0],vlo[i][1],vlo[i][2],vlo[i][3],vhi[i][0],vhi[i][1],vhi[i][2],vhi[i][3]}
  #define PIN(x) asm volatile("":"+v"(x))
  #define MX3(a,b,c) __builtin_fmaxf(__builtin_fmaxf((a),(b)),(c))
  #define GAPA(MF,A0,A1,A2,A3,W0,W1,PW) do{ MF; sacc+=A0; sacc+=A1; sacc+=A2; sacc+=A3; PIN(sacc); W0; W1; PIN(PW); SBAR(); }while(0)
  #define EX(v) __builtin_amdgcn_exp2f(v)
  #define GAPB(MF,X,B) do{ MF; X[B]=EX(X[B]); X[B+1]=EX(X[B+1]); X[B+2]=EX(X[B+2]); X[B+3]=EX(X[B+3]); PIN(X); SBAR(); }while(0)
  #define VRD(i) do{ vlo[i]=vtr(vp_+(((i)>>2)*4096+((i)&3)*1024)); vhi[i]=vtr(vp_+(((i)>>2)*4096+((i)&3)*1024+512)); }while(0)
  #define KRD(G,j) do{ if(G){ kload2(kf,kp0+sl_next,j); SBAR(); } }while(0)
  #define STEP(C0,C1,P0,P1,t,GK,GV,GL) do{ SBAR(); \
    const lds_cptr vp_=vp0+sl_prev; \
    VRD(0); SBAR(); float sacc=(P0[0]+P0[1]); \
    GAPA(C0=__builtin_amdgcn_mfma_f32_32x32x16_bf16(kf[0],qr[0],negm,0,0,0), P0[2],P0[3],P0[4],P0[5],     pw0[0]=PKW(P0,0), pw0[1]=PKW(P0,2), pw0); \
    VRD(4); SBAR(); GAPA(C1=__builtin_amdgcn_mfma_f32_32x32x16_bf16(kf[1],qr[0],negm,0,0,0), P0[6],P0[7],P0[8],P0[9],     pw0[2]=PKW(P0,4), pw0[3]=PKW(P0,6), pw0); \
    VRD(1); SBAR(); GAPA(C0=__builtin_amdgcn_mfma_f32_32x32x16_bf16(kf[2],qr[1],C0,0,0,0),   P0[10],P0[11],P0[12],P0[13], pw1[0]=PKW(P0,8), pw1[1]=PKW(P0,10), pw1); \
    VRD(5); SBAR(); GAPA(C1=__builtin_amdgcn_mfma_f32_32x32x16_bf16(kf[3],qr[1],C1,0,0,0),   P0[14],P0[15],P1[0],P1[1],   pw1[2]=PKW(P0,12),pw1[3]=PKW(P0,14), pw1); \
    VRD(2); SBAR(); GAPA(C0=__builtin_amdgcn_mfma_f32_32x32x16_bf16(kf[4],qr[2],C0,0,0,0),   P1[2],P1[3],P1[4],P1[5],     pw2[0]=PKW(P1,0), pw2[1]=PKW(P1,2), pw2); \
    VRD(6); SBAR(); GAPA(C1=__builtin_amdgcn_mfma_f32_32x32x16_bf16(kf[5],qr[2],C1,0,0,0),   P1[6],P1[7],P1[8],P1[9],     pw2[2]=PKW(P1,4), pw2[3]=PKW(P1,6), pw2); \
    VRD(3); SBAR(); GAPA(C0=__builtin_amdgcn_mfma_f32_32x32x16_bf16(kf[6],qr[3],C0,0,0,0),   P1[10],P1[11],P1[12],P1[13], pw3[0]=PKW(P1,8), pw3[1]=PKW(P1,10), pw3); \
    VRD(7); SBAR(); GAPA(C1=__builtin_amdgcn_mfma_f32_32x32x16_bf16(kf[7],qr[3],C1,0,0,0),   P1[14],P1[15],0.f,0.f,       pw3[2]=PKW(P1,12),pw3[3]=PKW(P1,14), pw3); \
    l_reg+=sacc; \
    if(GK){DMA_K((t)+3,sl_cur);} if(GV){DMA_V((t)+1,sl_next);} \
    CMASK(C0,C1,t); \
    { float a=MX3(C0[0],C0[1],C1[0]),b=MX3(C0[2],C0[3],C1[1]); a=MX3(a,C1[2],C1[3]); \
      _Pragma("unroll") for(int r=4;r<16;r+=4){a=MX3(a,C0[r],C0[r+1]);b=MX3(b,C0[r+2],C0[r+3]);a=MX3(a,C1[r],C1[r+1]);b=MX3(b,C1[r+2],C1[r+3]);} \
      float rm=__builtin_fmaxf(a,b); { auto rr=__builtin_amdgcn_permlane32_swap(__float_as_uint(rm),__float_as_uint(rm),false,false); rm=__builtin_fmaxf(__uint_as_float(rr[0]),__uint_as_float(rr[1])); } \
      resc=false; \
      if(__builtin_expect(__any(rm>(float)THRL),0)){ const float dl=__builtin_fmaxf(rm,0.f); mhat+=dl; \
        _Pragma("unroll") for(int r=0;r<16;++r){C0[r]-=dl;C1[r]-=dl;} \
        _Pragma("unroll") for(int r=0;r<16;++r)negm[r]=-mhat; asm volatile("":"+v"(negm)); \
        const float f=__builtin_amdgcn_exp2f(-dl); l_reg*=f; if(hi==0)wsf[r32]=f; resc=true; } } \
    SBAR(); \
    GAPB(o[0]=__builtin_amdgcn_mfma_f32_32x32x16_bf16(PAF(0),VFR(0),o[0],0,0,0), C0,0); \
    GAPB(o[1]=__builtin_amdgcn_mfma_f32_32x32x16_bf16(PAF(0),VFR(4),o[1],0,0,0), C0,4); \
    KRD(GL,0); GAPB(o[0]=__builtin_amdgcn_mfma_f32_32x32x16_bf16(PAF(1),VFR(1),o[0],0,0,0), C0,8); \
    KRD(GL,1); GAPB(o[1]=__builtin_amdgcn_mfma_f32_32x32x16_bf16(PAF(1),VFR(5),o[1],0,0,0), C0,12); \
    KRD(GL,2); GAPB(o[0]=__builtin_amdgcn_mfma_f32_32x32x16_bf16(PAF(2),VFR(2),o[0],0,0,0), C1,0); \
    KRD(GL,3); GAPB(o[1]=__builtin_amdgcn_mfma_f32_32x32x16_bf16(PAF(2),VFR(6),o[1],0,0,0), C1,4); \
    GAPB(o[0]=__builtin_amdgcn_mfma_f32_32x32x16_bf16(PAF(3),VFR(3),o[0],0,0,0), C1,8); \
    GAPB(o[1]=__builtin_amdgcn_mfma_f32_32x32x16_bf16(PAF(3),VFR(7),o[1],0,0,0), C1,12); \
    }while(0)
  int t=1;
  #undef CMASK
  #define CMASK(P0,P1,t) do{}while(0)
  for(;t+5<NT;t+=2){
    STEP(pB0,pB1,pA0,pA1,t,true,true,true);     WAIT_BAR(2); RESC(); ROT();
    STEP(pA0,pA1,pB0,pB1,t+1,true,true,true);   WAIT_BAR(2); RESC(); ROT();
  }
  #undef CMASK
  #define CMASK(P0,P1,t) do{}while(0)
  #define ENDW(tt) do{ if((tt)+3<NT){WAIT_BAR(2);} else if((tt)+2<NT){WAIT_BAR(1);} else {WAIT_BAR(0);} }while(0)
  for(;t+1<NT;t+=2){
    STEP(pB0,pB1,pA0,pA1,t,(t+3<NT),(t+1<NT),(t+1<NT));       ENDW(t);   RESC(); ROT();
    STEP(pA0,pA1,pB0,pB1,t+1,(t+4<NT),(t+2<NT),(t+2<NT));     ENDW(t+1); RESC(); ROT();
  }
  STEP(pB0,pB1,pA0,pA1,NT-1,false,false,false); RESC();
  { float sacc=pB0[0]+pB0[1]; _Pragma("unroll") for(int r=2;r<16;++r)sacc+=pB0[r]; _Pragma("unroll") for(int r=0;r<16;++r)sacc+=pB1[r]; l_reg+=sacc;
    pw0=(u32x4){PKW(pB0,0),PKW(pB0,2),PKW(pB0,4),PKW(pB0,6)};pw1=(u32x4){PKW(pB0,8),PKW(pB0,10),PKW(pB0,12),PKW(pB0,14)};pw2=(u32x4){PKW(pB1,0),PKW(pB1,2),PKW(pB1,4),PKW(pB1,6)};pw3=(u32x4){PKW(pB1,8),PKW(pB1,10),PKW(pB1,12),PKW(pB1,14)};
    SBAR(); pv(o,vb0+sl_cur,PAF(0),PAF(1),PAF(2),PAF(3)); }
  #undef PKW
  #undef PAF
  #undef VFR
  #undef PIN
  #undef MX3
  #undef GAPA
  #undef GAPB
  #undef EX
  #undef VRD
  #undef KRD
  #undef STEP
  #undef ENDW
  {auto rr=__builtin_amdgcn_permlane32_swap(__float_as_uint(l_reg),__float_as_uint(l_reg),false,false);l_reg=__uint_as_float(rr[0])+__uint_as_float(rr[1]);}
  if(hi==0)wsf[32+r32]=l_reg;asm volatile("s_waitcnt lgkmcnt(0)":::"memory");
  float rli[16];
  #pragma unroll
  for(int r=0;r<16;++r)rli[r]=__builtin_amdgcn_rcpf(wsf[32+crow(r,hi)]);
  bf16*Ow=Ow0+(long)(wid*QBLK)*opitch;
  { bf16*stg=(bf16*)(shm+LDS_OST)+wid*2048;
    #pragma unroll
    for(int r=0;r<16;++r){const int orow=crow(r,hi);
      #pragma unroll
      for(int d0=0;d0<2;++d0)stg[orow*64+d0*32+r32]=__float2bfloat16(o[d0][r]*rli[r]);}
    asm volatile("s_waitcnt lgkmcnt(0)":::"memory");
    #pragma unroll
    for(int i=0;i<4;++i){const int row=i*8+(lane>>3),ch=lane&7; const u32x4 v=*(const u32x4*)(stg+row*64+ch*8); ATTN_STORE16(Ow+(long)row*opitch+ch*8,v);} }
  asm volatile("s_waitcnt lgkmcnt(0)\n\ts_barrier":::"memory");
  #undef DMA_K
  #undef KROW
  #undef DMA_V
  #undef CMASK
  #undef START
  #undef RESC
  #undef ROT
}
constexpr int ATTN_LDS_BYTES=LDS_BYTES;
#undef SBAR
#undef WAIT_BAR
}
#define LAS __attribute__((address_space(3)))
typedef unsigned short bfs;
typedef float f32x4 __attribute__((ext_vector_type(4)));
typedef float f32x16 __attribute__((ext_vector_type(16)));
typedef unsigned u32x4 __attribute__((ext_vector_type(4)));
typedef unsigned u32x2 __attribute__((ext_vector_type(2)));
typedef short s16x8 __attribute__((ext_vector_type(8)));
constexpr int DM = 1024, NB = 8, SEQ = 4096, NCTX = 256;
constexpr int RCTX = NB * NCTX, RLAT = NB * SEQ, ROWS = RCTX + RLAT;
constexpr int DFF = 2816, NGU = 2 * DFF;
constexpr int NIN0 = 2336, PIN0 = 2560, NIN1 = 5120;
constexpr int C_GQ = 0, C_GK = 256, C_GV = 512, C_GOG = 1024, C_GZ = 1536, C_AQ = 1568, C_AK = 2080, C_AV = 2208;
constexpr int C_FQ = 0, C_FF = 1024, C_FI = 3072, C_FOG = 4096;
constexpr float RMS_EPS = 1e-6f;
constexpr size_t MiB = 1u << 20;
constexpr size_t WS_CTL = 0, CTL_BYTES = 4096;
constexpr size_t WS_MOD = 1 * MiB;
constexpr size_t WS_LB = WS_MOD + 512 * 1024;
constexpr size_t WS_XCTX = 2 * MiB;
constexpr size_t WS_WIN0 = 10 * MiB, WS_WOUT0 = 15 * MiB, WS_WGU0 = 17 * MiB, WS_WD0 = 28 * MiB;
constexpr size_t WS_WIN1 = 34 * MiB, WS_WOUT1 = 44 * MiB, WS_WGU1 = 46 * MiB, WS_WD1 = 57 * MiB;
constexpr size_t WS_C = 64 * MiB;
constexpr size_t WS_D = 132 * MiB;
constexpr size_t WS_Y = WS_D + 192 * MiB;
constexpr size_t WS_END = WS_D + 340 * MiB;
static_assert(WS_WD1 + (size_t)DM * DFF * 2 <= WS_C && WS_C + (size_t)ROWS * DM * 2 <= WS_D && (size_t)ROWS * DFF * 2 <= 192 * MiB && (size_t)ROWS * NIN1 * 2 <= 340 * MiB, "ws map");
constexpr int LDS_CTL_OFF = 153600, LDS_BYTES = 154112;
constexpr int NWAVES = 8, NTHR = 512;

__device__ __forceinline__ float bf2f(unsigned h) { return __uint_as_float(h << 16); }
__device__ __forceinline__ unsigned f2bf(float f) { unsigned u = __float_as_uint(f); return (u + 0x7fffu + ((u >> 16) & 1u)) >> 16; }
__device__ __forceinline__ unsigned pk2(float lo, float hi) { return pg8::cvt_pk_bf16(lo, hi); }
__device__ __forceinline__ float wave_sum(float v) {
#pragma unroll
    for (int o = 1; o < 64; o <<= 1) v += __shfl_xor(v, o);
    return v;
}
__device__ __forceinline__ float siluf(float x) { return x / (1.f + __expf(-x)); }

struct Args { const float* in[24]; float* out; unsigned char* ws; };

__device__ __forceinline__ void p0_transpose_item(const float* W, int K, int N, bfs* WT, int k0, int n0, int drow0, LAS float* scr, int lane) {
#pragma unroll 8
    for (int i = 0; i < 32; ++i) { const int kk = 2 * i + (lane >> 5); scr[kk * 33 + (lane & 31)] = W[(size_t)(k0 + kk) * N + n0 + (lane & 31)]; }
    asm volatile("s_waitcnt lgkmcnt(0)" ::: "memory");
    const int c = lane & 7;
#pragma unroll
    for (int j = 0; j < 4; ++j) { const int n = (lane >> 3) + 8 * j; const LAS float* s = scr + (8 * c) * 33 + n;
        u32x4 o; o.x = pk2(s[0 * 33], s[1 * 33]); o.y = pk2(s[2 * 33], s[3 * 33]); o.z = pk2(s[4 * 33], s[5 * 33]); o.w = pk2(s[6 * 33], s[7 * 33]);
        *(u32x4*)(WT + (size_t)(drow0 + n) * K + k0 + 8 * c) = o; }
    asm volatile("s_waitcnt lgkmcnt(0)" ::: "memory");
}
__device__ __forceinline__ bool p0_try(int& r, const float* W, int K, int N, bfs* WT, int mode  , LAS float* scr, int lane) {
    const int nblk = N / 32, cnt = (K / 64) * nblk;
    if (r >= cnt) { r -= cnt; return false; }
    const int kb = r / nblk, nb = r % nblk, n0 = 32 * nb;
    const int drow0 = mode == 0 ? n0 : ((n0 >> 7) * 256 + (n0 & 127) + (mode == 2 ? 128 : 0));
    p0_transpose_item(W, K, N, WT, 64 * kb, n0, drow0, scr, lane);
    return true;
}
__device__ __forceinline__ void p0_phase(const Args& a, LAS unsigned char* lds, int G) {
    const int tid = tid_fresh(), lane = tid & 63, wave = tid >> 6;
    unsigned char* ws = a.ws;
    {
        LAS float* sc = (LAS float*)lds;
        LAS float* red = (LAS float*)(lds + 40960);
        for (int i = tid; i < 9 * 1024; i += NTHR) { const float v = i < 8192 ? a.in[1][i] : a.in[3][i - 8192]; sc[i] = siluf(v); }
        __syncthreads();
        float* MOD = (float*)(ws + WS_MOD);
        for (int it = blockIdx.x; it < 192; it += G) {
            const int l = it / 96, cb = it % 96, col = cb * 64 + lane;
            const float* w = a.in[4] + (size_t)l * 1024 * 6144 + (size_t)(wave * 128) * 6144 + col;
            float acc[9];
#pragma unroll
            for (int bb = 0; bb < 9; ++bb) acc[bb] = 0.f;
            for (int k0 = 0; k0 < 128; k0 += 8) {
                float wv[8];
#pragma unroll
                for (int j = 0; j < 8; ++j) wv[j] = w[(size_t)(k0 + j) * 6144];
#pragma unroll
                for (int j = 0; j < 8; ++j)
#pragma unroll
                    for (int bb = 0; bb < 9; ++bb) acc[bb] += sc[bb * 1024 + wave * 128 + k0 + j] * wv[j];
            }
#pragma unroll
            for (int bb = 0; bb < 9; ++bb) red[(wave * 9 + bb) * 64 + lane] = acc[bb];
            __syncthreads();
            for (int i = tid; i < 9 * 64; i += NTHR) { float s = 0.f;
#pragma unroll
                for (int w8 = 0; w8 < 8; ++w8) s += red[w8 * 576 + i];
                const int bb = i / 64, c = cb * 64 + (i & 63);
                MOD[((size_t)l * 9 + bb) * 6144 + c] = s + a.in[5][l * 6144 + c]; }
            __syncthreads();
        }
        float* LB = (float*)(ws + WS_LB);
        for (int i = blockIdx.x * NTHR + tid; i < 2048; i += G * NTHR) { const int d = i >> 10, f = i & 1023; const float x0 = a.in[18][d * 2048 + f], x1 = a.in[18][d * 2048 + 1024 + f]; LB[i] = 1.f / (1.f + __expf(x0 - x1)); }
        { u32x4* z = (u32x4*)(ws + WS_WIN0 + (size_t)NIN0 * 1024 * 2); const int n16 = (PIN0 - NIN0) * 1024 * 2 / 16;
          for (int i = blockIdx.x * NTHR + tid; i < n16; i += G * NTHR) z[i] = (u32x4){0u, 0u, 0u, 0u}; }
        __syncthreads();
    }
    LAS float* scr = (LAS float*)(lds + wave * 16384);
    const int gw = blockIdx.x * NWAVES + wave, NGW = G * NWAVES;
    constexpr int I_IN0 = 16 * (NIN0 / 32), I_SQ = 16 * 32, I_G = 16 * (DFF / 32), I_D = (DFF / 64) * 32, I_IN1 = 16 * (NIN1 / 32);
    constexpr int NITEMS = I_IN0 + I_SQ + 2 * I_G + I_D + I_IN1 + I_SQ + 2 * I_G + I_D;
    for (int it = gw; it < NITEMS; it += NGW) {
        int r = it;
        if (p0_try(r, a.in[10], 1024, NIN0, (bfs*)(ws + WS_WIN0), 0, scr, lane)) continue;
        if (p0_try(r, a.in[16], 1024, 1024, (bfs*)(ws + WS_WOUT0), 0, scr, lane)) continue;
        if (p0_try(r, a.in[21], 1024, DFF, (bfs*)(ws + WS_WGU0), 1, scr, lane)) continue;
        if (p0_try(r, a.in[22], 1024, DFF, (bfs*)(ws + WS_WGU0), 2, scr, lane)) continue;
        if (p0_try(r, a.in[23], DFF, 1024, (bfs*)(ws + WS_WD0), 0, scr, lane)) continue;
        if (p0_try(r, a.in[17], 1024, NIN1, (bfs*)(ws + WS_WIN1), 0, scr, lane)) continue;
        if (p0_try(r, a.in[20], 1024, 1024, (bfs*)(ws + WS_WOUT1), 0, scr, lane)) continue;
        if (p0_try(r, a.in[21] + (size_t)1024 * DFF, 1024, DFF, (bfs*)(ws + WS_WGU1), 1, scr, lane)) continue;
        if (p0_try(r, a.in[22] + (size_t)1024 * DFF, 1024, DFF, (bfs*)(ws + WS_WGU1), 2, scr, lane)) continue;
        p0_try(r, a.in[23] + (size_t)DFF * 1024, DFF, 1024, (bfs*)(ws + WS_WD1), 0, scr, lane);
    }
}

struct RowOp {
    const float* xin_lat; const float* xin_ctx; float* xout_lat; float* xout_ctx;
    const bfs* y; const float* gpost; const float* modg; int gate_idx;
    bfs* h; const float* gpre; const float* modh; int shift_idx, scale_idx;
    int row_lo;
};
__device__ __forceinline__ void row_phase(const RowOp op, int G) {
    const int tid_ = tid_fresh(); const int lane = tid_ & 63, wave = tid_ >> 6;
    const int gw = blockIdx.x * NWAVES + wave, NGW = G * NWAVES;
    for (int r = op.row_lo + gw; r < ROWS; r += NGW) {
        const bool isctx = r < RCTX; const int bb = isctx ? 8 : (r - RCTX) / SEQ;
        const float* xin = isctx ? op.xin_ctx + (size_t)r * DM : op.xin_lat + (size_t)(r - RCTX) * DM;
        f32x4 v[4];
#pragma unroll
        for (int j = 0; j < 4; ++j) v[j] = *(const f32x4*)(xin + 4 * lane + 256 * j);
        if (op.y) {
            f32x4 yv[4]; float ss = 0.f;
#pragma unroll
            for (int j = 0; j < 4; ++j) { const u32x2 w = *(const u32x2*)(op.y + (size_t)r * DM + 4 * lane + 256 * j);
                yv[j] = (f32x4){bf2f(w.x & 0xffffu), bf2f(w.x >> 16), bf2f(w.y & 0xffffu), bf2f(w.y >> 16)};
                ss += (yv[j].x * yv[j].x + yv[j].y * yv[j].y) + (yv[j].z * yv[j].z + yv[j].w * yv[j].w); }
            const float rinv = rsqrtf(wave_sum(ss) * (1.f / DM) + RMS_EPS);
            float* xout = isctx ? (op.xout_ctx ? op.xout_ctx + (size_t)r * DM : nullptr) : op.xout_lat + (size_t)(r - RCTX) * DM;
#pragma unroll
            for (int j = 0; j < 4; ++j) { const int c = 4 * lane + 256 * j;
                const f32x4 gp = *(const f32x4*)(op.gpost + c), gt = *(const f32x4*)(op.modg + (size_t)bb * 6144 + op.gate_idx * 1024 + c);
                v[j] = v[j] + gt * (yv[j] * rinv * gp);
                if (xout) *(f32x4*)(xout + c) = v[j]; }
        }
        if (op.h) {
            float ss = 0.f;
#pragma unroll
            for (int j = 0; j < 4; ++j) ss += (v[j].x * v[j].x + v[j].y * v[j].y) + (v[j].z * v[j].z + v[j].w * v[j].w);
            const float rinv = rsqrtf(wave_sum(ss) * (1.f / DM) + RMS_EPS);
#pragma unroll
            for (int j = 0; j < 4; ++j) { const int c = 4 * lane + 256 * j;
                const f32x4 gp = *(const f32x4*)(op.gpre + c), sh = *(const f32x4*)(op.modh + (size_t)bb * 6144 + op.shift_idx * 1024 + c), sc = *(const f32x4*)(op.modh + (size_t)bb * 6144 + op.scale_idx * 1024 + c);
                const f32x4 hv = (v[j] * rinv * gp) * (sc + 1.f) + sh;
                u32x2 w; w.x = pk2(hv.x, hv.y); w.y = pk2(hv.z, hv.w);
                *(u32x2*)(op.h + (size_t)r * DM + c) = w; }
        }
    }
}

__device__ __forceinline__ void qk_phase(bfs* proj, const float* gq, const float* gk, int G) {
    const int tid_ = tid_fresh(); const int lane = tid_ & 63, wave = tid_ >> 6;
    const int gw = blockIdx.x * NWAVES + wave, NGW = G * NWAVES;
    const int sub = lane & 7;
    float gqv[8], gkv[8], inv[4];
#pragma unroll
    for (int e = 0; e < 8; ++e) { gqv[e] = gq[8 * sub + e]; gkv[e] = gk[8 * sub + e]; }
#pragma unroll
    for (int p = 0; p < 4; ++p) { const int pi = (4 * sub + p) & 15; inv[p] = exp2f(-(float)(2 * pi) * (13.287712379549449f / 32.f)); }
    for (int r = gw; r < ROWS; r += NGW) {
        const bool lat = r >= RCTX; const int t = lat ? (r - RCTX) % SEQ : 0;
        const float pos = (sub < 4) ? (float)(t >> 6) : (float)(t & 63);
        float cs[4], sn[4];
#pragma unroll
        for (int p = 0; p < 4; ++p) { if (lat) { const float ang = pos * inv[p]; cs[p] = cosf(ang); sn[p] = sinf(ang); } else { cs[p] = 1.f; sn[p] = 0.f; } }
        bfs* qp = proj + (size_t)r * PIN0 + C_AQ + 8 * lane;
        bfs* kp = proj + (size_t)r * PIN0 + C_AK + 8 * (lane & 15);
        const u32x4 qw = *(const u32x4*)qp; const u32x4 kw = *(const u32x4*)kp;
        float q[8], k[8]; float sq = 0.f, sk = 0.f;
#pragma unroll
        for (int e = 0; e < 4; ++e) { q[2 * e] = bf2f(qw[e] & 0xffffu); q[2 * e + 1] = bf2f(qw[e] >> 16); k[2 * e] = bf2f(kw[e] & 0xffffu); k[2 * e + 1] = bf2f(kw[e] >> 16); }
#pragma unroll
        for (int e = 0; e < 8; ++e) { sq += q[e] * q[e]; sk += k[e] * k[e]; }
#pragma unroll
        for (int o = 1; o < 8; o <<= 1) { sq += __shfl_xor(sq, o); sk += __shfl_xor(sk, o); }
        const float rq = rsqrtf(sq * (1.f / 64.f) + RMS_EPS) , rk = rsqrtf(sk * (1.f / 64.f) + RMS_EPS);
        const float C2 = 0.125f * 1.4426950408889634f;
        u32x4 qo, ko;
#pragma unroll
        for (int p = 0; p < 4; ++p) {
            const float q0 = q[2 * p] * rq * gqv[2 * p], q1 = q[2 * p + 1] * rq * gqv[2 * p + 1];
            const float k0 = k[2 * p] * rk * gkv[2 * p], k1 = k[2 * p + 1] * rk * gkv[2 * p + 1];
            qo[p] = pk2((q0 * cs[p] - q1 * sn[p]) * C2, (q0 * sn[p] + q1 * cs[p]) * C2);
            ko[p] = pk2(k0 * cs[p] - k1 * sn[p], k0 * sn[p] + k1 * cs[p]);
        }
        *(u32x4*)qp = qo;
        if (lane < 16) *(u32x4*)kp = ko;
    }
}

template <int NCOL> __device__ __forceinline__ void readout_phase(bfs* o, const bfs* proj, int pitch, int ogcol, const float* gain, int row_lo, int G) {
    constexpr int PL = NCOL / 64;
    constexpr int LPH = 128 / PL;
    const int tid_ = tid_fresh(); const int lane = tid_ & 63, wave = tid_ >> 6;
    const int gw = blockIdx.x * NWAVES + wave, NGW = G * NWAVES;
    float gv[PL];
#pragma unroll
    for (int e = 0; e < PL; ++e) gv[e] = gain[(PL * lane + e) & 127];
    for (int r = row_lo + gw; r < ROWS; r += NGW) {
        bfs* op = o + (size_t)r * DM + PL * lane; const bfs* gp = proj + (size_t)r * pitch + ogcol + PL * lane;
        float x[PL], g[PL]; float ss = 0.f;
#pragma unroll
        for (int c = 0; c < PL / 8; ++c) { const u32x4 ow = *(const u32x4*)(op + 8 * c), gw4 = *(const u32x4*)(gp + 8 * c);
#pragma unroll
            for (int e = 0; e < 4; ++e) { x[8 * c + 2 * e] = bf2f(ow[e] & 0xffffu); x[8 * c + 2 * e + 1] = bf2f(ow[e] >> 16); g[8 * c + 2 * e] = bf2f(gw4[e] & 0xffffu); g[8 * c + 2 * e + 1] = bf2f(gw4[e] >> 16); } }
#pragma unroll
        for (int e = 0; e < PL; ++e) ss += x[e] * x[e];
#pragma unroll
        for (int of = 1; of < LPH; of <<= 1) ss += __shfl_xor(ss, of);
        const float rinv = rsqrtf(ss * (1.f / 128.f) + RMS_EPS);
#pragma unroll
        for (int c = 0; c < PL / 8; ++c) { u32x4 w;
#pragma unroll
            for (int e = 0; e < 4; ++e) w[e] = pk2(x[8 * c + 2 * e] * rinv * gv[8 * c + 2 * e] * siluf(g[8 * c + 2 * e]), x[8 * c + 2 * e + 1] * rinv * gv[8 * c + 2 * e + 1] * siluf(g[8 * c + 2 * e + 1]));
            *(u32x4*)(op + 8 * c) = w; }
    }
}

namespace scan {
#define SC_LBAR() asm volatile("s_waitcnt lgkmcnt(0)\n\ts_barrier" ::: "memory")
#define SC_FBAR() asm volatile("s_waitcnt vmcnt(0) lgkmcnt(0)\n\ts_barrier" ::: "memory")
template <int PB> __device__ __forceinline__ int swz(int row, int chunk) {
    if (PB == 256) return row * 256 + ((chunk ^ (row & 15)) << 4);
    else return row * 128 + ((chunk ^ ((row >> 1) & 7)) << 4);
}
__device__ __forceinline__ int crow(int r, int hi) { return (r & 3) + 8 * (r >> 2) + 4 * hi; }
template <int DK, bool HG> struct Map {
    static constexpr int PQ = DK * 2, NSEG = 256 / DK;
    static constexpr int O_QG = 0, O_KG = 64 * PQ, O_KGT = 2 * 64 * PQ, O_VT = O_KGT + DK * 128, O_ST = O_VT + 8192, O_EGL = O_ST + 64 * PQ, O_PART = O_EGL + DK * 4, O_ZS = O_PART + NSEG * DK * 4, O_GS = O_ZS + 4096, O_END = HG ? O_ZS : O_GS + 64 * DK * 4;
};
template <int DK, bool HG>
__device__ __forceinline__ void scan_unit(LAS unsigned char* lds, const bfs* __restrict__ proj, const int pitch, const int qcol, const int kcol0, const int kcol_dstride, const int vcol, const int zcol,
                                          const float* __restrict__ wg, const float* __restrict__ bg, const int gcol, bfs* O, const int opitch, const int ocol, const int b, const float qscale) {
    typedef Map<DK, HG> MP;
    constexpr int PQ = MP::PQ, CPR = DK / 8, NQ = 64 * CPR / 256, NSEG = MP::NSEG, RPS = 64 / NSEG, NST = DK / 64;
    const int tid = tid_fresh(), dir = tid >> 8, t = tid & 255, lane = tid & 63, r32 = lane & 31, hi = lane >> 5, w4 = (tid >> 6) & 3;
    LAS unsigned char* L = lds + dir * MP::O_END;
    const int kcol = kcol0 + dir * kcol_dstride;
    const int kc = t % DK, seg = t / DK;
    const int mi = w4 >> 1, nj = w4 & 1, mk = (DK == 128) ? w4 : (w4 >> 1);
    f32x16 S[NST];
#pragma unroll
    for (int i = 0; i < NST; ++i)
#pragma unroll
        for (int r = 0; r < 16; ++r) S[i][r] = 0.f;
    float wreg[16]; float breg = 0.f;
    if (!HG) {
#pragma unroll
        for (int j = 0; j < 16; ++j) wreg[j] = wg[(dir * 16 + j) * 256 + gcol + kc];
        breg = bg[dir * 256 + gcol + kc];
    }
    u32x4 pq[NQ], pk[NQ], pv[2], pz = (u32x4){0u, 0u, 0u, 0u};
#define SC_BASE(s) ({ const int g_ = dir ? ((s) < 4 ? 3 - (s) : 71 - (s)) : (s); (long)(g_ < 4 ? b * 256 + 64 * g_ : 2048 + b * 4096 + 64 * (g_ - 4)); })
#define SC_GROW(base, i) ((base) + (dir ? 63 - (i) : (i)))
#define SC_ISSUE(s) do { const long nb_ = SC_BASE(s); \
        _Pragma("unroll") for (int i = 0; i < NQ; ++i) { const int id = t + 256 * i, row = id / CPR, c = id % CPR; const bfs* rp = proj + (size_t)SC_GROW(nb_, row) * pitch; \
            pq[i] = *(const u32x4*)(rp + qcol + 8 * c); pk[i] = *(const u32x4*)(rp + kcol + 8 * c); } \
        _Pragma("unroll") for (int i = 0; i < 2; ++i) { const int id = t + 256 * i, row = id >> 3, c = id & 7; pv[i] = *(const u32x4*)(proj + (size_t)SC_GROW(nb_, row) * pitch + vcol + 8 * c); } \
        if (!HG) { if (t < 128) pz = *(const u32x4*)(proj + (size_t)SC_GROW(nb_, t >> 1) * pitch + zcol + dir * 16 + 8 * (t & 1)); } } while (0)
    SC_ISSUE(0);
    for (int s = 0; s < 68; ++s) {
        const long base = SC_BASE(s);
        const int g_me = dir ? (s < 4 ? 3 - s : 71 - s) : s;
        const int s_other = dir ? g_me : (g_me < 4 ? 3 - g_me : 71 - g_me);
        const bool first = s < s_other;
#pragma unroll
        for (int ti = 0; ti < NST; ++ti) { const int nvs = (DK == 128) ? ti : (w4 & 1); const int v = 32 * nvs + r32;
#pragma unroll
            for (int r4 = 0; r4 < 4; ++r4) { const int k0 = 32 * mk + 8 * r4 + 4 * hi; u32x2 w; w.x = pk2(S[ti][4 * r4], S[ti][4 * r4 + 1]); w.y = pk2(S[ti][4 * r4 + 2], S[ti][4 * r4 + 3]);
                *(LAS u32x2*)(L + MP::O_ST + swz<PQ>(v, k0 >> 3) + (k0 & 7) * 2) = w; } }
#pragma unroll
        for (int i = 0; i < NQ; ++i) { const int id = t + 256 * i, row = id / CPR, c = id % CPR;
            *(LAS u32x4*)(L + MP::O_QG + swz<PQ>(row, c)) = pq[i]; *(LAS u32x4*)(L + MP::O_KG + swz<PQ>(row, c)) = pk[i]; }
#pragma unroll
        for (int i = 0; i < 2; ++i) { const int id = t + 256 * i, row = id >> 3, c = id & 7;
#pragma unroll
            for (int e = 0; e < 8; ++e) { const unsigned val = (pv[i][e >> 1] >> ((e & 1) * 16)) & 0xffffu; const int vv = c * 8 + e;
                *(LAS unsigned short*)(L + MP::O_VT + swz<128>(vv, row >> 3) + (row & 7) * 2) = (unsigned short)val; } }
        if (!HG) { if (t < 128) { const int row = t >> 1, c = t & 1; LAS float* zs = (LAS float*)(L + MP::O_ZS) + row * 16 + c * 8;
#pragma unroll
                for (int e = 0; e < 4; ++e) { zs[2 * e] = bf2f(pz[e] & 0xffffu); zs[2 * e + 1] = bf2f(pz[e] >> 16); } } }
        if (s + 1 < 68) SC_ISSUE(s + 1);
        SC_LBAR();
        float run = 0.f;
#pragma unroll
        for (int r = 0; r < RPS; ++r) { const int row = seg * RPS + r;
            float g;
            if (HG) g = bf2f(*(const LAS unsigned short*)(L + MP::O_KG + swz<PQ>(row, kc >> 3) + (kc & 7) * 2));
            else { const LAS f32x4* zs = (const LAS f32x4*)(L + MP::O_ZS + row * 64); float lg = breg;
#pragma unroll
                for (int j4 = 0; j4 < 4; ++j4) { const f32x4 z = zs[j4]; lg += z.x * wreg[4 * j4] + z.y * wreg[4 * j4 + 1] + z.z * wreg[4 * j4 + 2] + z.w * wreg[4 * j4 + 3]; }
                g = (fminf(lg, 0.f) - __logf(1.f + __expf(-fabsf(lg)))) * (1.f / 16.f); }
            if (!HG) ((LAS float*)(L + MP::O_GS))[row * DK + kc] = g;
            run += g; }
        ((LAS float*)(L + MP::O_PART))[seg * DK + kc] = run;
        SC_LBAR();
        { float prefix = 0.f, total = 0.f;
#pragma unroll
          for (int s2 = 0; s2 < NSEG; ++s2) { const float p = ((const LAS float*)(L + MP::O_PART))[s2 * DK + kc]; total += p; if (s2 < seg) prefix += p; }
          if (seg == 0) ((LAS float*)(L + MP::O_EGL))[kc] = __expf(total);
          run = prefix;
#pragma unroll
          for (int r = 0; r < RPS; ++r) { const int row = seg * RPS + r;
            LAS unsigned short* qp = (LAS unsigned short*)(L + MP::O_QG + swz<PQ>(row, kc >> 3) + (kc & 7) * 2);
            LAS unsigned short* kp = (LAS unsigned short*)(L + MP::O_KG + swz<PQ>(row, kc >> 3) + (kc & 7) * 2);
            const float kraw = bf2f(*kp); const float g = HG ? kraw : ((const LAS float*)(L + MP::O_GS))[row * DK + kc];
            run += g; const float eG = __expf(run), eN = __expf(-run);
            const float kval = HG ? (1.f - __expf(g)) : kraw;
            *qp = (unsigned short)f2bf(bf2f(*qp) * qscale * eG);
            const unsigned short kgv = (unsigned short)f2bf(kval * eN);
            *kp = kgv;
            *(LAS unsigned short*)(L + MP::O_KGT + swz<128>(kc, row >> 3) + (row & 7) * 2) = kgv; } }
        SC_LBAR();
        f32x16 acc;
#pragma unroll
        for (int r = 0; r < 16; ++r) acc[r] = 0.f;
        if (nj <= mi) {
#pragma unroll
            for (int kk = 0; kk < DK / 16; ++kk) { const s16x8 a = *(const LAS s16x8*)(L + MP::O_KG + swz<PQ>(32 * nj + r32, 2 * kk + hi)); const s16x8 bq = *(const LAS s16x8*)(L + MP::O_QG + swz<PQ>(32 * mi + r32, 2 * kk + hi));
                acc = __builtin_amdgcn_mfma_f32_32x32x16_bf16(a, bq, acc, 0, 0, 0); }
        }
        SC_LBAR();
        { const int i = 32 * mi + r32;
#pragma unroll
          for (int r4 = 0; r4 < 4; ++r4) { const int j0 = 32 * nj + 8 * r4 + 4 * hi; float p[4];
#pragma unroll
            for (int e = 0; e < 4; ++e) p[e] = (j0 + e <= i) ? acc[4 * r4 + e] : 0.f;
            u32x2 w; w.x = pk2(p[0], p[1]); w.y = pk2(p[2], p[3]);
            *(LAS u32x2*)(L + MP::O_KG + swz<128>(i, j0 >> 3) + (j0 & 7) * 2) = w; } }
        SC_LBAR();
        { const int nv = w4 & 1;
#pragma unroll
          for (int r = 0; r < 16; ++r) acc[r] = 0.f;
#pragma unroll
          for (int kk = 0; kk < 4; ++kk) { const s16x8 a = *(const LAS s16x8*)(L + MP::O_VT + swz<128>(32 * nv + r32, 2 * kk + hi)); const s16x8 bp = *(const LAS s16x8*)(L + MP::O_KG + swz<128>(32 * mi + r32, 2 * kk + hi));
              acc = __builtin_amdgcn_mfma_f32_32x32x16_bf16(a, bp, acc, 0, 0, 0); }
#pragma unroll
          for (int kk = 0; kk < DK / 16; ++kk) { const s16x8 a = *(const LAS s16x8*)(L + MP::O_ST + swz<PQ>(32 * nv + r32, 2 * kk + hi)); const s16x8 bq = *(const LAS s16x8*)(L + MP::O_QG + swz<PQ>(32 * mi + r32, 2 * kk + hi));
              acc = __builtin_amdgcn_mfma_f32_32x32x16_bf16(a, bq, acc, 0, 0, 0); }
          bfs* orow = O + (size_t)SC_GROW(base, 32 * mi + r32) * opitch + ocol + 32 * nv + 4 * hi;
#pragma unroll
          for (int r4 = 0; r4 < 4; ++r4) { float o0 = acc[4 * r4], o1 = acc[4 * r4 + 1], o2 = acc[4 * r4 + 2], o3 = acc[4 * r4 + 3];
              unsigned long long* gp = (unsigned long long*)(orow + 8 * r4);
              if (!first) { const unsigned long long old = __hip_atomic_load(gp, __ATOMIC_RELAXED, __HIP_MEMORY_SCOPE_AGENT); const unsigned lo = (unsigned)old, hh = (unsigned)(old >> 32);
                  o0 += bf2f(lo & 0xffffu); o1 += bf2f(lo >> 16); o2 += bf2f(hh & 0xffffu); o3 += bf2f(hh >> 16); }
              *gp = (unsigned long long)pk2(o0, o1) | ((unsigned long long)pk2(o2, o3) << 32); } }
#pragma unroll
        for (int ti = 0; ti < NST; ++ti) { const int nvs = (DK == 128) ? ti : (w4 & 1);
#pragma unroll
            for (int kk = 0; kk < 4; ++kk) { const s16x8 a = *(const LAS s16x8*)(L + MP::O_KGT + swz<128>(32 * mk + r32, 2 * kk + hi)); const s16x8 bv = *(const LAS s16x8*)(L + MP::O_VT + swz<128>(32 * nvs + r32, 2 * kk + hi));
                S[ti] = __builtin_amdgcn_mfma_f32_32x32x16_bf16(a, bv, S[ti], 0, 0, 0); }
#pragma unroll
            for (int r = 0; r < 16; ++r) S[ti][r] *= ((const LAS float*)(L + MP::O_EGL))[32 * mk + crow(r, hi)]; }
        SC_FBAR();
    }
#undef SC_BASE
#undef SC_GROW
#undef SC_ISSUE
}
}

#define GRID_SYNC() grid.sync()
__global__ void __launch_bounds__(NTHR, 2) fwd_megakernel(Args a) {
    extern __shared__ __attribute__((aligned(16))) unsigned char lds_raw[];
    cg::grid_group grid = cg::this_grid();
    LAS unsigned char* lds = (LAS unsigned char*)lds_raw;
    const int G = gridDim.x, tid = threadIdx.x;
    unsigned char* ws = a.ws;
    float* MOD = (float*)(ws + WS_MOD); const float* LB = (const float*)(ws + WS_LB);
    float* XCTX = (float*)(ws + WS_XCTX);
    bfs* CB = (bfs*)(ws + WS_C); bfs* DB = (bfs*)(ws + WS_D); bfs* YB = (bfs*)(ws + WS_Y);
    unsigned* ctl = (unsigned*)(ws + WS_CTL);

    p0_phase(a, lds, G);
    GRID_SYNC();
    { RowOp op{a.in[0], a.in[2], nullptr, nullptr, nullptr, nullptr, nullptr, 0, CB, a.in[6], MOD, 0, 1, 0}; row_phase(op, G); }
    GRID_SYNC();
    for (int l = 0; l < 2; ++l) {
        const float* MODL = MOD + (size_t)l * 9 * 6144;
        const bfs* Win = (const bfs*)(ws + (l ? WS_WIN1 : WS_WIN0)); const bfs* Wout = (const bfs*)(ws + (l ? WS_WOUT1 : WS_WOUT0));
        const bfs* Wgu = (const bfs*)(ws + (l ? WS_WGU1 : WS_WGU0)); const bfs* Wd = (const bfs*)(ws + (l ? WS_WD1 : WS_WD0));
        const int pitch = l ? NIN1 : PIN0;
        { pg8::Gemm g{CB, Win, ROWS, pitch, DM}; pg8::StaticOrder S; S.init(ROWS, pitch, G, (int)blockIdx.x);
          pg8::EpiStore E{DB, pitch, l, LB};
#ifndef NO_GEMM
          pg8::gemm_phase<pg8::EpiStore, pg8::StaticOrder, true, true>(lds, g, S, E);
#endif
 }
        GRID_SYNC();
        if (l == 0) {
            qk_phase(DB, a.in[14], a.in[15], G);
            GRID_SYNC();
            volatile LAS unsigned* lctl = (volatile LAS unsigned*)(lds + LDS_CTL_OFF);
            constexpr int N_GLA = 64, N_ATL = 1024, N_ATC = 64, N_ITEMS = N_GLA + N_ATL + N_ATC;
            for (;;) {
                if (tid == 0) lctl[0] = __hip_atomic_fetch_add(ctl + 64, 1u, __ATOMIC_RELAXED, __HIP_MEMORY_SCOPE_AGENT);
                __syncthreads();
                const int it = (int)lctl[0];
                __syncthreads();
                if (it >= N_ITEMS) break;
                if (it < N_GLA) {
                    const int b = it >> 3, h = (it >> 1) & 3, vh = it & 1;
#ifndef NO_GLA
                    scan::scan_unit<64, false>(lds, DB, PIN0, C_GQ + 64 * h, C_GK + 64 * h, 0, C_GV + 128 * h + 64 * vh, C_GZ, a.in[11], a.in[12], 64 * h, CB, DM, 128 * h + 64 * vh, b, 0.125f);
#endif
                } else if (it < N_GLA + N_ATL) {
                    const int u = it - N_GLA, gq = u & 3, qb = (u >> 2) & 15, kvh = (u >> 6) & 1, b = u >> 7, h = kvh * 4 + gq;
                    const size_t qrow = (size_t)RCTX + (size_t)b * SEQ + (size_t)qb * 256;
#ifndef NO_ATTN
                    attn_body::attn_unit<8>(b, 68, (const attn_body::bf16*)(DB + qrow * PIN0 + C_AQ + 64 * h), PIN0, (const attn_body::bf16*)(DB + C_AK + 64 * kvh), (const attn_body::bf16*)(DB + C_AV + 64 * kvh), PIN0,
                                            (attn_body::bf16*)(CB + qrow * DM + 512 + 64 * h), DM, (char*)lds_raw);
#endif
                } else {
                    const int u = it - N_GLA - N_ATL, h = u & 7, b = u >> 3, kvh = h >> 2;
                    const size_t qrow = (size_t)b * NCTX;
#ifndef NO_ATTN2
                    attn_body::attn_unit<8>(b, 4, (const attn_body::bf16*)(DB + qrow * PIN0 + C_AQ + 64 * h), PIN0, (const attn_body::bf16*)(DB + C_AK + 64 * kvh), (const attn_body::bf16*)(DB + C_AV + 64 * kvh), PIN0,
                                            (attn_body::bf16*)(CB + qrow * DM + 512 + 64 * h), DM, (char*)lds_raw);
#endif
                }
            }
            GRID_SYNC();
            readout_phase<512>(CB, DB, PIN0, C_GOG, a.in[13], 0, G);
        } else {
            for (int u = blockIdx.x; u < 128; u += G) {
                const int b = u >> 4, hh = (u >> 1) & 7, vh = u & 1;
#ifndef NO_HG
                scan::scan_unit<128, true>(lds, DB, NIN1, C_FQ + 128 * hh, C_FF + 128 * hh, 1024, C_FI + 128 * hh + 64 * vh, 0, nullptr, nullptr, 0, CB, DM, 128 * hh + 64 * vh, b, 1.0f);
#endif
            }
            GRID_SYNC();
            readout_phase<1024>(CB, DB, NIN1, C_FOG, a.in[19], RCTX, G);
        }
        GRID_SYNC();
        const int row_lo = l ? RCTX : 0; const int Mg = ROWS - row_lo;
        { pg8::Gemm g{CB + (size_t)row_lo * DM, Wout, Mg, DM, DM}; pg8::StaticOrder S; S.init(Mg, DM, G, (int)blockIdx.x);
          pg8::EpiStore E{YB + (size_t)row_lo * DM, DM, 0, nullptr};
#ifndef NO_GEMM
          pg8::gemm_phase<pg8::EpiStore, pg8::StaticOrder, true, true>(lds, g, S, E);
#endif
 }
        GRID_SYNC();
        { RowOp op{l ? a.out : a.in[0], l ? XCTX : a.in[2], a.out, XCTX, YB, a.in[7] + l * DM, MODL, 2, CB, a.in[8] + l * DM, MODL, 3, 4, row_lo}; row_phase(op, G); }
        GRID_SYNC();
        { pg8::Gemm g{CB + (size_t)row_lo * DM, Wgu, Mg, NGU, DM}; pg8::StaticOrder S; S.init(Mg, NGU, G, (int)blockIdx.x);
          pg8::EpiSwiGLU E{DB + (size_t)row_lo * DFF, DFF};
#ifndef NO_GEMM
          pg8::gemm_phase<pg8::EpiSwiGLU, pg8::StaticOrder, true, true>(lds, g, S, E);
#endif
 }
        GRID_SYNC();
        { pg8::Gemm g{DB + (size_t)row_lo * DFF, Wd, Mg, DM, DFF}; pg8::StaticOrder S; S.init(Mg, DM, G, (int)blockIdx.x);
          pg8::EpiStore E{YB + (size_t)row_lo * DM, DM, 0, nullptr};
#ifndef NO_GEMM
          pg8::gemm_phase<pg8::EpiStore, pg8::StaticOrder, true, true>(lds, g, S, E);
#endif
 }
        GRID_SYNC();
        if (l == 0) { RowOp op{a.out, XCTX, a.out, XCTX, YB, a.in[9], MODL, 5, CB, a.in[6] + DM, MOD + (size_t)9 * 6144, 0, 1, 0}; row_phase(op, G); GRID_SYNC(); }
        else { RowOp op{a.out, XCTX, a.out, nullptr, YB, a.in[9] + DM, MODL, 5, nullptr, nullptr, nullptr, 0, 0, RCTX}; row_phase(op, G); }
    }
}

extern "C" void kernel_launch(void* const* d_in, const int* in_sizes, int n_in, void* d_out, int out_size, void* d_ws, size_t ws_size, hipStream_t stream) {
    static int grid = 0;
    if (grid == 0) {
        if (n_in != 24 || ws_size < WS_END) { fprintf(stderr, "kernel_launch: unexpected inputs (n_in %d, ws %zu < %zu)\n", n_in, ws_size, (size_t)WS_END); grid = -1; return; }
        int dev = 0, cus = 0, per_cu = 0;
        hipGetDevice(&dev);
        hipDeviceGetAttribute(&cus, hipDeviceAttributeMultiprocessorCount, dev);
        if (hipFuncSetAttribute((const void*)fwd_megakernel, hipFuncAttributeMaxDynamicSharedMemorySize, LDS_BYTES) != hipSuccess) { fprintf(stderr, "kernel_launch: hipFuncSetAttribute failed\n"); grid = -1; return; }
        if (hipOccupancyMaxActiveBlocksPerMultiprocessor(&per_cu, (const void*)fwd_megakernel, NTHR, LDS_BYTES) != hipSuccess || per_cu < 1) { fprintf(stderr, "kernel_launch: occupancy query gave %d\n", per_cu); per_cu = 1; }
        (void)hipGetLastError();
        grid = cus * 1;
        fprintf(stderr, "kernel_launch: grid %d (cus %d, per_cu %d)\n", grid, cus, per_cu);
    }
    if (grid < 0) return;
    hipMemsetAsync((char*)d_ws + WS_CTL, 0, CTL_BYTES, stream);
    Args a{};
    for (int i = 0; i < 24; ++i) a.in[i] = (const float*)d_in[i];
    a.out = (float*)d_out; a.ws = (unsigned char*)d_ws;
    void* args[] = {&a};
    hipError_t e = hipLaunchCooperativeKernel((const void*)fwd_megakernel, dim3(grid), dim3(NTHR), args, LDS_BYTES, stream);
    if (e != hipSuccess) fprintf(stderr, "cooperative launch failed: %s (grid %d)\n", hipGetErrorString(e), grid);
}
```

```cpp
#include <hip/hip_runtime.h>
#include <hip/hip_cooperative_groups.h>
#include <hip/hip_bf16.h>
#include <cstdio>
#include <cstdint>
#include <cmath>
namespace cg = cooperative_groups;
__device__ __forceinline__ int tid_fresh() { int t = threadIdx.x; asm volatile("" : "+v"(t)); return t; }
namespace pg8 {
#define PG8_LAS __attribute__((address_space(3)))
typedef unsigned short bf16_t;
typedef short bf16x8 __attribute__((ext_vector_type(8)));
typedef float f32x4 __attribute__((ext_vector_type(4)));
typedef unsigned u32x4 __attribute__((ext_vector_type(4)));
constexpr int BM = 256, BK = 64, HALF = 128, HTB = HALF * BK * 2  , STAGE_BYTES = 8 * HTB, NXCD = 8, WGM = 8;

__host__ __device__ __forceinline__ int lds_byte(int r, int c) { const int st = (r >> 4) * 2 + (c >> 5), rr = r & 15, cc = c & 31, ob = rr * 64 + cc * 2; return st * 1024 + (ob ^ (((ob >> 9) & 1) << 5)); }
__host__ __device__ __forceinline__ void stage_rc(int b, int& R, int& C) { const int st = b / 1024, sb = b % 1024, swz = sb ^ (((sb >> 9) & 1) << 5); R = (st >> 1) * 16 + swz / 64; C = (st & 1) * 32 + (swz % 64) / 2; }
__host__ __device__ __forceinline__ int perm32(int rho) { const int n = rho >> 4, i = rho & 15; return 8 * (i >> 2) + 4 * n + (i & 3); }

struct Unit { int pm, pn; };
struct Gemm { const bf16_t* A; const bf16_t* Bt; int M, N, K; };

struct StaticOrder {
    int nM, nN, nwg, G, c;
    __host__ __device__ void init(int M, int N, int G_, int c_) { nM = M / BM; nN = N / BM; nwg = nM * nN; G = G_; c = c_; }
    __host__ __device__ bool next(int i, Unit& u) const {
        const long L = (long)i * G + c; if (L >= nwg) return false;
        int wgid = (int)L; { const int q = nwg / NXCD, r = nwg % NXCD, xcd = wgid % NXCD, off = wgid / NXCD; wgid = (xcd < r ? xcd * (q + 1) : r * (q + 1) + (xcd - r) * q) + off; }
        const int nig = WGM * nN, gid = wgid / nig, fm = gid * WGM, gsz = (nM - fm) < WGM ? (nM - fm) : WGM;
        u.pm = fm + ((wgid % nig) % gsz); u.pn = (wgid % nig) / gsz; return true;
    }
    __device__ __forceinline__ void a_ready(const Unit&) const {}
    __device__ __forceinline__ void done(const Unit&) const {}
};

typedef float f32x2_cv __attribute__((ext_vector_type(2))); typedef __bf16 bf16x2_cv __attribute__((ext_vector_type(2)));
__device__ __forceinline__ unsigned cvt_pk_bf16(float lo, float hi) { f32x2_cv v = {lo, hi}; bf16x2_cv b = __builtin_convertvector(v, bf16x2_cv); return __builtin_bit_cast(unsigned, b); }
typedef float f32x2 __attribute__((ext_vector_type(2)));
typedef float f32x2 __attribute__((ext_vector_type(2)));
struct EpiStore {
    static constexpr bool PERM = true, AFTER_DRAIN = false;
    bf16_t* O; int ldc; int mode; const float* lb;
    __device__ __forceinline__ void operator()(const f32x4 (&acc)[2][2][4][2], const Unit& u, int wr, int wc, int fr, int fq) const {
        const int row0 = u.pm * BM + wr * 64 + fr; const int col0 = u.pn * BM + wc * 32 + 8 * fq;
#pragma unroll
        for (int bj = 0; bj < 2; ++bj) {
            const int col = col0 + bj * HALF;
            int cls = 0; f32x4 l0 = (f32x4){0.f,0.f,0.f,0.f}, l1 = l0;
            if (mode == 1) { if (col < 1024) cls = 1; else if (col < 3072) { cls = 2; l0 = *(const f32x4*)(lb + col - 1024); l1 = *(const f32x4*)(lb + col - 1024 + 4); } }
#pragma unroll
            for (int ai = 0; ai < 2; ++ai)
#pragma unroll
                for (int m = 0; m < 4; ++m) {
                    f32x4 v0 = acc[ai][bj][m][0], v1 = acc[ai][bj][m][1];
                    if (cls == 1) {
#pragma unroll
                        for (int e = 0; e < 4; ++e) { v0[e] = v0[e] * __builtin_amdgcn_rcpf(1.f + __expf(-v0[e])); v1[e] = v1[e] * __builtin_amdgcn_rcpf(1.f + __expf(-v1[e])); }
                    } else if (cls == 2) {
#pragma unroll
                        for (int e = 0; e < 4; ++e) { const float s0 = __builtin_amdgcn_rcpf(1.f + __expf(v0[e])), s1 = __builtin_amdgcn_rcpf(1.f + __expf(v1[e]));
                            v0[e] = (1.f - l0[e]) * s0; v1[e] = (1.f - l1[e]) * s1; }
                    }
                    u32x4 w; w.x = cvt_pk_bf16(v0[0], v0[1]); w.y = cvt_pk_bf16(v0[2], v0[3]); w.z = cvt_pk_bf16(v1[0], v1[1]); w.w = cvt_pk_bf16(v1[2], v1[3]);
                    *(u32x4*)(O + (size_t)(row0 + ai * HALF + m * 16) * ldc + col) = w;
                }
        }
    }
};
struct EpiSwiGLU {
    static constexpr bool PERM = true, AFTER_DRAIN = false;
    bf16_t* O; int ldc;
    __device__ __forceinline__ void operator()(const f32x4 (&acc)[2][2][4][2], const Unit& u, int wr, int wc, int fr, int fq) const {
        const int row0 = u.pm * BM + wr * 64 + fr; const int col = u.pn * HALF + wc * 32 + 8 * fq;
#pragma unroll
        for (int ai = 0; ai < 2; ++ai)
#pragma unroll
            for (int m = 0; m < 4; ++m) {
                f32x4 g0 = acc[ai][0][m][0], g1 = acc[ai][0][m][1]; const f32x4 u0 = acc[ai][1][m][0], u1 = acc[ai][1][m][1];
#pragma unroll
                for (int e = 0; e < 4; ++e) { g0[e] = g0[e] * __builtin_amdgcn_rcpf(1.f + __expf(-g0[e])) * u0[e]; g1[e] = g1[e] * __builtin_amdgcn_rcpf(1.f + __expf(-g1[e])) * u1[e]; }
                u32x4 w; w.x = cvt_pk_bf16(g0[0], g0[1]); w.y = cvt_pk_bf16(g0[2], g0[3]); w.z = cvt_pk_bf16(g1[0], g1[1]); w.w = cvt_pk_bf16(g1[2], g1[3]);
                *(u32x4*)(O + (size_t)(row0 + ai * HALF + m * 16) * ldc + col) = w;
            }
    }
};
template <class Epi, class Sched, bool ALIGN_EPI = false, bool SP2 = false>
__device__ __forceinline__ void gemm_phase(PG8_LAS unsigned char* lds, const Gemm g, const Sched& S, const Epi& E) {
    const int tid = tid_fresh(), wid = __builtin_amdgcn_readfirstlane(tid >> 6), lane = tid & 63, wr = wid >> 2, wc = wid & 3, fr = lane & 15, fq = lane >> 4;
    const int K = g.K, nt = K / BK;
    unsigned voffA[2], voffB[2];
#pragma unroll
    for (int i = 0; i < 2; ++i) { int R, C; stage_rc(tid * 16 + i * 8192, R, C); const int Rb = Epi::PERM ? ((R & ~31) + perm32(R & 31)) : R;
        voffA[i] = (unsigned)(R * K + C) * 2u; voffB[i] = (unsigned)(Rb * K + C) * 2u; }
    const size_t kstep = (size_t)(BK * 2);
    const size_t hstep = (size_t)HALF * K * 2;
    const size_t tstep = 2 * hstep;
    const unsigned ldsw = (unsigned)wid * 1024u;
    const int aoff = lds_byte(wr * 64 + fr, fq * 8), boff = lds_byte(wc * 32 + fr, fq * 8);
#define PG8_SA(b, h) (((b) * 2 + (h)) * HTB)
#define PG8_SB(b, h) ((4 + (b) * 2 + (h)) * HTB)
#define PG8_STAGE(bufoff, gbase, voff) do { _Pragma("unroll") for (int _i = 0; _i < 2; ++_i) \
        __builtin_amdgcn_global_load_lds((const unsigned*)((const char*)(gbase) + (voff)[_i]), (PG8_LAS unsigned*)(lds + (bufoff) + ldsw + _i * 8192), 16, 0, 0); } while (0)
#define PG8_LDA(dst, b, h) do { _Pragma("unroll") for (int m = 0; m < 4; ++m) _Pragma("unroll") for (int k = 0; k < 2; ++k) dst[m][k] = *(const PG8_LAS bf16x8*)(lds + PG8_SA(b, h) + aoff + m * 2048 + k * 1024); } while (0)
#define PG8_LDB(dst, b, h) do { _Pragma("unroll") for (int n = 0; n < 2; ++n) _Pragma("unroll") for (int k = 0; k < 2; ++k) dst[n][k] = *(const PG8_LAS bf16x8*)(lds + PG8_SB(b, h) + boff + n * 2048 + k * 1024); } while (0)
#define PG8_MMA(ai, bj, At, Bt) do { __builtin_amdgcn_s_setprio(1); _Pragma("unroll") for (int m = 0; m < 4; ++m) _Pragma("unroll") for (int n = 0; n < 2; ++n) _Pragma("unroll") for (int k = 0; k < 2; ++k) \
        acc[ai][bj][m][n] = __builtin_amdgcn_mfma_f32_16x16x32_bf16(Bt[n][k], At[m][k], acc[ai][bj][m][n], 0, 0, 0); __builtin_amdgcn_s_setprio(0); } while (0)
#define PG8_WAIT_V(n) asm volatile("s_waitcnt vmcnt(" #n ")" ::: "memory")
#define PG8_WAIT_L(n) asm volatile("s_waitcnt lgkmcnt(" #n ")" ::: "memory")
#define PG8_BAR __builtin_amdgcn_s_barrier()
#define PG8_SCHED __builtin_amdgcn_sched_barrier(0)
    Unit cur, nxt; int ui = 0;
    if (!S.next(0, cur)) return;
    f32x4 acc[2][2][4][2];
#pragma unroll
    for (int a = 0; a < 2; ++a)
#pragma unroll
        for (int b = 0; b < 2; ++b)
#pragma unroll
            for (int m = 0; m < 4; ++m)
#pragma unroll
                for (int n = 0; n < 2; ++n) acc[a][b][m][n] = (f32x4){0.f, 0.f, 0.f, 0.f};
    bf16x8 At[4][2], B0[2][2], B1[2][2];
    const char* cA = (const char*)g.A + (size_t)cur.pm * tstep; const char* cB = (const char*)g.Bt + (size_t)cur.pn * tstep;
    S.a_ready(cur);
    if constexpr (SP2) {
        PG8_STAGE(PG8_SB(0, 0), cB, voffB); PG8_STAGE(PG8_SB(0, 1), cB + hstep, voffB); PG8_STAGE(PG8_SA(0, 0), cA, voffA); PG8_STAGE(PG8_SA(0, 1), cA + hstep, voffA);
        if (wr == 1) PG8_BAR;
        PG8_WAIT_V(2); PG8_BAR;
        PG8_STAGE(PG8_SB(1, 0), cB + kstep, voffB); PG8_STAGE(PG8_SA(1, 0), cA + kstep, voffA); PG8_STAGE(PG8_SB(1, 1), cB + hstep + kstep, voffB);
        PG8_WAIT_V(6); PG8_BAR;
    } else {
        PG8_STAGE(PG8_SB(0, 0), cB, voffB); PG8_STAGE(PG8_SA(0, 0), cA, voffA); PG8_STAGE(PG8_SB(0, 1), cB + hstep, voffB); PG8_STAGE(PG8_SA(0, 1), cA + hstep, voffA);
        if (wr == 1) PG8_BAR;
        PG8_WAIT_V(4); PG8_BAR;
        PG8_STAGE(PG8_SB(1, 0), cB + kstep, voffB); PG8_STAGE(PG8_SA(1, 0), cA + kstep, voffA); PG8_STAGE(PG8_SB(1, 1), cB + hstep + kstep, voffB);
        PG8_WAIT_V(6); PG8_BAR;
    }
    for (;;) {
        const bool has_next = S.next(ui + 1, nxt);
        const char* nA = has_next ? (const char*)g.A + (size_t)nxt.pm * tstep : cA; const char* nB = has_next ? (const char*)g.Bt + (size_t)nxt.pn * tstep : cB;
        for (int t = 0; t < nt; t += 2) {
            const bool last = (t == nt - 2);
            const char* a1 = cA + (size_t)(t + 1) * kstep;
            const char* a2 = last ? nA : cA + (size_t)(t + 2) * kstep; const char* b2 = last ? nB : cB + (size_t)(t + 2) * kstep;
            const char* a3 = a2 + kstep; const char* b3 = b2 + kstep;
            if (last && has_next) S.a_ready(nxt);
            if constexpr (SP2) {
            PG8_LDB(B0, 0, 0); PG8_LDB(B1, 0, 1); PG8_SCHED; PG8_LDA(At, 0, 0); PG8_STAGE(PG8_SA(1, 1), a1 + hstep, voffA);
            PG8_WAIT_V(8); PG8_WAIT_L(0); PG8_BAR; PG8_MMA(0, 0, At, B0); PG8_MMA(0, 1, At, B1); PG8_BAR; PG8_SCHED;
            PG8_LDA(At, 0, 1); PG8_STAGE(PG8_SB(0, 0), b2, voffB); PG8_STAGE(PG8_SB(0, 1), b2 + hstep, voffB); PG8_STAGE(PG8_SA(0, 0), a2, voffA);
            PG8_WAIT_V(8); PG8_WAIT_L(0); PG8_BAR; PG8_MMA(1, 0, At, B0); PG8_MMA(1, 1, At, B1); PG8_BAR; PG8_SCHED;
            PG8_LDB(B0, 1, 0); PG8_LDB(B1, 1, 1); PG8_SCHED; PG8_LDA(At, 1, 0); PG8_STAGE(PG8_SA(0, 1), a2 + hstep, voffA);
            PG8_WAIT_V(8); PG8_WAIT_L(0); PG8_BAR; PG8_MMA(0, 0, At, B0); PG8_MMA(0, 1, At, B1); PG8_BAR; PG8_SCHED;
            PG8_LDA(At, 1, 1); PG8_STAGE(PG8_SB(1, 0), b3, voffB); PG8_STAGE(PG8_SB(1, 1), b3 + hstep, voffB); PG8_STAGE(PG8_SA(1, 0), a3, voffA);
            PG8_WAIT_V(8); PG8_WAIT_L(0); PG8_BAR; PG8_MMA(1, 0, At, B0); PG8_MMA(1, 1, At, B1); PG8_BAR; PG8_SCHED;
            } else {
            PG8_LDB(B0, 0, 0); PG8_SCHED; PG8_LDA(At, 0, 0); PG8_STAGE(PG8_SA(1, 1), a1 + hstep, voffA);
            PG8_WAIT_L(8); PG8_BAR; PG8_WAIT_L(0); PG8_MMA(0, 0, At, B0); PG8_BAR; PG8_SCHED;
            PG8_LDB(B1, 0, 1); PG8_STAGE(PG8_SB(0, 0), b2, voffB);
            PG8_BAR; PG8_WAIT_L(0); PG8_MMA(0, 1, At, B1); PG8_BAR;
            PG8_LDA(At, 0, 1); PG8_STAGE(PG8_SA(0, 0), a2, voffA);
            PG8_BAR; PG8_WAIT_L(0); PG8_MMA(1, 0, At, B0); PG8_BAR; PG8_SCHED;
            PG8_STAGE(PG8_SB(0, 1), b2 + hstep, voffB);
            PG8_WAIT_V(6); PG8_BAR; PG8_MMA(1, 1, At, B1); PG8_BAR;
            PG8_LDB(B0, 1, 0); PG8_SCHED; PG8_LDA(At, 1, 0); PG8_STAGE(PG8_SA(0, 1), a2 + hstep, voffA);
            PG8_WAIT_L(8); PG8_BAR; PG8_WAIT_L(0); PG8_MMA(0, 0, At, B0); PG8_BAR; PG8_SCHED;
            PG8_LDB(B1, 1, 1); PG8_STAGE(PG8_SB(1, 0), b3, voffB);
            PG8_BAR; PG8_WAIT_L(0); PG8_MMA(0, 1, At, B1); PG8_BAR;
            PG8_LDA(At, 1, 1); PG8_STAGE(PG8_SA(1, 0), a3, voffA);
            PG8_BAR; PG8_WAIT_L(0); PG8_MMA(1, 0, At, B0); PG8_BAR; PG8_SCHED;
            PG8_STAGE(PG8_SB(1, 1), b3 + hstep, voffB);
            PG8_WAIT_V(6); PG8_BAR; PG8_MMA(1, 1, At, B1); PG8_BAR;
            }
        }
        if constexpr (ALIGN_EPI) { if (wr == 0) PG8_BAR; }
        if constexpr (!Epi::AFTER_DRAIN) { E(acc, cur, wr, wc, fr, fq); S.done(cur); }
        if (!has_next) break;
#pragma unroll
        for (int a = 0; a < 2; ++a)
#pragma unroll
            for (int b = 0; b < 2; ++b)
#pragma unroll
                for (int m = 0; m < 4; ++m)
#pragma unroll
                    for (int n = 0; n < 2; ++n) acc[a][b][m][n] = (f32x4){0.f, 0.f, 0.f, 0.f};
        cur = nxt; cA = nA; cB = nB; ++ui;
        if constexpr (ALIGN_EPI) { if (wr == 1) PG8_BAR; }
    }
    PG8_WAIT_V(0);
    if constexpr (!ALIGN_EPI) { if (wr == 0) PG8_BAR; }
    PG8_BAR;
    if constexpr (Epi::AFTER_DRAIN) { E.fused(acc, cur, wr, wc, fr, fq, lds, wid, lane); S.done(cur); }
#undef PG8_SA
#undef PG8_SB
#undef PG8_STAGE
#undef PG8_LDA
#undef PG8_LDB
#undef PG8_MMA
#undef PG8_WAIT_V
#undef PG8_WAIT_L
#undef PG8_BAR
#undef PG8_SCHED
}
}
#include <hip/hip_bf16.h>
#include <cmath>
namespace attn_body {
using bf16=__hip_bfloat16;
using bf16x8=__attribute__((ext_vector_type(8)))short;
using s16x4=__attribute__((ext_vector_type(4)))short;
using f32x16=__attribute__((ext_vector_type(16)))float;
using u32x4=__attribute__((ext_vector_type(4)))unsigned;
constexpr int D=64;
constexpr int NW=8,QBLK=32,QB=QBLK*NW,KVBLK=64;
__device__ __forceinline__ int crow(int r,int hi){return (r&3)+8*(r>>2)+4*hi;}
#define SBAR() __builtin_amdgcn_sched_barrier(0)
__device__ __forceinline__ void cmask(f32x16&p0,f32x16&p1,int jb,int qrel,int hi){
  const float NEG=-INFINITY; int kb=64*jb+4*hi;
  #pragma unroll
  for(int r=0;r<16;++r){int kv=kb+(r&3)+8*(r>>2); if(kv>qrel)p0[r]=NEG; if(kv+32>qrel)p1[r]=NEG;}
}

constexpr int NSLOT=3, SLOTB=8192;
constexpr int LDS_K=0, LDS_V=NSLOT*SLOTB, LDS_WS=2*NSLOT*SLOTB, LDS_OST=LDS_WS+NW*64*4, LDS_BYTES=LDS_OST+NW*4096;
constexpr float C2=0.125f*1.4426950408889634f;
__device__ __forceinline__ void glds16(const void*gsrc,unsigned lds_dst){unsigned keep;
  asm volatile("s_mov_b32 %0, m0\n\ts_mov_b32 m0, %2\n\ts_nop 0\n\tglobal_load_lds_dwordx4 %1, off\n\ts_mov_b32 m0, %0":"=&s"(keep):"v"(gsrc),"s"(lds_dst):"memory");}
__device__ __forceinline__ float max3f(float a,float b,float c){float r;asm("v_max3_f32 %0, %1, %2, %3":"=v"(r):"v"(a),"v"(b),"v"(c));return r;}
__device__ __forceinline__ float max2f(float a,float b){float r;asm("v_max_f32_e32 %0, %1, %2":"=v"(r):"v"(a),"v"(b));return r;}
__device__ __forceinline__ float fadd_s(float a,float b){float r;asm("v_add_f32_e32 %0, %1, %2":"=v"(r):"v"(a),"v"(b));return r;}
__device__ __forceinline__ float fsub_s(float a,float b){float r;asm("v_sub_f32_e32 %0, %1, %2":"=v"(r):"v"(a),"v"(b));return r;}
typedef float f32x2_t __attribute__((ext_vector_type(2))); typedef __bf16 bf16x2_t __attribute__((ext_vector_type(2)));
__device__ __forceinline__ unsigned cvtpk_s(float lo,float hi){f32x2_t v={lo,hi};bf16x2_t b=__builtin_convertvector(v,bf16x2_t);return __builtin_bit_cast(unsigned,b);}
#define WAIT_BAR(N) asm volatile("s_waitcnt vmcnt(" #N ") lgkmcnt(0)\n\ts_barrier":::"memory")

__device__ __forceinline__ void qkt(f32x16&p0,f32x16&p1,const char*Kslot,const bf16x8*qr,const f32x16&negm,int r32,int hi){
  const char*kb=Kslot+hi*1024+r32*16;
  #pragma unroll
  for(int d0=0;d0<4;++d0){
    const bf16x8 b0=*reinterpret_cast<const bf16x8*>(kb+d0*2048);
    const bf16x8 b1=*reinterpret_cast<const bf16x8*>(kb+d0*2048+512);
    if(d0==0){p0=__builtin_amdgcn_mfma_f32_32x32x16_bf16(b0,qr[0],negm,0,0,0);p1=__builtin_amdgcn_mfma_f32_32x32x16_bf16(b1,qr[0],negm,0,0,0);}
    else{p0=__builtin_amdgcn_mfma_f32_32x32x16_bf16(b0,qr[d0],p0,0,0,0);p1=__builtin_amdgcn_mfma_f32_32x32x16_bf16(b1,qr[d0],p1,0,0,0);}}
}
typedef __attribute__((address_space(3))) const char* lds_cptr;
typedef short v4i16_t __attribute__((ext_vector_type(4)));
__device__ __forceinline__ void kload8(bf16x8*kf,lds_cptr kp){
  kf[0]=*(const __attribute__((address_space(3))) bf16x8*)(kp);      kf[1]=*(const __attribute__((address_space(3))) bf16x8*)(kp+512);
  kf[2]=*(const __attribute__((address_space(3))) bf16x8*)(kp+2048); kf[3]=*(const __attribute__((address_space(3))) bf16x8*)(kp+2560);
  kf[4]=*(const __attribute__((address_space(3))) bf16x8*)(kp+4096); kf[5]=*(const __attribute__((address_space(3))) bf16x8*)(kp+4608);
  kf[6]=*(const __attribute__((address_space(3))) bf16x8*)(kp+6144); kf[7]=*(const __attribute__((address_space(3))) bf16x8*)(kp+6656);
}
__device__ __forceinline__ void kload2(bf16x8*kf,lds_cptr kp,int j){ kf[2*j]=*(const __attribute__((address_space(3))) bf16x8*)(kp+j*2048); kf[2*j+1]=*(const __attribute__((address_space(3))) bf16x8*)(kp+j*2048+512); }
__device__ __forceinline__ s16x4 vtr(lds_cptr p){ return __builtin_bit_cast(s16x4,__builtin_amdgcn_ds_read_tr16_b64_v4i16((__attribute__((address_space(3))) v4i16_t*)p)); }
__device__ __forceinline__ float rowmax(const f32x16&p0,const f32x16&p1){
  float a=max3f(p0[0],p0[1],p1[0]),b=max3f(p0[2],p0[3],p1[1]);a=max3f(a,p1[2],p1[3]);
  #pragma unroll
  for(int r=4;r<16;r+=4){a=max3f(a,p0[r],p0[r+1]);b=max3f(b,p0[r+2],p0[r+3]);a=max3f(a,p1[r],p1[r+1]);b=max3f(b,p1[r+2],p1[r+3]);}
  const float m=max2f(a,b);
  auto rr=__builtin_amdgcn_permlane32_swap(__float_as_uint(m),__float_as_uint(m),false,false);
  return max2f(__uint_as_float(rr[0]),__uint_as_float(rr[1]));
}
__device__ __forceinline__ void pv(f32x16*o,int vb,bf16x8 pa0,bf16x8 pa1,bf16x8 pa2,bf16x8 pa3){
  #pragma unroll
  for(int d0=0;d0<2;++d0){s16x4 lo[4],hi[4];
    #pragma unroll
    for(int ks=0;ks<4;++ks){
      asm volatile("ds_read_b64_tr_b16 %0,%1 offset:%c2":"=&v"(lo[ks]):"v"(vb),"i"(d0*4096+ks*1024):"memory");
      asm volatile("ds_read_b64_tr_b16 %0,%1 offset:%c2":"=&v"(hi[ks]):"v"(vb),"i"(d0*4096+ks*1024+512):"memory");}
    asm volatile("s_waitcnt lgkmcnt(0)":::"memory");SBAR();
    #define PK(k) (bf16x8){lo[k][0],lo[k][1],lo[k][2],lo[k][3],hi[k][0],hi[k][1],hi[k][2],hi[k][3]}
    o[d0]=__builtin_amdgcn_mfma_f32_32x32x16_bf16(pa0,PK(0),o[d0],0,0,0);
    o[d0]=__builtin_amdgcn_mfma_f32_32x32x16_bf16(pa1,PK(1),o[d0],0,0,0);
    o[d0]=__builtin_amdgcn_mfma_f32_32x32x16_bf16(pa2,PK(2),o[d0],0,0,0);
    o[d0]=__builtin_amdgcn_mfma_f32_32x32x16_bf16(pa3,PK(3),o[d0],0,0,0);
    #undef PK
  }
}

#ifndef ATTN_STORE16
#define ATTN_STORE16(p,v) (*(u32x4*)(p)=(v))
#endif
template<int THRL> __device__ __forceinline__ void attn_unit(const int b,const int NT,const bf16*Qw0,const int qpitch,const bf16*__restrict__ Kh,const bf16*__restrict__ Vh,const int kvpitch,bf16*Ow0,const int opitch,char*shm){
  const int tid=tid_fresh(),lane=tid&63,r32=lane&31,hi=lane>>5; const int wid=__builtin_amdgcn_readfirstlane(tid>>6);
  const bf16*Qw=Qw0+(long)(wid*QBLK)*qpitch;
  const unsigned lds0=(unsigned)(uintptr_t)shm;
  float*wsf=(float*)(shm+LDS_WS)+wid*64;
  const bf16*ksrc=Kh+(long)lane*kvpitch+wid*8;
  const bf16*vsrc=Vh+(long)(16*(wid&3)+(lane>>2))*kvpitch+(wid>>2)*32+(lane&3)*8;
  const unsigned kdst=lds0+LDS_K+wid*1024, vdst=lds0+LDS_V+wid*1024;
  #define KROW(t) ((long)((t)<4 ? b*256+64*(t) : 2048+b*4096+64*((t)-4)))
  #define DMA_K(t,slot) glds16(ksrc+KROW(t)*kvpitch,(unsigned)__builtin_amdgcn_readfirstlane(kdst+(slot)))
  #define DMA_V(t,slot) glds16(vsrc+KROW(t)*kvpitch,(unsigned)__builtin_amdgcn_readfirstlane(vdst+(slot)))
  const int vb0=(int)(lds0+LDS_V)+((lane>>4)&1)*32+(lane&3)*8+(4*hi+((lane&15)>>2))*64;
  const char*Kbase=shm+LDS_K; bf16x8 kf[8];
  const lds_cptr shm3=(lds_cptr)shm; const lds_cptr kp0=shm3+LDS_K+hi*1024+r32*16; const lds_cptr vp0=shm3+LDS_V+((lane>>4)&1)*32+(lane&3)*8+(4*hi+((lane&15)>>2))*64;
  DMA_K(0,0);DMA_V(0,0);DMA_K(1,SLOTB);
  bf16x8 qr[4];
  #pragma unroll
  for(int d0=0;d0<4;++d0)qr[d0]=*reinterpret_cast<const bf16x8*>(&Qw[(long)r32*qpitch+d0*16+hi*8]);
  float mhat=0.f,l_reg=0.f;f32x16 o[2];o[0]=f32x16{};o[1]=f32x16{};f32x16 negm=f32x16{};asm volatile("":"+v"(negm));
  #define CMASK(P0,P1,t) do{}while(0)
  bool resc=false;
  #define START(P0,P1) do{ const float rm=rowmax(P0,P1); resc=false; \
    { const float dl=rm; mhat=fadd_s(mhat,dl); \
      _Pragma("unroll") for(int r=0;r<16;++r){P0[r]=fsub_s(P0[r],dl);P1[r]=fsub_s(P1[r],dl);} \
      _Pragma("unroll") for(int r=0;r<16;++r)negm[r]=-mhat; asm volatile("":"+v"(negm)); } \
    _Pragma("unroll") for(int r=0;r<16;++r)P0[r]=__builtin_amdgcn_exp2f(P0[r]); }while(0)
  #define RESC() do{ if(resc){ asm volatile("s_waitcnt lgkmcnt(0)":::"memory"); \
      _Pragma("unroll") for(int d_=0;d_<2;++d_) _Pragma("unroll") for(int r=0;r<16;++r)o[d_][r]*=wsf[crow(r,hi)]; } }while(0)
  f32x16 pA0,pA1,pB0,pB1;
  int sl_prev=0,sl_cur=0,sl_next=SLOTB;
  #define ROT() do{sl_prev=sl_cur;sl_cur=sl_next;sl_next=(sl_next==(NSLOT-1)*SLOTB)?0:sl_next+SLOTB;}while(0)
  DMA_K(2,2*SLOTB);
  WAIT_BAR(3);
  qkt(pA0,pA1,Kbase,qr,negm,r32,hi);asm volatile("s_nop 15\n\ts_nop 7":"+v"(pA0),"+v"(pA1));CMASK(pA0,pA1,0);
  START(pA0,pA1);
  _Pragma("unroll") for(int r=0;r<16;++r)pA1[r]=__builtin_amdgcn_exp2f(pA1[r]);
  WAIT_BAR(0);
  DMA_K(3,0);DMA_V(1,SLOTB);
  ROT();
  kload8(kf,kp0+sl_cur);
  WAIT_BAR(2);
  s16x4 vlo[8],vhi[8]; u32x4 pw0,pw1,pw2,pw3;
  #define PKW(P,B) cvtpk_s(P[B],P[B+1])
  #define PAF(k) __builtin_bit_cast(bf16x8,pw##k)
  #define VFR(i) (bf16x8){vlo[i][0],vlo[i][1],vlo[i][2],vlo[i][3],vhi[i][0],vhi[i][1],vhi[i][2],vhi[i][3]}
  #define PIN(x) asm volatile("":"+v"(x))
  #define MX3(a,b,c) __builtin_fmaxf(__builtin_fmaxf((a),(b)),(c))
  #define GAPA(MF,A0,A1,A2,A3,W0,W1,PW) do{ MF; sacc+=A0; sacc+=A1; sacc+=A2; sacc+=A3; PIN(sacc); W0; W1; PIN(PW); SBAR(); }while(0)
  #define EX(v) __builtin_amdgcn_exp2f(v)
  #define GAPB(MF,X,B) do{ MF; X[B]=EX(X[B]); X[B+1]=EX(X[B+1]); X[B+2]=EX(X[B+2]); X[B+3]=EX(X[B+3]); PIN(X); SBAR(); }while(0)
  #define VRD(i) do{ vlo[i]=vtr(vp_+(((i)>>2)*4096+((i)&3)*1024)); vhi[i]=vtr(vp_+(((i)>>2)*4096+((i)&3)*1024+512)); }while(0)
  #define KRD(G,j) do{ if(G){ kload2(kf,kp0+sl_next,j); SBAR(); } }while(0)
  #define STEP(C0,C1,P0,P1,t,GK,GV,GL) do{ SBAR(); \
    const lds_cptr vp_=vp0+sl_prev; \
    VRD(0); SBAR(); float sacc=(P0[0]+P0[1]); \
    GAPA(C0=__builtin_amdgcn_mfma_f32_32x32x16_bf16(kf[0],qr[0],negm,0,0,0), P0[2],P0[3],P0[4],P0[5],     pw0[0]=PKW(P0,0), pw0[1]=PKW(P0,2), pw0); \
    VRD(4); SBAR(); GAPA(C1=__builtin_amdgcn_mfma_f32_32x32x16_bf16(kf[1],qr[0],negm,0,0,0), P0[6],P0[7],P0[8],P0[9],     pw0[2]=PKW(P0,4), pw0[3]=PKW(P0,6), pw0); \
    VRD(1); SBAR(); GAPA(C0=__builtin_amdgcn_mfma_f32_32x32x16_bf16(kf[2],qr[1],C0,0,0,0),   P0[10],P0[11],P0[12],P0[13], pw1[0]=PKW(P0,8), pw1[1]=PKW(P0,10), pw1); \
    VRD(5); SBAR(); GAPA(C1=__builtin_amdgcn_mfma_f32_32x32x16_bf16(kf[3],qr[1],C1,0,0,0),   P0[14],P0[15],P1[0],P1[1],   pw1[2]=PKW(P0,12),pw1[3]=PKW(P0,14), pw1); \
    VRD(2); SBAR(); GAPA(C0=__builtin_amdgcn_mfma_f32_32x32x16_bf16(kf[4],qr[2],C0,0,0,0),   P1[2],P1[3],P1[4],P1[5],     pw2[0]=PKW(P1,0), pw2[1]=PKW(P1,2), pw2); \
    VRD(6); SBAR(); GAPA(C1=__builtin_amdgcn_mfma_f32_32x32x16_bf16(kf[5],qr[2],C1,0,0,0),   P1[6],P1[7],P1[8],P1[9],     pw2[2]=PKW(P1,4), pw2[3]=PKW(P1,6), pw2); \
    VRD(3); SBAR(); GAPA(C0=__builtin_amdgcn_mfma_f32_32x32x16_bf16(kf[6],qr[3],C0,0,0,0),   P1[10],P1[11],P1[12],P1[13], pw3[0]=PKW(P1,8), pw3[1]=PKW(P1,10), pw3); \
    VRD(7); SBAR(); GAPA(C1=__builtin_amdgcn_mfma_f32_32x32x16_bf16(kf[7],qr[3],C1,0,0,0),   P1[14],P1[15],0.f,0.f,       pw3[2]=PKW(P1,12),pw3[3]=PKW(P1,14), pw3); \
    l_reg+=sacc; \
    if(GK){DMA_K((t)+3,sl_cur);} if(GV){DMA_V((t)+1,sl_next);} \
    CMASK(C0,C1,t); \
    { float a=MX3(C0[0],C0[1],C1[0]),b=MX3(C0[2],C0[3],C1[1]); a=MX3(a,C1[2],C1[3]); \
      _Pragma("unroll") for(int r=4;r<16;r+=4){a=MX3(a,C0[r],C0[r+1]);b=MX3(b,C0[r+2],C0[r+3]);a=MX3(a,C1[r],C1[r+1]);b=MX3(b,C1[r+2],C1[r+3]);} \
      float rm=__builtin_fmaxf(a,b); { auto rr=__builtin_amdgcn_permlane32_swap(__float_as_uint(rm),__float_as_uint(rm),false,false); rm=__builtin_fmaxf(__uint_as_float(rr[0]),__uint_as_float(rr[1])); } \
      resc=false; \
      if(__builtin_expect(__any(rm>(float)THRL),0)){ const float dl=__builtin_fmaxf(rm,0.f); mhat+=dl; \
        _Pragma("unroll") for(int r=0;r<16;++r){C0[r]-=dl;C1[r]-=dl;} \
        _Pragma("unroll") for(int r=0;r<16;++r)negm[r]=-mhat; asm volatile("":"+v"(negm)); \
        const float f=__builtin_amdgcn_exp2f(-dl); l_reg*=f; if(hi==0)wsf[r32]=f; resc=true; } } \
    SBAR(); \
    GAPB(o[0]=__builtin_amdgcn_mfma_f32_32x32x16_bf16(PAF(0),VFR(0),o[0],0,0,0), C0,0); \
    GAPB(o[1]=__builtin_amdgcn_mfma_f32_32x32x16_bf16(PAF(0),VFR(4),o[1],0,0,0), C0,4); \
    KRD(GL,0); GAPB(o[0]=__builtin_amdgcn_mfma_f32_32x32x16_bf16(PAF(1),VFR(1),o[0],0,0,0), C0,8); \
    KRD(GL,1); GAPB(o[1]=__builtin_amdgcn_mfma_f32_32x32x16_bf16(PAF(1),VFR(5),o[1],0,0,0), C0,12); \
    KRD(GL,2); GAPB(o[0]=__builtin_amdgcn_mfma_f32_32x32x16_bf16(PAF(2),VFR(2),o[0],0,0,0), C1,0); \
    KRD(GL,3); GAPB(o[1]=__builtin_amdgcn_mfma_f32_32x32x16_bf16(PAF(2),VFR(6),o[1],0,0,0), C1,4); \
    GAPB(o[0]=__builtin_amdgcn_mfma_f32_32x32x16_bf16(PAF(3),VFR(3),o[0],0,0,0), C1,8); \
    GAPB(o[1]=__builtin_amdgcn_mfma_f32_32x32x16_bf16(PAF(3),VFR(7),o[1],0,0,0), C1,12); \
    }while(0)
  int t=1;
  #undef CMASK
  #define CMASK(P0,P1,t) do{}while(0)
  for(;t+5<NT;t+=2){
    STEP(pB0,pB1,pA0,pA1,t,true,true,true);     WAIT_BAR(2); RESC(); ROT();
    STEP(pA0,pA1,pB0,pB1,t+1,true,true,true);   WAIT_BAR(2); RESC(); ROT();
  }
  #undef CMASK
  #define CMASK(P0,P1,t) do{}while(0)
  #define ENDW(tt) do{ if((tt)+3<NT){WAIT_BAR(2);} else if((tt)+2<NT){WAIT_BAR(1);} else {WAIT_BAR(0);} }while(0)
  for(;t+1<NT;t+=2){
    STEP(pB0,pB1,pA0,pA1,t,(t+3<NT),(t+1<NT),(t+1<NT));       ENDW(t);   RESC(); ROT();
    STEP(pA0,pA1,pB0,pB1,t+1,(t+4<NT),(t+2<NT),(t+2<NT));     ENDW(t+1); RESC(); ROT();
  }
  STEP(pB0,pB1,pA0,pA1,NT-1,false,false,false); RESC();
  { float sacc=pB0[0]+pB0[1]; _Pragma("unroll") for(int r=2;r<16;++r)sacc+=pB0[r]; _Pragma("unroll") for(int r=0;r<16;++r)sacc+=pB1[r]; l_reg+=sacc;
    pw0=(u32x4){PKW(pB0,0),PKW(pB0,2),PKW(pB0,4),PKW(pB0,6)};pw1=(u32x4){PKW(pB0,8),PKW(pB0,10),PKW(pB0,12),PKW(pB0,14)};pw2=(u32x4){PKW(pB1,0),PKW(pB1,2),PKW(pB1,4),PKW(pB1,6)};pw3=(u32x4){PKW(pB1,8),PKW(pB1,10),PKW(pB1,12),PKW(pB1,14)};
    SBAR(); pv(o,vb0+sl_cur,PAF(0),PAF(1),PAF(2),PAF(3)); }
  #undef PKW
  #undef PAF
  #undef VFR
  #undef PIN
  #undef MX3
  #undef GAPA
  #undef GAPB
  #undef EX
  #undef VRD
  #undef KRD
  #undef STEP
  #undef ENDW
  {auto rr=__builtin_amdgcn_permlane32_swap(__float_as_uint(l_reg),__float_as_uint(l_reg),false,false);l_reg=__uint_as_float(rr[0])+__uint_as_float(rr[1]);}
  if(hi==0)wsf[32+r32]=l_reg;asm volatile("s_waitcnt lgkmcnt(0)":::"memory");
  float rli[16];
  #pragma unroll
  for(int r=0;r<16;++r)rli[r]=__builtin_amdgcn_rcpf(wsf[32+crow(r,hi)]);
  bf16*Ow=Ow0+(long)(wid*QBLK)*opitch;
  { bf16*stg=(bf16*)(shm+LDS_OST)+wid*2048;
    #pragma unroll
    for(int r=0;r<16;++r){const int orow=crow(r,hi);
      #pragma unroll
      for(int d0=0;d0<2;++d0)stg[orow*64+d0*32+r32]=__float2bfloat16(o[d0][r]*rli[r]);}
    asm volatile("s_waitcnt lgkmcnt(0)":::"memory");
    #pragma unroll
    for(int i=0;i<4;++i){const int row=i*8+(lane>>3),ch=lane&7; const u32x4 v=*(const u32x4*)(stg+row*64+ch*8); ATTN_STORE16(Ow+(long)row*opitch+ch*8,v);} }
  asm volatile("s_waitcnt lgkmcnt(0)\n\ts_barrier":::"memory");
  #undef DMA_K
  #undef KROW
  #undef DMA_V
  #undef CMASK
  #undef START
  #undef RESC
  #undef ROT
}
constexpr int ATTN_LDS_BYTES=LDS_BYTES;
#undef SBAR
#undef WAIT_BAR
}
#define LAS __attribute__((address_space(3)))
typedef unsigned short bfs;
typedef float f32x4 __attribute__((ext_vector_type(4)));
typedef float f32x16 __attribute__((ext_vector_type(16)));
typedef unsigned u32x4 __attribute__((ext_vector_type(4)));
typedef unsigned u32x2 __attribute__((ext_vector_type(2)));
typedef short s16x8 __attribute__((ext_vector_type(8)));
constexpr int DM = 1024, NB = 8, SEQ = 4096, NCTX = 256;
constexpr int RCTX = NB * NCTX, RLAT = NB * SEQ, ROWS = RCTX + RLAT;
constexpr int DFF = 2816, NGU = 2 * DFF;
constexpr int NIN0 = 2336, PIN0 = 2560, NIN1 = 5120;
constexpr int C_GQ = 0, C_GK = 256, C_GV = 512, C_GOG = 1024, C_GZ = 1536, C_AQ = 1568, C_AK = 2080, C_AV = 2208;
constexpr int C_FQ = 0, C_FF = 1024, C_FI = 3072, C_FOG = 4096;
constexpr float RMS_EPS = 1e-6f;
constexpr size_t MiB = 1u << 20;
constexpr size_t WS_CTL = 0, CTL_BYTES = 65536;
constexpr size_t WS_MOD = 1 * MiB;
constexpr size_t WS_LB = WS_MOD + 512 * 1024;
constexpr size_t WS_XCTX = 2 * MiB;
constexpr size_t WS_WIN0 = 10 * MiB, WS_WOUT0 = 15 * MiB, WS_WGU0 = 17 * MiB, WS_WD0 = 28 * MiB;
constexpr size_t WS_WIN1 = 34 * MiB, WS_WOUT1 = 44 * MiB, WS_WGU1 = 46 * MiB, WS_WD1 = 57 * MiB;
constexpr size_t WS_C = 64 * MiB;
constexpr size_t WS_D = 132 * MiB;
constexpr size_t WS_Y = WS_D + 192 * MiB;
constexpr size_t WS_E0 = WS_D + 260 * MiB;
constexpr size_t WS_END = WS_D + 340 * MiB;
static_assert(WS_WD1 + (size_t)DM * DFF * 2 <= WS_C && WS_C + (size_t)ROWS * DM * 2 <= WS_D && (size_t)ROWS * DFF * 2 <= 192 * MiB && (size_t)ROWS * NIN1 * 2 <= 340 * MiB, "ws map");
constexpr int LDS_CTL_OFF = 153600, LDS_BYTES = 154112;
constexpr int NWAVES = 8, NTHR = 512;

__device__ __forceinline__ float bf2f(unsigned h) { return __uint_as_float(h << 16); }
__device__ __forceinline__ unsigned f2bf(float f) { unsigned u = __float_as_uint(f); return (u + 0x7fffu + ((u >> 16) & 1u)) >> 16; }
__device__ __forceinline__ unsigned pk2(float lo, float hi) { return pg8::cvt_pk_bf16(lo, hi); }
__device__ __forceinline__ float dpp_ror(float x, const int n) {
    switch (n) {
    case 8: return __int_as_float(__builtin_amdgcn_update_dpp(0, __float_as_int(x), 0x128, 0xf, 0xf, false));
    case 4: return __int_as_float(__builtin_amdgcn_update_dpp(0, __float_as_int(x), 0x124, 0xf, 0xf, false));
    case 2: return __int_as_float(__builtin_amdgcn_update_dpp(0, __float_as_int(x), 0x122, 0xf, 0xf, false));
    default: return __int_as_float(__builtin_amdgcn_update_dpp(0, __float_as_int(x), 0x121, 0xf, 0xf, false));
    }
}
__device__ __forceinline__ float wave_sum(float v) {
    v += dpp_ror(v, 8); v += dpp_ror(v, 4); v += dpp_ror(v, 2); v += dpp_ror(v, 1);
    const int vi = __float_as_int(v);
    const float r0 = __int_as_float(__builtin_amdgcn_readlane(vi, 0)), r1 = __int_as_float(__builtin_amdgcn_readlane(vi, 16)), r2 = __int_as_float(__builtin_amdgcn_readlane(vi, 32)), r3 = __int_as_float(__builtin_amdgcn_readlane(vi, 48));
    return (r0 + r1) + (r2 + r3);
}
__device__ __forceinline__ float siluf(float x) { return x * __builtin_amdgcn_rcpf(1.f + __expf(-x)); }

struct Args { const float* in[24]; float* out; unsigned char* ws; };

__device__ __forceinline__ void p0_transpose_item(const float* W, int K, int N, bfs* WT, int k0, int n0, int drow0, LAS float* scr, int lane) {
    float tv[32];
#pragma unroll
    for (int i = 0; i < 32; ++i) tv[i] = W[(size_t)(k0 + 2 * i + (lane >> 5)) * N + n0 + (lane & 31)];
#pragma unroll
    for (int i = 0; i < 32; ++i) scr[(2 * i + (lane >> 5)) * 33 + (lane & 31)] = tv[i];
    asm volatile("s_waitcnt lgkmcnt(0)" ::: "memory");
    const int c = lane & 7;
#pragma unroll
    for (int j = 0; j < 4; ++j) { const int n = (lane >> 3) + 8 * j; const LAS float* s = scr + (8 * c) * 33 + n;
        u32x4 o; o.x = pk2(s[0 * 33], s[1 * 33]); o.y = pk2(s[2 * 33], s[3 * 33]); o.z = pk2(s[4 * 33], s[5 * 33]); o.w = pk2(s[6 * 33], s[7 * 33]);
        *(u32x4*)(WT + (size_t)(drow0 + n) * K + k0 + 8 * c) = o; }
    asm volatile("s_waitcnt lgkmcnt(0)" ::: "memory");
}
__device__ __forceinline__ bool p0_try(int& r, const float* W, int K, int N, bfs* WT, int mode  , LAS float* scr, int lane) {
    const int nblk = N / 32, cnt = (K / 64) * nblk;
    if (r >= cnt) { r -= cnt; return false; }
    const int kb = r / nblk, nb = r % nblk, n0 = 32 * nb;
    const int drow0 = mode == 0 ? n0 : ((n0 >> 7) * 256 + (n0 & 127) + (mode == 2 ? 128 : 0));
    p0_transpose_item(W, K, N, WT, 64 * kb, n0, drow0, scr, lane);
    return true;
}
constexpr int P0_I_IN0 = 16 * (NIN0 / 32), P0_I_SQ = 16 * 32, P0_I_G = 16 * (DFF / 32), P0_I_D = (DFF / 64) * 32, P0_I_IN1 = 16 * (NIN1 / 32);
constexpr int P0_NA = P0_I_IN0 + P0_I_SQ + 2 * P0_I_G + P0_I_D + P0_I_IN1, P0_NITEMS = P0_NA + P0_I_SQ + 2 * P0_I_G + P0_I_D;
__device__ __forceinline__ void p0_weights(const Args& a, LAS unsigned char* lds, int it_lo, int it_hi, int gw, int NGW) {
    const int tid = tid_fresh(), lane = tid & 63, wave = tid >> 6;
    unsigned char* ws = a.ws;
    LAS float* scr = (LAS float*)(lds + wave * 16384);
    for (int it = it_lo + gw; it < it_hi; it += NGW) {
        int r = it;
        if (p0_try(r, a.in[10], 1024, NIN0, (bfs*)(ws + WS_WIN0), 0, scr, lane)) continue;
        if (p0_try(r, a.in[16], 1024, 1024, (bfs*)(ws + WS_WOUT0), 0, scr, lane)) continue;
        if (p0_try(r, a.in[21], 1024, DFF, (bfs*)(ws + WS_WGU0), 1, scr, lane)) continue;
        if (p0_try(r, a.in[22], 1024, DFF, (bfs*)(ws + WS_WGU0), 2, scr, lane)) continue;
        if (p0_try(r, a.in[23], DFF, 1024, (bfs*)(ws + WS_WD0), 0, scr, lane)) continue;
        if (p0_try(r, a.in[17], 1024, NIN1, (bfs*)(ws + WS_WIN1), 0, scr, lane)) continue;
        if (p0_try(r, a.in[20], 1024, 1024, (bfs*)(ws + WS_WOUT1), 0, scr, lane)) continue;
        if (p0_try(r, a.in[21] + (size_t)1024 * DFF, 1024, DFF, (bfs*)(ws + WS_WGU1), 1, scr, lane)) continue;
        if (p0_try(r, a.in[22] + (size_t)1024 * DFF, 1024, DFF, (bfs*)(ws + WS_WGU1), 2, scr, lane)) continue;
        p0_try(r, a.in[23] + (size_t)DFF * 1024, DFF, 1024, (bfs*)(ws + WS_WD1), 0, scr, lane);
    }
}
__device__ __forceinline__ void p0_phase(const Args& a, LAS unsigned char* lds, int G) {
    const int tid = tid_fresh(), lane = tid & 63, wave = tid >> 6;
    unsigned char* ws = a.ws;
    {
        LAS float* sc = (LAS float*)lds;
        LAS float* red = (LAS float*)(lds + 40960);
        for (int i = tid; i < 9 * 1024; i += NTHR) { const float v = i < 8192 ? a.in[1][i] : a.in[3][i - 8192]; sc[i] = siluf(v); }
        __syncthreads();
        float* MOD = (float*)(ws + WS_MOD);
        for (int it = blockIdx.x; it < 192; it += G) {
            const int l = it / 96, cb = it % 96, col = cb * 64 + lane;
            const float* w = a.in[4] + (size_t)l * 1024 * 6144 + (size_t)(wave * 128) * 6144 + col;
            float acc[9];
#pragma unroll
            for (int bb = 0; bb < 9; ++bb) acc[bb] = 0.f;
            for (int k0 = 0; k0 < 128; k0 += 32) {
                float wv[32];
#pragma unroll
                for (int j = 0; j < 32; ++j) wv[j] = w[(size_t)(k0 + j) * 6144];
#pragma unroll
                for (int j = 0; j < 32; ++j)
#pragma unroll
                    for (int bb = 0; bb < 9; ++bb) acc[bb] += sc[bb * 1024 + wave * 128 + k0 + j] * wv[j];
            }
#pragma unroll
            for (int bb = 0; bb < 9; ++bb) red[(wave * 9 + bb) * 64 + lane] = acc[bb];
            __syncthreads();
            for (int i = tid; i < 9 * 64; i += NTHR) { float s = 0.f;
#pragma unroll
                for (int w8 = 0; w8 < 8; ++w8) s += red[w8 * 576 + i];
                const int bb = i / 64, c = cb * 64 + (i & 63);
                MOD[((size_t)l * 9 + bb) * 6144 + c] = s + a.in[5][l * 6144 + c]; }
            __syncthreads();
        }
        float* LB = (float*)(ws + WS_LB);
        for (int i = blockIdx.x * NTHR + tid; i < 2048; i += G * NTHR) { const int d = i >> 10, f = i & 1023; const float x0 = a.in[18][d * 2048 + f], x1 = a.in[18][d * 2048 + 1024 + f]; LB[i] = 1.f / (1.f + __expf(x0 - x1)); }
        { u32x4* z = (u32x4*)(ws + WS_WIN0 + (size_t)NIN0 * 1024 * 2); const int n16 = (PIN0 - NIN0) * 1024 * 2 / 16;
          for (int i = blockIdx.x * NTHR + tid; i < n16; i += G * NTHR) z[i] = (u32x4){0u, 0u, 0u, 0u}; }
        __syncthreads();
    }
    p0_weights(a, lds, 0, (G >= 256) ? P0_NA : P0_NITEMS, blockIdx.x * NWAVES + wave, G * NWAVES);
}

struct RowOp {
    const void* xin_lat; const void* xin_ctx; void* xout_lat; void* xout_ctx;
    const bfs* y; const float* gpost; const float* modg; int gate_idx;
    bfs* h; const float* gpre; const float* modh; int shift_idx, scale_idx;
    int row_lo; int xin_bf, xout_bf;
};
__device__ __forceinline__ void row_phase(const RowOp op, int G) {
    const int tid_ = tid_fresh(); const int lane = tid_ & 63, wave = tid_ >> 6;
    const int gw = blockIdx.x * NWAVES + wave, NGW = G * NWAVES;
    const int rpw = (ROWS - op.row_lo + NGW - 1) / NGW;
    const int r0 = op.row_lo + gw * rpw, r1 = (r0 + rpw < ROWS) ? r0 + rpw : ROWS;
    if (r0 >= r1) return;
    f32x4 gp[4], gpre[4], gt[4], sh[4], sc[4];
#pragma unroll
    for (int j = 0; j < 4; ++j) { const int c = 4 * lane + 256 * j; gp[j] = op.y ? *(const f32x4*)(op.gpost + c) : (f32x4){0.f, 0.f, 0.f, 0.f}; gpre[j] = op.h ? *(const f32x4*)(op.gpre + c) : (f32x4){0.f, 0.f, 0.f, 0.f};
        gt[j] = sh[j] = sc[j] = (f32x4){0.f, 0.f, 0.f, 0.f}; }
    int cur_bb = -1;
    f32x4 xn[4]; u32x2 xnb[4], yn[4];
#pragma unroll
    for (int j = 0; j < 4; ++j) { xn[j] = (f32x4){0.f, 0.f, 0.f, 0.f}; xnb[j] = (u32x2){0u, 0u}; }
#define ROW_LOAD(r) do { const bool ic_ = (r) < RCTX; const size_t ro_ = ic_ ? (size_t)(r) * DM : (size_t)((r) - RCTX) * DM; const void* xb_ = ic_ ? op.xin_ctx : op.xin_lat; \
        if (op.xin_bf) { _Pragma("unroll") for (int j = 0; j < 4; ++j) xnb[j] = *(const u32x2*)((const bfs*)xb_ + ro_ + 4 * lane + 256 * j); } \
        else { _Pragma("unroll") for (int j = 0; j < 4; ++j) xn[j] = *(const f32x4*)((const float*)xb_ + ro_ + 4 * lane + 256 * j); } \
        _Pragma("unroll") for (int j = 0; j < 4; ++j) yn[j] = op.y ? *(const u32x2*)(op.y + (size_t)(r) * DM + 4 * lane + 256 * j) : (u32x2){0u, 0u}; } while (0)
    ROW_LOAD(r0);
    for (int r = r0; r < r1; ++r) {
        const bool isctx = r < RCTX; const int bb = isctx ? 8 : (r - RCTX) / SEQ;
        f32x4 v[4]; u32x2 yw[4];
#pragma unroll
        for (int j = 0; j < 4; ++j) { v[j] = op.xin_bf ? (f32x4){bf2f(xnb[j].x & 0xffffu), bf2f(xnb[j].x >> 16), bf2f(xnb[j].y & 0xffffu), bf2f(xnb[j].y >> 16)} : xn[j]; yw[j] = yn[j]; }
        if (r + 1 < r1) ROW_LOAD(r + 1);
        if (bb != cur_bb) { cur_bb = bb;
#pragma unroll
            for (int j = 0; j < 4; ++j) { const int c = 4 * lane + 256 * j;
                if (op.y) gt[j] = *(const f32x4*)(op.modg + (size_t)bb * 6144 + op.gate_idx * 1024 + c);
                if (op.h) { sh[j] = *(const f32x4*)(op.modh + (size_t)bb * 6144 + op.shift_idx * 1024 + c); sc[j] = *(const f32x4*)(op.modh + (size_t)bb * 6144 + op.scale_idx * 1024 + c) + 1.f; } } }
        if (op.y) {
            f32x4 yv[4]; float ss = 0.f;
#pragma unroll
            for (int j = 0; j < 4; ++j) { yv[j] = (f32x4){bf2f(yw[j].x & 0xffffu), bf2f(yw[j].x >> 16), bf2f(yw[j].y & 0xffffu), bf2f(yw[j].y >> 16)};
                ss += (yv[j].x * yv[j].x + yv[j].y * yv[j].y) + (yv[j].z * yv[j].z + yv[j].w * yv[j].w); }
            const float rinv = rsqrtf(wave_sum(ss) * (1.f / DM) + RMS_EPS);
            void* xob = isctx ? op.xout_ctx : op.xout_lat; const size_t xoo = isctx ? (size_t)r * DM : (size_t)(r - RCTX) * DM;
#pragma unroll
            for (int j = 0; j < 4; ++j) { v[j] = v[j] + gt[j] * (yv[j] * rinv * gp[j]);
                if (xob) { if (op.xout_bf) { u32x2 wx; wx.x = pk2(v[j].x, v[j].y); wx.y = pk2(v[j].z, v[j].w); *(u32x2*)((bfs*)xob + xoo + 4 * lane + 256 * j) = wx;
                        v[j] = (f32x4){bf2f(wx.x & 0xffffu), bf2f(wx.x >> 16), bf2f(wx.y & 0xffffu), bf2f(wx.y >> 16)}; }
                    else *(f32x4*)((float*)xob + xoo + 4 * lane + 256 * j) = v[j]; } }
        }
        if (op.h) {
            float ss = 0.f;
#pragma unroll
            for (int j = 0; j < 4; ++j) ss += (v[j].x * v[j].x + v[j].y * v[j].y) + (v[j].z * v[j].z + v[j].w * v[j].w);
            const float rinv = rsqrtf(wave_sum(ss) * (1.f / DM) + RMS_EPS);
#pragma unroll
            for (int j = 0; j < 4; ++j) { const f32x4 hv = (v[j] * rinv * gpre[j]) * sc[j] + sh[j];
                u32x2 w; w.x = pk2(hv.x, hv.y); w.y = pk2(hv.z, hv.w);
                *(u32x2*)(op.h + (size_t)r * DM + 4 * lane + 256 * j) = w; }
        }
    }
#undef ROW_LOAD
}

__device__ __forceinline__ void qk_phase(bfs* proj, const float* gq, const float* gk, int G) {
    const int tid_ = tid_fresh(); const int lane = tid_ & 63, wave = tid_ >> 6;
    const int gw = blockIdx.x * NWAVES + wave, NGW = G * NWAVES;
    const int sub = lane & 7;
    float gqv[8], gkv[8], inv[4];
#pragma unroll
    for (int e = 0; e < 8; ++e) { gqv[e] = gq[8 * sub + e]; gkv[e] = gk[8 * sub + e]; }
#pragma unroll
    for (int p = 0; p < 4; ++p) { const int pi = (4 * sub + p) & 15; inv[p] = exp2f(-(float)(2 * pi) * (13.287712379549449f / 32.f)); }
    const int rpw = (ROWS + NGW - 1) / NGW; const int r0 = gw * rpw, r1 = (r0 + rpw < ROWS) ? r0 + rpw : ROWS;
    u32x4 qn = (u32x4){0u, 0u, 0u, 0u}, kn = qn;
    if (r0 < r1) { qn = *(const u32x4*)(proj + (size_t)r0 * PIN0 + C_AQ + 8 * lane); kn = *(const u32x4*)(proj + (size_t)r0 * PIN0 + C_AK + 8 * (lane & 15)); }
    for (int r = r0; r < r1; ++r) {
        const bool lat = r >= RCTX; const int t = lat ? (r - RCTX) % SEQ : 0;
        const float pos = (sub < 4) ? (float)(t >> 6) : (float)(t & 63);
        float cs[4], sn[4];
#pragma unroll
        for (int p = 0; p < 4; ++p) { if (lat) { const float ang = pos * inv[p]; cs[p] = __cosf(ang); sn[p] = __sinf(ang);     } else { cs[p] = 1.f; sn[p] = 0.f; } }
        bfs* qp = proj + (size_t)r * PIN0 + C_AQ + 8 * lane;
        bfs* kp = proj + (size_t)r * PIN0 + C_AK + 8 * (lane & 15);
        const u32x4 qw = qn; const u32x4 kw = kn;
        if (r + 1 < r1) { qn = *(const u32x4*)(qp + PIN0); kn = *(const u32x4*)(kp + PIN0); }
        float q[8], k[8]; float sq = 0.f, sk = 0.f;
#pragma unroll
        for (int e = 0; e < 4; ++e) { q[2 * e] = bf2f(qw[e] & 0xffffu); q[2 * e + 1] = bf2f(qw[e] >> 16); k[2 * e] = bf2f(kw[e] & 0xffffu); k[2 * e + 1] = bf2f(kw[e] >> 16); }
#pragma unroll
        for (int e = 0; e < 8; ++e) { sq += q[e] * q[e]; sk += k[e] * k[e]; }
#pragma unroll
        for (int o = 1; o < 8; o <<= 1) { sq += __shfl_xor(sq, o); sk += __shfl_xor(sk, o); }
        const float rq = rsqrtf(sq * (1.f / 64.f) + RMS_EPS) , rk = rsqrtf(sk * (1.f / 64.f) + RMS_EPS);
        const float C2 = 0.125f * 1.4426950408889634f;
        u32x4 qo, ko;
#pragma unroll
        for (int p = 0; p < 4; ++p) {
            const float q0 = q[2 * p] * rq * gqv[2 * p], q1 = q[2 * p + 1] * rq * gqv[2 * p + 1];
            const float k0 = k[2 * p] * rk * gkv[2 * p], k1 = k[2 * p + 1] * rk * gkv[2 * p + 1];
            qo[p] = pk2((q0 * cs[p] - q1 * sn[p]) * C2, (q0 * sn[p] + q1 * cs[p]) * C2);
            ko[p] = pk2(k0 * cs[p] - k1 * sn[p], k0 * sn[p] + k1 * cs[p]);
        }
        *(u32x4*)qp = qo;
        if (lane < 16) *(u32x4*)kp = ko;
    }
}

template <int NCOL> __device__ __forceinline__ void readout_phase(const bfs* of, int pf, const bfs* ob, int pb, bfs* out, const bfs* proj, int pitch, int ogcol, const float* gain, int row_lo, int G) {
    constexpr int PL = NCOL / 64;
    constexpr int LPH = 128 / PL;
    const int tid_ = tid_fresh(); const int lane = tid_ & 63, wave = tid_ >> 6;
    const int gw = blockIdx.x * NWAVES + wave, NGW = G * NWAVES;
    float gv[PL];
#pragma unroll
    for (int e = 0; e < PL; ++e) gv[e] = gain[(PL * lane + e) & 127];
    const int rpw = (ROWS - row_lo + NGW - 1) / NGW; const int r0 = row_lo + gw * rpw, r1 = (r0 + rpw < ROWS) ? r0 + rpw : ROWS;
    u32x4 fn[PL / 8], bn[PL / 8], gn[PL / 8];
#define RO_LOAD(r) do { _Pragma("unroll") for (int c = 0; c < PL / 8; ++c) { fn[c] = *(const u32x4*)(of + (size_t)(r) * pf + PL * lane + 8 * c); bn[c] = *(const u32x4*)(ob + (size_t)(r) * pb + PL * lane + 8 * c); gn[c] = *(const u32x4*)(proj + (size_t)(r) * pitch + ogcol + PL * lane + 8 * c); } } while (0)
    if (r0 < r1) RO_LOAD(r0);
    for (int r = r0; r < r1; ++r) {
        float x[PL], g[PL]; float ss = 0.f;
#pragma unroll
        for (int c = 0; c < PL / 8; ++c) { const u32x4 fw = fn[c], bw = bn[c], gw4 = gn[c];
#pragma unroll
            for (int e = 0; e < 4; ++e) { x[8 * c + 2 * e] = bf2f(fw[e] & 0xffffu) + bf2f(bw[e] & 0xffffu); x[8 * c + 2 * e + 1] = bf2f(fw[e] >> 16) + bf2f(bw[e] >> 16); g[8 * c + 2 * e] = bf2f(gw4[e] & 0xffffu); g[8 * c + 2 * e + 1] = bf2f(gw4[e] >> 16); } }
        if (r + 1 < r1) RO_LOAD(r + 1);
#pragma unroll
        for (int e = 0; e < PL; ++e) ss += x[e] * x[e];
#pragma unroll
        for (int of2 = 1; of2 < LPH; of2 <<= 1) ss += __shfl_xor(ss, of2);
        const float rinv = rsqrtf(ss * (1.f / 128.f) + RMS_EPS);
#pragma unroll
        for (int c = 0; c < PL / 8; ++c) { u32x4 wv;
#pragma unroll
            for (int e = 0; e < 4; ++e) wv[e] = pk2(x[8 * c + 2 * e] * rinv * gv[8 * c + 2 * e] * siluf(g[8 * c + 2 * e]), x[8 * c + 2 * e + 1] * rinv * gv[8 * c + 2 * e + 1] * siluf(g[8 * c + 2 * e + 1]));
            *(u32x4*)(out + (size_t)r * DM + PL * lane + 8 * c) = wv; }
    }
#undef RO_LOAD
}

namespace scan {
#define SC_LBAR() asm volatile("s_waitcnt lgkmcnt(0)\n\ts_barrier" ::: "memory")
template <int PB> __device__ __forceinline__ int swz(int row, int chunk) {
    if (PB == 256) return row * 256 + ((chunk ^ (row & 15) ^ ((row >> 4) & 3)) << 4);
    else return row * 128 + ((chunk ^ (((row >> 1) ^ (row >> 4)) & 7)) << 4);
}
__device__ __forceinline__ int crow(int r, int hi) { return (r & 3) + 8 * (r >> 2) + 4 * hi; }
__device__ __forceinline__ float dpp_shr(float x, float old, const int n) {
    switch (n) {
    case 1: return __int_as_float(__builtin_amdgcn_update_dpp(__float_as_int(old), __float_as_int(x), 0x111, 0xf, 0xf, false));
    case 2: return __int_as_float(__builtin_amdgcn_update_dpp(__float_as_int(old), __float_as_int(x), 0x112, 0xf, 0xf, false));
    case 4: return __int_as_float(__builtin_amdgcn_update_dpp(__float_as_int(old), __float_as_int(x), 0x114, 0xf, 0xf, false));
    default: return __int_as_float(__builtin_amdgcn_update_dpp(__float_as_int(old), __float_as_int(x), 0x118, 0xf, 0xf, false));
    }
}
template <int DK, bool HG> struct Map {
    static constexpr int PQ = DK * 2;
    static constexpr int O_QG = 0, O_KG = 64 * PQ, O_KGT = 2 * 64 * PQ, O_VT = O_KGT + DK * 128, O_ST = O_VT + 16384, O_EGL = O_ST + 128 * PQ, O_VR = O_EGL + DK * 4, O_ZB = O_VR + 16384, O_FB = O_ZB + 2048, O_END = HG ? O_ZB : O_FB + 16384;
};
template <int DK, bool HG, int pitch>
__device__ __forceinline__ void scan_unit(LAS unsigned char* L, const bfs* __restrict__ proj, const int qcol, const int kcol, const int vcol, const int zcol,
                                          const float* __restrict__ wg, const float* __restrict__ bg, bfs* O, const int opitch, const int ocol, const int b, const int dir, const float qscale) {
    typedef Map<DK, HG> MP;
    constexpr int PQ = MP::PQ, NTG = DK * 4, NST = DK / 64;
    const int tid = tid_fresh(), lane = tid & 63, r32 = lane & 31, hi = lane >> 5, w = tid >> 6;
    const int c4 = tid >> 4, sg = tid & 15;
    const bool gact = tid < NTG;
    const int mk = (DK == 128) ? (w >> 1) : (w >> 2);
    const int nv0 = (DK == 128) ? 2 * (w & 1) : (w & 3);
    f32x16 S[NST];
#pragma unroll
    for (int i = 0; i < NST; ++i)
#pragma unroll
        for (int r = 0; r < 16; ++r) S[i][r] = 0.f;
    s16x8 wgB = (s16x8){0, 0, 0, 0, 0, 0, 0, 0}; float bias = 0.f;
    if (!HG) {
        const int col = 32 * (w & 1) + r32;
#pragma unroll
        for (int j = 0; j < 8; ++j) wgB[j] = (short)f2bf(wg[(8 * hi + j) * 256 + col]);
        bias = bg[col];
    }
    constexpr int NQ = DK / 64, CPR = DK / 8;
    u32x4 pqA[NQ], pkA[NQ], pvA[2]; u32x4 pzA = (u32x4){0u, 0u, 0u, 0u};
#define SC_BASE(s) ({ const int g_ = dir ? ((s) < 4 ? 3 - (s) : 71 - (s)) : (s); (long)(g_ < 4 ? b * 256 + 64 * g_ : 2048 + b * 4096 + 64 * (g_ - 4)); })
#define SC_GROW(base, i) ((base) + (dir ? 63 - (i) : (i)))
#define SC_ISSUE(s) do { const long nb_ = SC_BASE(s); \
        _Pragma("unroll") for (int i = 0; i < NQ; ++i) { const int id = tid + 512 * i, row = id / CPR, c = id % CPR; const bfs* rp = proj + (size_t)SC_GROW(nb_, row) * pitch + 8 * c; pq[i] = *(const u32x4*)(rp + qcol); pk[i] = *(const u32x4*)(rp + kcol); } \
        _Pragma("unroll") for (int i = 0; i < 2; ++i) { const int id = tid + 512 * i, row = id >> 4, c = id & 15; pv[i] = *(const u32x4*)(proj + (size_t)SC_GROW(nb_, row) * pitch + vcol + 8 * c); } \
        if (!HG) { if (tid < 128) pz = *(const u32x4*)(proj + (size_t)SC_GROW(nb_, tid >> 1) * pitch + zcol + 8 * (tid & 1)); } } while (0)
    { auto& pq = pqA; auto& pk = pkA; auto& pv = pvA; auto& pz = pzA; SC_ISSUE(0); }
    unsigned ost[8]; long pbase = 0;
#pragma unroll
    for (int i = 0; i < 8; ++i) ost[i] = 0u;
#define SC_STORE(bs) do { const int nvt_ = w >> 1, mi_ = w & 1; const int lrow_ = dir ? 63 - (32 * mi_ + 4 * hi) : (32 * mi_ + 4 * hi); const long ostep_ = dir ? -(long)opitch : (long)opitch; \
        bfs* ob_ = O + (size_t)((bs) + lrow_) * opitch + ocol + 32 * nvt_ + r32; \
        _Pragma("unroll") for (int r = 0; r < 16; ++r) ob_[((r & 3) + 8 * (r >> 2)) * ostep_] = (bfs)((r & 1) ? (ost[r >> 1] >> 16) : (ost[r >> 1] & 0xffffu)); } while (0)
    auto body = [&](const int s, u32x4 (&pq)[NQ], u32x4 (&pk)[NQ], u32x4 (&pv)[2], u32x4& pz) __attribute__((always_inline)) {
        const long base = SC_BASE(s);
#ifdef PROBE_SEG
        unsigned long long tseg0 = __builtin_amdgcn_s_memrealtime();
#define SEG_MARK(k) do { const unsigned long long tn_ = __builtin_amdgcn_s_memrealtime(); if (HG && blockIdx.x == PROBE_BLK && threadIdx.x == 0 && (PROBE_SEG == (k) || PROBE_SEG == 0)) { volatile LAS unsigned long long* pa_ = (volatile LAS unsigned long long*)(L + 153600 + 64 + 40 * 8); pa_[0] += tn_ - tseg0; } tseg0 = tn_; } while (0)
#else
#define SEG_MARK(k) do {} while (0)
#endif
#pragma unroll
        for (int ti = 0; ti < NST; ++ti) { const int v = 32 * (nv0 + ti) + r32;
#pragma unroll
            for (int r4 = 0; r4 < 4; ++r4) { const int k0 = 32 * mk + 8 * r4 + 4 * hi; u32x2 wv; wv.x = pk2(S[ti][4 * r4], S[ti][4 * r4 + 1]); wv.y = pk2(S[ti][4 * r4 + 2], S[ti][4 * r4 + 3]);
                *(LAS u32x2*)(L + MP::O_ST + swz<PQ>(v, k0 >> 3) + (k0 & 7) * 2) = wv; } }
        if (s > 0) SC_STORE(pbase);
        pbase = base;
#pragma unroll
        for (int i = 0; i < NQ; ++i) { const int id = tid + 512 * i, row = id / CPR, c = id % CPR;
            *(LAS u32x4*)(L + MP::O_QG + swz<PQ>(row, c)) = pq[i]; *(LAS u32x4*)(L + MP::O_KG + swz<PQ>(row, c)) = pk[i]; }
#pragma unroll
        for (int i = 0; i < 2; ++i) { const int id = tid + 512 * i, row = id >> 4, c = id & 15; *(LAS u32x4*)(L + MP::O_VR + swz<256>(row, c)) = pv[i]; }
        if (!HG) { if (tid < 128) *(LAS u32x4*)(L + MP::O_ZB + (tid >> 1) * 32 + (tid & 1) * 16) = pz; }
        if (s + 1 < 68) SC_ISSUE(s + 1);
        SC_LBAR();
        u32x2 q2[4], k2[4], v2[4];
#pragma unroll
        for (int r = 0; r < 4; ++r) { v2[r] = *(const LAS u32x2*)(L + MP::O_VR + swz<256>(4 * sg + r, c4 >> 1) + (c4 & 1) * 8); q2[r] = (u32x2){0u, 0u}; k2[r] = (u32x2){0u, 0u}; }
        if (gact) {
#pragma unroll
            for (int r = 0; r < 4; ++r) { const int off = swz<PQ>(4 * sg + r, c4 >> 1) + (c4 & 1) * 8; q2[r] = *(const LAS u32x2*)(L + MP::O_QG + off); k2[r] = *(const LAS u32x2*)(L + MP::O_KG + off); } }
        {
            u32x2 t0, t1, t2, t3;
            t0.x = (v2[0].x & 0xffffu) | (v2[1].x << 16); t0.y = (v2[2].x & 0xffffu) | (v2[3].x << 16);
            t1.x = (v2[0].x >> 16) | (v2[1].x & 0xffff0000u); t1.y = (v2[2].x >> 16) | (v2[3].x & 0xffff0000u);
            t2.x = (v2[0].y & 0xffffu) | (v2[1].y << 16); t2.y = (v2[2].y & 0xffffu) | (v2[3].y << 16);
            t3.x = (v2[0].y >> 16) | (v2[1].y & 0xffff0000u); t3.y = (v2[2].y >> 16) | (v2[3].y & 0xffff0000u);
            const int vo = (sg & 1) * 8;
            *(LAS u32x2*)(L + MP::O_VT + swz<128>(4 * c4 + 0, sg >> 1) + vo) = t0; *(LAS u32x2*)(L + MP::O_VT + swz<128>(4 * c4 + 1, sg >> 1) + vo) = t1;
            *(LAS u32x2*)(L + MP::O_VT + swz<128>(4 * c4 + 2, sg >> 1) + vo) = t2; *(LAS u32x2*)(L + MP::O_VT + swz<128>(4 * c4 + 3, sg >> 1) + vo) = t3; }
        float qv[4][4], kv[4][4];
#pragma unroll
        for (int r = 0; r < 4; ++r) { qv[r][0] = bf2f(q2[r].x & 0xffffu); qv[r][1] = bf2f(q2[r].x >> 16); qv[r][2] = bf2f(q2[r].y & 0xffffu); qv[r][3] = bf2f(q2[r].y >> 16);
            kv[r][0] = bf2f(k2[r].x & 0xffffu); kv[r][1] = bf2f(k2[r].x >> 16); kv[r][2] = bf2f(k2[r].y & 0xffffu); kv[r][3] = bf2f(k2[r].y >> 16); }
        if (!HG) {
            if (w < 4) { const int mi = w >> 1, nj = w & 1;
                const s16x8 za = *(const LAS s16x8*)(L + MP::O_ZB + (32 * mi + r32) * 32 + hi * 16);
                f32x16 lg;
#pragma unroll
                for (int r = 0; r < 16; ++r) lg[r] = 0.f;
                lg = __builtin_amdgcn_mfma_f32_32x32x16_bf16(za, wgB, lg, 0, 0, 0);
#pragma unroll
                for (int r = 0; r < 16; ++r) { const float x = lg[r] + bias; const float ls = fminf(x, 0.f) - __logf(1.f + __expf(-fabsf(x)));
                    ((LAS float*)(L + MP::O_FB))[(32 * mi + crow(r, hi)) * 64 + 32 * nj + r32] = __expf(ls * (1.f / 16.f)); } }
            SC_LBAR();
        }
        if (gact) {
            float p[4][4];
#pragma unroll
            for (int r = 0; r < 4; ++r) {
                f32x4 f;
                if (HG) f = (f32x4){1.f - kv[r][0], 1.f - kv[r][1], 1.f - kv[r][2], 1.f - kv[r][3]};
                else f = *(const LAS f32x4*)(L + MP::O_FB + ((4 * sg + r) * 64 + 4 * c4) * 4);
#pragma unroll
                for (int e = 0; e < 4; ++e) p[r][e] = r ? p[r - 1][e] * f[e] : f[e]; }
            float ex[4];
#pragma unroll
            for (int e = 0; e < 4; ++e) { float x = p[3][e];
                x *= dpp_shr(x, 1.f, 1); x *= dpp_shr(x, 1.f, 2); x *= dpp_shr(x, 1.f, 4); x *= dpp_shr(x, 1.f, 8);
                ex[e] = dpp_shr(x, 1.f, 1);
                if (sg == 15) ((LAS float*)(L + MP::O_EGL))[4 * c4 + e] = x; }
            float kg[4][4];
#pragma unroll
            for (int r = 0; r < 4; ++r) { const int row = 4 * sg + r; float qg[4];
#pragma unroll
                for (int e = 0; e < 4; ++e) { const float eG = ex[e] * p[r][e]; qg[e] = qv[r][e] * qscale * eG; kg[r][e] = kv[r][e] * __builtin_amdgcn_rcpf(eG); }
                u32x2 wq, wk; wq.x = pk2(qg[0], qg[1]); wq.y = pk2(qg[2], qg[3]); wk.x = pk2(kg[r][0], kg[r][1]); wk.y = pk2(kg[r][2], kg[r][3]);
                const int off = swz<PQ>(row, c4 >> 1) + (c4 & 1) * 8;
                *(LAS u32x2*)(L + MP::O_QG + off) = wq; *(LAS u32x2*)(L + MP::O_KG + off) = wk; }
#pragma unroll
            for (int e = 0; e < 4; ++e) { u32x2 wt; wt.x = pk2(kg[0][e], kg[1][e]); wt.y = pk2(kg[2][e], kg[3][e]);
                *(LAS u32x2*)(L + MP::O_KGT + swz<128>(4 * c4 + e, sg >> 1) + (sg & 1) * 8) = wt; }
        }
        SC_LBAR();
        SEG_MARK(1);
        f32x16 acc;
#pragma unroll
        for (int r = 0; r < 16; ++r) acc[r] = 0.f;
        { const int mi = (w >> 1) & 1, nj = w & 1;
          if (w < 4 && nj <= mi) {
#pragma unroll
            for (int kk = 0; kk < DK / 16; ++kk) { const s16x8 ka = *(const LAS s16x8*)(L + MP::O_KG + swz<PQ>(32 * nj + r32, 2 * kk + hi)); const s16x8 bq = *(const LAS s16x8*)(L + MP::O_QG + swz<PQ>(32 * mi + r32, 2 * kk + hi));
                acc = __builtin_amdgcn_mfma_f32_32x32x16_bf16(ka, bq, acc, 0, 0, 0); } }
          SC_LBAR();
          if (w < 4) { const int i = 32 * mi + r32;
#pragma unroll
            for (int r4 = 0; r4 < 4; ++r4) { const int j0 = 32 * nj + 8 * r4 + 4 * hi; float pp[4];
#pragma unroll
              for (int e = 0; e < 4; ++e) pp[e] = (j0 + e <= i) ? acc[4 * r4 + e] : 0.f;
              u32x2 wv; wv.x = pk2(pp[0], pp[1]); wv.y = pk2(pp[2], pp[3]);
              *(LAS u32x2*)(L + MP::O_KG + swz<128>(i, j0 >> 3) + (j0 & 7) * 2) = wv; } } }
        SC_LBAR();
        SEG_MARK(2);
        { const int nvt = w >> 1, mi = w & 1;
#pragma unroll
          for (int r = 0; r < 16; ++r) acc[r] = 0.f;
#pragma unroll
          for (int kk = 0; kk < 4; ++kk) { const s16x8 va = *(const LAS s16x8*)(L + MP::O_VT + swz<128>(32 * nvt + r32, 2 * kk + hi)); const s16x8 bp = *(const LAS s16x8*)(L + MP::O_KG + swz<128>(32 * mi + r32, 2 * kk + hi));
              acc = __builtin_amdgcn_mfma_f32_32x32x16_bf16(bp, va, acc, 0, 0, 0); }
#pragma unroll
          for (int kk = 0; kk < DK / 16; ++kk) { const s16x8 sa = *(const LAS s16x8*)(L + MP::O_ST + swz<PQ>(32 * nvt + r32, 2 * kk + hi)); const s16x8 bq = *(const LAS s16x8*)(L + MP::O_QG + swz<PQ>(32 * mi + r32, 2 * kk + hi));
              acc = __builtin_amdgcn_mfma_f32_32x32x16_bf16(bq, sa, acc, 0, 0, 0); }
#pragma unroll
          for (int i = 0; i < 8; ++i) ost[i] = pk2(acc[2 * i], acc[2 * i + 1]);
          }
#pragma unroll
        for (int ti = 0; ti < NST; ++ti) {
#pragma unroll
            for (int kk = 0; kk < 4; ++kk) { const s16x8 ka = *(const LAS s16x8*)(L + MP::O_KGT + swz<128>(32 * mk + r32, 2 * kk + hi)); const s16x8 bv = *(const LAS s16x8*)(L + MP::O_VT + swz<128>(32 * (nv0 + ti) + r32, 2 * kk + hi));
                S[ti] = __builtin_amdgcn_mfma_f32_32x32x16_bf16(ka, bv, S[ti], 0, 0, 0); }
#pragma unroll
            for (int r = 0; r < 16; ++r) S[ti][r] *= ((const LAS float*)(L + MP::O_EGL))[32 * mk + crow(r, hi)]; }
        SC_LBAR();
        SEG_MARK(3);
    };
    for (int s2 = 0; s2 < 68; ++s2) body(s2, pqA, pkA, pvA, pzA);
    SC_STORE(pbase);
    asm volatile("s_waitcnt vmcnt(0)" ::: "memory");
#undef SC_STORE
#undef SC_BASE
#undef SC_GROW
#undef SC_ISSUE
}
}

#define XB_TMO      128
#define XB_XCNT(j)  (256  + 64 * (j))
#define XB_XSUB(j)  (1280 + 64 * (j))
#define XB_XGEN(j)  (2304 + 64 * (j))
#define XB_TOP      3328
#define XB_TOPGEN   3392
#define XCD_BAR_WORDS 3456
#define XB_SPIN_CAP (1u << 18)

__device__ __forceinline__ unsigned xb_ld(unsigned* p)              { return __hip_atomic_load(p, __ATOMIC_RELAXED, __HIP_MEMORY_SCOPE_AGENT); }
__device__ __forceinline__ unsigned xb_add(unsigned* p, unsigned v) { return __hip_atomic_fetch_add(p, v, __ATOMIC_RELAXED, __HIP_MEMORY_SCOPE_AGENT); }
__device__ __forceinline__ unsigned xb_xcc_id() { return (unsigned)__builtin_amdgcn_s_getreg((3 << 11) | 20) & 0xFu; }
#define XB_SPIN(cond, bar) do { unsigned _sp = 0; while (cond) { __builtin_amdgcn_s_sleep(1); \
    if ((++_sp & 255u) == 0u) { if (xb_ld(&(bar)[XB_TMO])) break; if (_sp > XB_SPIN_CAP) { atomicAdd(&(bar)[XB_TMO], 1u); break; } } } } while (0)

struct XcdBarrier {
    unsigned* bar; unsigned x;
    volatile LAS unsigned* st;
};

__device__ __forceinline__ XcdBarrier xcd_barrier_post(unsigned* bar, volatile LAS unsigned* st) {
    XcdBarrier b; b.bar = bar; b.x = xb_xcc_id(); b.st = st;
    if (threadIdx.x == 0) (void)xb_add(&bar[XB_XCNT(b.x)], 1u);
    return b;
}
__device__ __forceinline__ void xcd_barrier_complete(unsigned* bar, unsigned x, unsigned& nloc, unsigned& nx) {
    const unsigned G = gridDim.x * gridDim.y * gridDim.z;
    unsigned sum, cnt, mine, sp = 0u;
    for (;;) {
        sum = 0u; cnt = 0u; mine = 0u;
#pragma unroll
        for (unsigned j = 0; j < 16; ++j) { const unsigned c = xb_ld(&bar[XB_XCNT(j)]); sum += c; cnt += (c > 0u) ? 1u : 0u; mine = (j == x) ? c : mine; }
        if (sum == G) break;
        __builtin_amdgcn_s_sleep(1);
        if ((++sp & 255u) == 0u) { if (xb_ld(&bar[XB_TMO])) break; if (sp > XB_SPIN_CAP) { atomicAdd(&bar[XB_TMO], 1u); break; } }
    }
    nloc = mine > 0u ? mine : 1u; nx = cnt > 0u ? cnt : 1u;
}

__device__ __forceinline__ void xcd_barrier(const XcdBarrier& b) {
    asm volatile("s_waitcnt vmcnt(0)" ::: "memory");
    __syncthreads();
    if (threadIdx.x == 0) {
        unsigned* bar = b.bar;
        __builtin_amdgcn_s_waitcnt(0);
        unsigned nloc = b.st[0], nx = b.st[1];
        if (nloc == 0u) { xcd_barrier_complete(bar, b.x, nloc, nx); b.st[0] = nloc; b.st[1] = nx; }
        const unsigned old = xb_add(&bar[XB_XSUB(b.x)], 1u);
        const unsigned gen = old / nloc;
        if (old + 1u == (gen + 1u) * nloc) {
            __builtin_amdgcn_fence(__ATOMIC_RELEASE, "agent");
            asm volatile("s_waitcnt vmcnt(0)" ::: "memory");
            const unsigned og = xb_add(&bar[XB_TOP], 1u);
            const unsigned tg = og / nx;
            if (og + 1u == (tg + 1u) * nx) xb_add(&bar[XB_TOPGEN], 1u);
            else XB_SPIN(xb_ld(&bar[XB_TOPGEN]) == tg, bar);
            __builtin_amdgcn_fence(__ATOMIC_ACQUIRE, "agent");
            xb_add(&bar[XB_XGEN(b.x)], 1u);
            asm volatile("s_waitcnt vmcnt(0)" ::: "memory");
        } else {
            XB_SPIN(xb_ld(&bar[XB_XGEN(b.x)]) == gen, bar);
            __builtin_amdgcn_fence(__ATOMIC_ACQUIRE, "agent");
            asm volatile("s_waitcnt vmcnt(0)" ::: "memory");
        }
    }
    __syncthreads();
}

#ifdef PROBE_MASK
#define STAMP() do { if (blockIdx.x == PROBE_BLK && threadIdx.x == 0) { pst[pn] = __builtin_amdgcn_s_memrealtime(); } ++pn; } while (0)
#else
#define STAMP() do {} while (0)
#endif
#define GRID_SYNC() do { xcd_barrier(xbar); STAMP(); } while (0)
#define GRID_SYNC_CG() do { if (a.ws == nullptr) grid.sync(); xcd_barrier(xbar); STAMP(); } while (0)
__global__ void __launch_bounds__(NTHR, 2) fwd_megakernel(Args a) {
    extern __shared__ __attribute__((aligned(16))) unsigned char lds_raw[];
    cg::grid_group grid = cg::this_grid();
    LAS unsigned char* lds = (LAS unsigned char*)lds_raw;
    const int G = gridDim.x, tid = threadIdx.x;
    unsigned char* ws = a.ws;
    float* MOD = (float*)(ws + WS_MOD); const float* LB = (const float*)(ws + WS_LB);
    bfs* XB1 = (bfs*)a.out;
    bfs* X2 = (bfs*)(ws + WS_D + 264 * MiB);
    bfs* CB = (bfs*)(ws + WS_C); bfs* DB = (bfs*)(ws + WS_D); bfs* YB = (bfs*)(ws + WS_Y); bfs* EB = (bfs*)(ws + WS_E0);
    unsigned* ctl = (unsigned*)(ws + WS_CTL);
    { volatile LAS unsigned* st0 = (volatile LAS unsigned*)(lds + LDS_CTL_OFF + 16); if (tid == 0) { st0[0] = 0u; st0[1] = 0u; } __syncthreads(); }
    XcdBarrier xbar = xcd_barrier_post(ctl + 1024, (volatile LAS unsigned*)(lds + LDS_CTL_OFF + 16));
#ifdef PROBE_MASK
    volatile LAS unsigned long long* pst = (volatile LAS unsigned long long*)(lds + LDS_CTL_OFF + 64); int pn = 1;
    if (threadIdx.x == 0) { pst[0] = __builtin_amdgcn_s_memrealtime(); pst[40] = 0; }
#endif

    p0_phase(a, lds, G);
    GRID_SYNC_CG();
    { RowOp op{a.in[0], a.in[2], nullptr, nullptr, nullptr, nullptr, nullptr, 0, CB, a.in[6], MOD, 0, 1, 0, 0, 0}; row_phase(op, G); }
    GRID_SYNC();
    for (int l = 0; l < 2; ++l) {
        const float* MODL = MOD + (size_t)l * 9 * 6144;
        const bfs* Win = (const bfs*)(ws + (l ? WS_WIN1 : WS_WIN0)); const bfs* Wout = (const bfs*)(ws + (l ? WS_WOUT1 : WS_WOUT0));
        const bfs* Wgu = (const bfs*)(ws + (l ? WS_WGU1 : WS_WGU0)); const bfs* Wd = (const bfs*)(ws + (l ? WS_WD1 : WS_WD0));
        const int pitch = l ? NIN1 : PIN0;
        { pg8::Gemm g{CB, Win, ROWS, pitch, DM}; pg8::StaticOrder S; S.init(ROWS, pitch, G, (int)blockIdx.x);
          pg8::EpiStore E{DB, pitch, l, LB};
#ifndef NO_GEMM
          pg8::gemm_phase<pg8::EpiStore, pg8::StaticOrder, true, true>(lds, g, S, E);
#endif
 }
        GRID_SYNC();
        if (l == 0) {
            qk_phase(DB, a.in[14], a.in[15], G);
            GRID_SYNC();
            volatile LAS unsigned* lctl = (volatile LAS unsigned*)(lds + LDS_CTL_OFF);
            constexpr int N_GLA = 64, N_ATL = 1024, N_ATC = 64, N_ITEMS = N_GLA + N_ATL + N_ATC;
            for (;;) {
                if (tid == 0) lctl[0] = __hip_atomic_fetch_add(ctl + 64, 1u, __ATOMIC_RELAXED, __HIP_MEMORY_SCOPE_AGENT);
                __syncthreads();
                const int it = (int)lctl[0];
                __syncthreads();
                if (it >= N_ITEMS) break;
                if (it < N_GLA) {
                    const int b = it >> 3, h = (it >> 1) & 3, dir = it & 1;
#ifndef NO_GLA
                    scan::scan_unit<64, false, PIN0>(lds, DB, C_GQ + 64 * h, C_GK + 64 * h, C_GV + 128 * h, C_GZ + 16 * dir, a.in[11] + dir * 16 * 256 + 64 * h, a.in[12] + dir * 256 + 64 * h,
                                               dir ? EB : CB, dir ? 512 : DM, 128 * h, b, dir, 0.125f);
#endif
                } else if (it < N_GLA + N_ATL) {
                    const int u = it - N_GLA, gq = u & 3, qb = (u >> 2) & 15, kvh = (u >> 6) & 1, b = u >> 7, h = kvh * 4 + gq;
                    const size_t qrow = (size_t)RCTX + (size_t)b * SEQ + (size_t)qb * 256;
#ifndef NO_ATTN
                    attn_body::attn_unit<8>(b, 68, (const attn_body::bf16*)(DB + qrow * PIN0 + C_AQ + 64 * h), PIN0, (const attn_body::bf16*)(DB + C_AK + 64 * kvh), (const attn_body::bf16*)(DB + C_AV + 64 * kvh), PIN0,
                                            (attn_body::bf16*)(CB + qrow * DM + 512 + 64 * h), DM, (char*)lds_raw);
#endif
                } else {
                    const int u = it - N_GLA - N_ATL, h = u & 7, b = u >> 3, kvh = h >> 2;
                    const size_t qrow = (size_t)b * NCTX;
#ifndef NO_ATTN2
                    attn_body::attn_unit<8>(b, 4, (const attn_body::bf16*)(DB + qrow * PIN0 + C_AQ + 64 * h), PIN0, (const attn_body::bf16*)(DB + C_AK + 64 * kvh), (const attn_body::bf16*)(DB + C_AV + 64 * kvh), PIN0,
                                            (attn_body::bf16*)(CB + qrow * DM + 512 + 64 * h), DM, (char*)lds_raw);
#endif
                }
            }
            GRID_SYNC();
            readout_phase<512>(CB, DM, EB, 512, CB, DB, PIN0, C_GOG, a.in[13], 0, G);
        } else {
            if (G >= 256 && blockIdx.x >= 128) { p0_weights(a, lds, P0_NA, P0_NITEMS, ((int)blockIdx.x - 128) * NWAVES + (tid >> 6), (G - 128) * NWAVES); asm volatile("s_waitcnt vmcnt(0) lgkmcnt(0)" ::: "memory"); __syncthreads(); }
            for (int u = blockIdx.x; u < 128; u += G) {
                const int b = u >> 4, hh = (u >> 1) & 7, dir = u & 1;
#ifndef NO_HG
                scan::scan_unit<128, true, NIN1>(lds, DB, C_FQ + 128 * hh, C_FF + 1024 * dir + 128 * hh, C_FI + 128 * hh, 0, nullptr, nullptr, DB, NIN1, C_FF + 1024 * dir + 128 * hh, b, dir, 1.0f);
#endif
            }
            GRID_SYNC();
            readout_phase<1024>(DB + C_FF, NIN1, DB + C_FF + 1024, NIN1, CB, DB, NIN1, C_FOG, a.in[19], RCTX, G);
        }
        GRID_SYNC();
        const int row_lo = l ? RCTX : 0; const int Mg = ROWS - row_lo;
        { pg8::Gemm g{CB + (size_t)row_lo * DM, Wout, Mg, DM, DM}; pg8::StaticOrder S; S.init(Mg, DM, G, (int)blockIdx.x);
          pg8::EpiStore E{YB + (size_t)row_lo * DM, DM, 0, nullptr};
#ifndef NO_GEMM
          pg8::gemm_phase<pg8::EpiStore, pg8::StaticOrder, true, true>(lds, g, S, E);
#endif
 }
        GRID_SYNC();
        { RowOp op{l ? (const void*)(XB1 + (size_t)RCTX * DM) : (const void*)a.in[0], l ? (const void*)XB1 : (const void*)a.in[2], l ? (void*)X2 : (void*)(XB1 + (size_t)RCTX * DM), l ? (void*)nullptr : (void*)XB1,
                   YB, a.in[7] + l * DM, MODL, 2, CB, a.in[8] + l * DM, MODL, 3, 4, row_lo, l, 1}; row_phase(op, G); }
        GRID_SYNC();
        { pg8::Gemm g{CB + (size_t)row_lo * DM, Wgu, Mg, NGU, DM}; pg8::StaticOrder S; S.init(Mg, NGU, G, (int)blockIdx.x);
          pg8::EpiSwiGLU E{DB + (size_t)row_lo * DFF, DFF};
#ifndef NO_GEMM
          pg8::gemm_phase<pg8::EpiSwiGLU, pg8::StaticOrder, true, true>(lds, g, S, E);
#endif
 }
        GRID_SYNC();
        { pg8::Gemm g{DB + (size_t)row_lo * DFF, Wd, Mg, DM, DFF}; pg8::StaticOrder S; S.init(Mg, DM, G, (int)blockIdx.x);
          pg8::EpiStore E{YB + (size_t)row_lo * DM, DM, 0, nullptr};
#ifndef NO_GEMM
          pg8::gemm_phase<pg8::EpiStore, pg8::StaticOrder, true, true>(lds, g, S, E);
#endif
 }
        GRID_SYNC();
        if (l == 0) { RowOp op{XB1 + (size_t)RCTX * DM, XB1, XB1 + (size_t)RCTX * DM, XB1, YB, a.in[9], MODL, 5, CB, a.in[6] + DM, MOD + (size_t)9 * 6144, 0, 1, 0, 1, 1}; row_phase(op, G); GRID_SYNC(); }
        else { RowOp op{X2, nullptr, a.out, nullptr, YB, a.in[9] + DM, MODL, 5, nullptr, nullptr, nullptr, 0, 0, RCTX, 1, 0}; row_phase(op, G); }
    }
#ifdef PROBE_SYNCS
    for (int i = 0; i < PROBE_SYNCS; ++i) xcd_barrier(xbar);
#endif
#ifdef PROBE_MASK
    STAMP();
    if (blockIdx.x == PROBE_BLK && threadIdx.x == 0) {
        unsigned long long extra = 0;
        for (int i = 1; i < pn; ++i) if ((PROBE_MASK >> (i - 1)) & 1u) extra += pst[i] - pst[i - 1];
        extra += pst[40];
        const unsigned long long t0 = __builtin_amdgcn_s_memrealtime();
        while (__builtin_amdgcn_s_memrealtime() - t0 < extra) __builtin_amdgcn_s_sleep(8);
    }
#endif
}

extern "C" void kernel_launch(void* const* d_in, const int* in_sizes, int n_in, void* d_out, int out_size, void* d_ws, size_t ws_size, hipStream_t stream) {
    static int grid = 0;
    if (grid == 0) {
        if (n_in != 24 || ws_size < WS_END) { fprintf(stderr, "kernel_launch: unexpected inputs (n_in %d, ws %zu < %zu)\n", n_in, ws_size, (size_t)WS_END); grid = -1; return; }
        int dev = 0, cus = 0, per_cu = 0;
        hipGetDevice(&dev);
        hipDeviceGetAttribute(&cus, hipDeviceAttributeMultiprocessorCount, dev);
        if (hipFuncSetAttribute((const void*)fwd_megakernel, hipFuncAttributeMaxDynamicSharedMemorySize, LDS_BYTES) != hipSuccess) { fprintf(stderr, "kernel_launch: hipFuncSetAttribute failed\n"); grid = -1; return; }
        if (hipOccupancyMaxActiveBlocksPerMultiprocessor(&per_cu, (const void*)fwd_megakernel, NTHR, LDS_BYTES) != hipSuccess || per_cu < 1) { fprintf(stderr, "kernel_launch: occupancy query gave %d\n", per_cu); per_cu = 1; }
        (void)hipGetLastError();
        grid = cus * 1;
        fprintf(stderr, "kernel_launch: grid %d (cus %d, per_cu %d)\n", grid, cus, per_cu);
    }
    if (grid < 0) return;
    hipMemsetAsync((char*)d_ws + WS_CTL, 0, CTL_BYTES, stream);
    Args a{};
    for (int i = 0; i < 24; ++i) a.in[i] = (const float*)d_in[i];
    a.out = (float*)d_out; a.ws = (unsigned char*)d_ws;
    void* args[] = {&a};
    hipError_t e = hipLaunchCooperativeKernel((const void*)fwd_megakernel, dim3(grid), dim3(NTHR), args, LDS_BYTES, stream);
    if (e != hipSuccess) fprintf(stderr, "cooperative launch failed: %s (grid %d)\n", hipGetErrorString(e), grid);
}
```

```cpp
#include <hip/hip_runtime.h>
#include <hip/hip_cooperative_groups.h>
#include <hip/hip_bf16.h>
#include <cstdio>
#include <cstdint>
#include <cmath>
namespace cg = cooperative_groups;
__device__ __forceinline__ int tid_fresh() { int t = threadIdx.x; asm volatile("" : "+v"(t)); return t; }
namespace pg8 {
#define PG8_LAS __attribute__((address_space(3)))
typedef unsigned short bf16_t;
typedef short bf16x8 __attribute__((ext_vector_type(8)));
typedef float f32x4 __attribute__((ext_vector_type(4)));
typedef unsigned u32x4 __attribute__((ext_vector_type(4)));
constexpr int BM = 256, BK = 64, HALF = 128, HTB = HALF * BK * 2  , STAGE_BYTES = 8 * HTB, NXCD = 8, WGM = 8;

__host__ __device__ __forceinline__ int lds_byte(int r, int c) { const int st = (r >> 4) * 2 + (c >> 5), rr = r & 15, cc = c & 31, ob = rr * 64 + cc * 2; return st * 1024 + (ob ^ (((ob >> 9) & 1) << 5)); }
__host__ __device__ __forceinline__ void stage_rc(int b, int& R, int& C) { const int st = b / 1024, sb = b % 1024, swz = sb ^ (((sb >> 9) & 1) << 5); R = (st >> 1) * 16 + swz / 64; C = (st & 1) * 32 + (swz % 64) / 2; }
__host__ __device__ __forceinline__ int perm32(int rho) { const int n = rho >> 4, i = rho & 15; return 8 * (i >> 2) + 4 * n + (i & 3); }

struct Unit { int pm, pn; };
struct Gemm { const bf16_t* A; const bf16_t* Bt; int M, N, K; };

struct StaticOrder {
    int nM, nN, nwg, G, c;
    __host__ __device__ void init(int M, int N, int G_, int c_) { nM = M / BM; nN = N / BM; nwg = nM * nN; G = G_; c = c_; }
    __host__ __device__ bool next(int i, Unit& u) const {
        const long L = (long)i * G + c; if (L >= nwg) return false;
        int wgid = (int)L; { const int q = nwg / NXCD, r = nwg % NXCD, xcd = wgid % NXCD, off = wgid / NXCD; wgid = (xcd < r ? xcd * (q + 1) : r * (q + 1) + (xcd - r) * q) + off; }
        const int nig = WGM * nN, gid = wgid / nig, fm = gid * WGM, gsz = (nM - fm) < WGM ? (nM - fm) : WGM;
        u.pm = fm + ((wgid % nig) % gsz); u.pn = (wgid % nig) / gsz; return true;
    }
    __device__ __forceinline__ void a_ready(const Unit&) const {}
    __device__ __forceinline__ void done(const Unit&) const {}
};

typedef float f32x2_cv __attribute__((ext_vector_type(2))); typedef __bf16 bf16x2_cv __attribute__((ext_vector_type(2)));
__device__ __forceinline__ unsigned cvt_pk_bf16(float lo, float hi) { f32x2_cv v = {lo, hi}; bf16x2_cv b = __builtin_convertvector(v, bf16x2_cv); return __builtin_bit_cast(unsigned, b); }
typedef float f32x2 __attribute__((ext_vector_type(2)));
typedef float f32x2 __attribute__((ext_vector_type(2)));
struct EpiStore {
    static constexpr bool PERM = true, AFTER_DRAIN = false;
    bf16_t* O; int ldc; int mode; const float* lb;
    __device__ __forceinline__ void operator()(const f32x4 (&acc)[2][2][4][2], const Unit& u, int wr, int wc, int fr, int fq) const {
        const int row0 = u.pm * BM + wr * 64 + fr; const int col0 = u.pn * BM + wc * 32 + 8 * fq;
#pragma unroll
        for (int bj = 0; bj < 2; ++bj) {
            const int col = col0 + bj * HALF;
            int cls = 0; f32x4 l0 = (f32x4){0.f,0.f,0.f,0.f}, l1 = l0;
            if (mode == 1) { if (col < 1024) cls = 1; else if (col < 3072) { cls = 2; l0 = *(const f32x4*)(lb + col - 1024); l1 = *(const f32x4*)(lb + col - 1024 + 4); } }
#pragma unroll
            for (int ai = 0; ai < 2; ++ai)
#pragma unroll
                for (int m = 0; m < 4; ++m) {
                    f32x4 v0 = acc[ai][bj][m][0], v1 = acc[ai][bj][m][1];
                    if (cls == 1) {
#pragma unroll
                        for (int e = 0; e < 4; ++e) { v0[e] = v0[e] * __builtin_amdgcn_rcpf(1.f + __expf(-v0[e])); v1[e] = v1[e] * __builtin_amdgcn_rcpf(1.f + __expf(-v1[e])); }
                    } else if (cls == 2) {
#pragma unroll
                        for (int e = 0; e < 4; ++e) { const float s0 = __builtin_amdgcn_rcpf(1.f + __expf(v0[e])), s1 = __builtin_amdgcn_rcpf(1.f + __expf(v1[e]));
                            v0[e] = (1.f - l0[e]) * s0; v1[e] = (1.f - l1[e]) * s1; }
                    }
                    u32x4 w; w.x = cvt_pk_bf16(v0[0], v0[1]); w.y = cvt_pk_bf16(v0[2], v0[3]); w.z = cvt_pk_bf16(v1[0], v1[1]); w.w = cvt_pk_bf16(v1[2], v1[3]);
                    *(u32x4*)(O + (size_t)(row0 + ai * HALF + m * 16) * ldc + col) = w;
                }
        }
    }
};
struct EpiSwiGLU {
    static constexpr bool PERM = true, AFTER_DRAIN = false;
    bf16_t* O; int ldc;
    __device__ __forceinline__ void operator()(const f32x4 (&acc)[2][2][4][2], const Unit& u, int wr, int wc, int fr, int fq) const {
        const int row0 = u.pm * BM + wr * 64 + fr; const int col = u.pn * HALF + wc * 32 + 8 * fq;
#pragma unroll
        for (int ai = 0; ai < 2; ++ai)
#pragma unroll
            for (int m = 0; m < 4; ++m) {
                f32x4 g0 = acc[ai][0][m][0], g1 = acc[ai][0][m][1]; const f32x4 u0 = acc[ai][1][m][0], u1 = acc[ai][1][m][1];
#pragma unroll
                for (int e = 0; e < 4; ++e) { g0[e] = g0[e] * __builtin_amdgcn_rcpf(1.f + __expf(-g0[e])) * u0[e]; g1[e] = g1[e] * __builtin_amdgcn_rcpf(1.f + __expf(-g1[e])) * u1[e]; }
                u32x4 w; w.x = cvt_pk_bf16(g0[0], g0[1]); w.y = cvt_pk_bf16(g0[2], g0[3]); w.z = cvt_pk_bf16(g1[0], g1[1]); w.w = cvt_pk_bf16(g1[2], g1[3]);
                *(u32x4*)(O + (size_t)(row0 + ai * HALF + m * 16) * ldc + col) = w;
            }
    }
};
template <class Epi, class Sched, bool ALIGN_EPI = false, bool SP2 = false>
__device__ __forceinline__ void gemm_phase(PG8_LAS unsigned char* lds, const Gemm g, const Sched& S, const Epi& E) {
    const int tid = tid_fresh(), wid = __builtin_amdgcn_readfirstlane(tid >> 6), lane = tid & 63, wr = wid >> 2, wc = wid & 3, fr = lane & 15, fq = lane >> 4;
    const int K = g.K, nt = K / BK;
    unsigned voffA[2], voffB[2];
#pragma unroll
    for (int i = 0; i < 2; ++i) { int R, C; stage_rc(tid * 16 + i * 8192, R, C); const int Rb = Epi::PERM ? ((R & ~31) + perm32(R & 31)) : R;
        voffA[i] = (unsigned)(R * K + C) * 2u; voffB[i] = (unsigned)(Rb * K + C) * 2u; }
    const size_t kstep = (size_t)(BK * 2);
    const size_t hstep = (size_t)HALF * K * 2;
    const size_t tstep = 2 * hstep;
    const unsigned ldsw = (unsigned)wid * 1024u;
    const int aoff = lds_byte(wr * 64 + fr, fq * 8), boff = lds_byte(wc * 32 + fr, fq * 8);
#define PG8_SA(b, h) (((b) * 2 + (h)) * HTB)
#define PG8_SB(b, h) ((4 + (b) * 2 + (h)) * HTB)
#define PG8_STAGE(bufoff, gbase, voff) do { _Pragma("unroll") for (int _i = 0; _i < 2; ++_i) \
        __builtin_amdgcn_global_load_lds((const unsigned*)((const char*)(gbase) + (voff)[_i]), (PG8_LAS unsigned*)(lds + (bufoff) + ldsw + _i * 8192), 16, 0, 0); } while (0)
#define PG8_LDA(dst, b, h) do { _Pragma("unroll") for (int m = 0; m < 4; ++m) _Pragma("unroll") for (int k = 0; k < 2; ++k) dst[m][k] = *(const PG8_LAS bf16x8*)(lds + PG8_SA(b, h) + aoff + m * 2048 + k * 1024); } while (0)
#define PG8_LDB(dst, b, h) do { _Pragma("unroll") for (int n = 0; n < 2; ++n) _Pragma("unroll") for (int k = 0; k < 2; ++k) dst[n][k] = *(const PG8_LAS bf16x8*)(lds + PG8_SB(b, h) + boff + n * 2048 + k * 1024); } while (0)
#define PG8_MMA(ai, bj, At, Bt) do { __builtin_amdgcn_s_setprio(1); _Pragma("unroll") for (int m = 0; m < 4; ++m) _Pragma("unroll") for (int n = 0; n < 2; ++n) _Pragma("unroll") for (int k = 0; k < 2; ++k) \
        acc[ai][bj][m][n] = __builtin_amdgcn_mfma_f32_16x16x32_bf16(Bt[n][k], At[m][k], acc[ai][bj][m][n], 0, 0, 0); __builtin_amdgcn_s_setprio(0); } while (0)
#define PG8_WAIT_V(n) asm volatile("s_waitcnt vmcnt(" #n ")" ::: "memory")
#define PG8_WAIT_L(n) asm volatile("s_waitcnt lgkmcnt(" #n ")" ::: "memory")
#define PG8_BAR __builtin_amdgcn_s_barrier()
#define PG8_SCHED __builtin_amdgcn_sched_barrier(0)
    Unit cur, nxt; int ui = 0;
    if (!S.next(0, cur)) return;
    f32x4 acc[2][2][4][2];
#pragma unroll
    for (int a = 0; a < 2; ++a)
#pragma unroll
        for (int b = 0; b < 2; ++b)
#pragma unroll
            for (int m = 0; m < 4; ++m)
#pragma unroll
                for (int n = 0; n < 2; ++n) acc[a][b][m][n] = (f32x4){0.f, 0.f, 0.f, 0.f};
    bf16x8 At[4][2], B0[2][2], B1[2][2];
    const char* cA = (const char*)g.A + (size_t)cur.pm * tstep; const char* cB = (const char*)g.Bt + (size_t)cur.pn * tstep;
    S.a_ready(cur);
    if constexpr (SP2) {
        PG8_STAGE(PG8_SB(0, 0), cB, voffB); PG8_STAGE(PG8_SB(0, 1), cB + hstep, voffB); PG8_STAGE(PG8_SA(0, 0), cA, voffA); PG8_STAGE(PG8_SA(0, 1), cA + hstep, voffA);
        if (wr == 1) PG8_BAR;
        PG8_WAIT_V(2); PG8_BAR;
        PG8_STAGE(PG8_SB(1, 0), cB + kstep, voffB); PG8_STAGE(PG8_SA(1, 0), cA + kstep, voffA); PG8_STAGE(PG8_SB(1, 1), cB + hstep + kstep, voffB);
        PG8_WAIT_V(6); PG8_BAR;
    } else {
        PG8_STAGE(PG8_SB(0, 0), cB, voffB); PG8_STAGE(PG8_SA(0, 0), cA, voffA); PG8_STAGE(PG8_SB(0, 1), cB + hstep, voffB); PG8_STAGE(PG8_SA(0, 1), cA + hstep, voffA);
        if (wr == 1) PG8_BAR;
        PG8_WAIT_V(4); PG8_BAR;
        PG8_STAGE(PG8_SB(1, 0), cB + kstep, voffB); PG8_STAGE(PG8_SA(1, 0), cA + kstep, voffA); PG8_STAGE(PG8_SB(1, 1), cB + hstep + kstep, voffB);
        PG8_WAIT_V(6); PG8_BAR;
    }
    for (;;) {
        const bool has_next = S.next(ui + 1, nxt);
        const char* nA = has_next ? (const char*)g.A + (size_t)nxt.pm * tstep : cA; const char* nB = has_next ? (const char*)g.Bt + (size_t)nxt.pn * tstep : cB;
        for (int t = 0; t < nt; t += 2) {
            const bool last = (t == nt - 2);
            const char* a1 = cA + (size_t)(t + 1) * kstep;
            const char* a2 = last ? nA : cA + (size_t)(t + 2) * kstep; const char* b2 = last ? nB : cB + (size_t)(t + 2) * kstep;
            const char* a3 = a2 + kstep; const char* b3 = b2 + kstep;
            if (last && has_next) S.a_ready(nxt);
            if constexpr (SP2) {
            PG8_LDB(B0, 0, 0); PG8_LDB(B1, 0, 1); PG8_SCHED; PG8_LDA(At, 0, 0); PG8_STAGE(PG8_SA(1, 1), a1 + hstep, voffA);
            PG8_WAIT_V(8); PG8_WAIT_L(0); PG8_BAR; PG8_MMA(0, 0, At, B0); PG8_MMA(0, 1, At, B1); PG8_BAR; PG8_SCHED;
            PG8_LDA(At, 0, 1); PG8_STAGE(PG8_SB(0, 0), b2, voffB); PG8_STAGE(PG8_SB(0, 1), b2 + hstep, voffB); PG8_STAGE(PG8_SA(0, 0), a2, voffA);
            PG8_WAIT_V(8); PG8_WAIT_L(0); PG8_BAR; PG8_MMA(1, 0, At, B0); PG8_MMA(1, 1, At, B1); PG8_BAR; PG8_SCHED;
            PG8_LDB(B0, 1, 0); PG8_LDB(B1, 1, 1); PG8_SCHED; PG8_LDA(At, 1, 0); PG8_STAGE(PG8_SA(0, 1), a2 + hstep, voffA);
            PG8_WAIT_V(8); PG8_WAIT_L(0); PG8_BAR; PG8_MMA(0, 0, At, B0); PG8_MMA(0, 1, At, B1); PG8_BAR; PG8_SCHED;
            PG8_LDA(At, 1, 1); PG8_STAGE(PG8_SB(1, 0), b3, voffB); PG8_STAGE(PG8_SB(1, 1), b3 + hstep, voffB); PG8_STAGE(PG8_SA(1, 0), a3, voffA);
            PG8_WAIT_V(8); PG8_WAIT_L(0); PG8_BAR; PG8_MMA(1, 0, At, B0); PG8_MMA(1, 1, At, B1); PG8_BAR; PG8_SCHED;
            } else {
            PG8_LDB(B0, 0, 0); PG8_SCHED; PG8_LDA(At, 0, 0); PG8_STAGE(PG8_SA(1, 1), a1 + hstep, voffA);
            PG8_WAIT_L(8); PG8_BAR; PG8_WAIT_L(0); PG8_MMA(0, 0, At, B0); PG8_BAR; PG8_SCHED;
            PG8_LDB(B1, 0, 1); PG8_STAGE(PG8_SB(0, 0), b2, voffB);
            PG8_BAR; PG8_WAIT_L(0); PG8_MMA(0, 1, At, B1); PG8_BAR;
            PG8_LDA(At, 0, 1); PG8_STAGE(PG8_SA(0, 0), a2, voffA);
            PG8_BAR; PG8_WAIT_L(0); PG8_MMA(1, 0, At, B0); PG8_BAR; PG8_SCHED;
            PG8_STAGE(PG8_SB(0, 1), b2 + hstep, voffB);
            PG8_WAIT_V(6); PG8_BAR; PG8_MMA(1, 1, At, B1); PG8_BAR;
            PG8_LDB(B0, 1, 0); PG8_SCHED; PG8_LDA(At, 1, 0); PG8_STAGE(PG8_SA(0, 1), a2 + hstep, voffA);
            PG8_WAIT_L(8); PG8_BAR; PG8_WAIT_L(0); PG8_MMA(0, 0, At, B0); PG8_BAR; PG8_SCHED;
            PG8_LDB(B1, 1, 1); PG8_STAGE(PG8_SB(1, 0), b3, voffB);
            PG8_BAR; PG8_WAIT_L(0); PG8_MMA(0, 1, At, B1); PG8_BAR;
            PG8_LDA(At, 1, 1); PG8_STAGE(PG8_SA(1, 0), a3, voffA);
            PG8_BAR; PG8_WAIT_L(0); PG8_MMA(1, 0, At, B0); PG8_BAR; PG8_SCHED;
            PG8_STAGE(PG8_SB(1, 1), b3 + hstep, voffB);
            PG8_WAIT_V(6); PG8_BAR; PG8_MMA(1, 1, At, B1); PG8_BAR;
            }
        }
        if constexpr (ALIGN_EPI) { if (wr == 0) PG8_BAR; }
        if constexpr (!Epi::AFTER_DRAIN) { E(acc, cur, wr, wc, fr, fq); S.done(cur); }
        if (!has_next) break;
#pragma unroll
        for (int a = 0; a < 2; ++a)
#pragma unroll
            for (int b = 0; b < 2; ++b)
#pragma unroll
                for (int m = 0; m < 4; ++m)
#pragma unroll
                    for (int n = 0; n < 2; ++n) acc[a][b][m][n] = (f32x4){0.f, 0.f, 0.f, 0.f};
        cur = nxt; cA = nA; cB = nB; ++ui;
        if constexpr (ALIGN_EPI) { if (wr == 1) PG8_BAR; }
    }
    PG8_WAIT_V(0);
    if constexpr (!ALIGN_EPI) { if (wr == 0) PG8_BAR; }
    PG8_BAR;
    if constexpr (Epi::AFTER_DRAIN) { E.fused(acc, cur, wr, wc, fr, fq, lds, wid, lane); S.done(cur); }
#undef PG8_SA
#undef PG8_SB
#undef PG8_STAGE
#undef PG8_LDA
#undef PG8_LDB
#undef PG8_MMA
#undef PG8_WAIT_V
#undef PG8_WAIT_L
#undef PG8_BAR
#undef PG8_SCHED
}
}
#include <hip/hip_bf16.h>
#include <cmath>
namespace attn_body {
using bf16=__hip_bfloat16;
using bf16x8=__attribute__((ext_vector_type(8)))short;
using s16x4=__attribute__((ext_vector_type(4)))short;
using f32x16=__attribute__((ext_vector_type(16)))float;
using u32x4=__attribute__((ext_vector_type(4)))unsigned;
constexpr int D=64;
constexpr int NW=8,QBLK=32,QB=QBLK*NW,KVBLK=64;
__device__ __forceinline__ int crow(int r,int hi){return (r&3)+8*(r>>2)+4*hi;}
#define SBAR() __builtin_amdgcn_sched_barrier(0)
__device__ __forceinline__ void cmask(f32x16&p0,f32x16&p1,int jb,int qrel,int hi){
  const float NEG=-INFINITY; int kb=64*jb+4*hi;
  #pragma unroll
  for(int r=0;r<16;++r){int kv=kb+(r&3)+8*(r>>2); if(kv>qrel)p0[r]=NEG; if(kv+32>qrel)p1[r]=NEG;}
}

constexpr int NSLOT=3, SLOTB=8192;
constexpr int LDS_K=0, LDS_V=NSLOT*SLOTB, LDS_WS=2*NSLOT*SLOTB, LDS_OST=LDS_WS+NW*64*4, LDS_BYTES=LDS_OST+NW*4096;
constexpr float C2=0.125f*1.4426950408889634f;
__device__ __forceinline__ void glds16(const void*gsrc,unsigned lds_dst){unsigned keep;
  asm volatile("s_mov_b32 %0, m0\n\ts_mov_b32 m0, %2\n\ts_nop 0\n\tglobal_load_lds_dwordx4 %1, off\n\ts_mov_b32 m0, %0":"=&s"(keep):"v"(gsrc),"s"(lds_dst):"memory");}
__device__ __forceinline__ float max3f(float a,float b,float c){float r;asm("v_max3_f32 %0, %1, %2, %3":"=v"(r):"v"(a),"v"(b),"v"(c));return r;}
__device__ __forceinline__ float max2f(float a,float b){float r;asm("v_max_f32_e32 %0, %1, %2":"=v"(r):"v"(a),"v"(b));return r;}
__device__ __forceinline__ float fadd_s(float a,float b){float r;asm("v_add_f32_e32 %0, %1, %2":"=v"(r):"v"(a),"v"(b));return r;}
__device__ __forceinline__ float fsub_s(float a,float b){float r;asm("v_sub_f32_e32 %0, %1, %2":"=v"(r):"v"(a),"v"(b));return r;}
typedef float f32x2_t __attribute__((ext_vector_type(2))); typedef __bf16 bf16x2_t __attribute__((ext_vector_type(2)));
__device__ __forceinline__ unsigned cvtpk_s(float lo,float hi){f32x2_t v={lo,hi};bf16x2_t b=__builtin_convertvector(v,bf16x2_t);return __builtin_bit_cast(unsigned,b);}
#define WAIT_BAR(N) asm volatile("s_waitcnt vmcnt(" #N ") lgkmcnt(0)\n\ts_barrier":::"memory")

__device__ __forceinline__ void qkt(f32x16&p0,f32x16&p1,const char*Kslot,const bf16x8*qr,const f32x16&negm,int r32,int hi){
  const char*kb=Kslot+hi*1024+r32*16;
  #pragma unroll
  for(int d0=0;d0<4;++d0){
    const bf16x8 b0=*reinterpret_cast<const bf16x8*>(kb+d0*2048);
    const bf16x8 b1=*reinterpret_cast<const bf16x8*>(kb+d0*2048+512);
    if(d0==0){p0=__builtin_amdgcn_mfma_f32_32x32x16_bf16(b0,qr[0],negm,0,0,0);p1=__builtin_amdgcn_mfma_f32_32x32x16_bf16(b1,qr[0],negm,0,0,0);}
    else{p0=__builtin_amdgcn_mfma_f32_32x32x16_bf16(b0,qr[d0],p0,0,0,0);p1=__builtin_amdgcn_mfma_f32_32x32x16_bf16(b1,qr[d0],p1,0,0,0);}}
}
typedef __attribute__((address_space(3))) const char* lds_cptr;
typedef short v4i16_t __attribute__((ext_vector_type(4)));
__device__ __forceinline__ void kload8(bf16x8*kf,lds_cptr kp){
  kf[0]=*(const __attribute__((address_space(3))) bf16x8*)(kp);      kf[1]=*(const __attribute__((address_space(3))) bf16x8*)(kp+512);
  kf[2]=*(const __attribute__((address_space(3))) bf16x8*)(kp+2048); kf[3]=*(const __attribute__((address_space(3))) bf16x8*)(kp+2560);
  kf[4]=*(const __attribute__((address_space(3))) bf16x8*)(kp+4096); kf[5]=*(const __attribute__((address_space(3))) bf16x8*)(kp+4608);
  kf[6]=*(const __attribute__((address_space(3))) bf16x8*)(kp+6144); kf[7]=*(const __attribute__((address_space(3))) bf16x8*)(kp+6656);
}
__device__ __forceinline__ void kload2(bf16x8*kf,lds_cptr kp,int j){ kf[2*j]=*(const __attribute__((address_space(3))) bf16x8*)(kp+j*2048); kf[2*j+1]=*(const __attribute__((address_space(3))) bf16x8*)(kp+j*2048+512); }
__device__ __forceinline__ s16x4 vtr(lds_cptr p){ return __builtin_bit_cast(s16x4,__builtin_amdgcn_ds_read_tr16_b64_v4i16((__attribute__((address_space(3))) v4i16_t*)p)); }
__device__ __forceinline__ float rowmax(const f32x16&p0,const f32x16&p1){
  float a=max3f(p0[0],p0[1],p1[0]),b=max3f(p0[2],p0[3],p1[1]);a=max3f(a,p1[2],p1[3]);
  #pragma unroll
  for(int r=4;r<16;r+=4){a=max3f(a,p0[r],p0[r+1]);b=max3f(b,p0[r+2],p0[r+3]);a=max3f(a,p1[r],p1[r+1]);b=max3f(b,p1[r+2],p1[r+3]);}
  const float m=max2f(a,b);
  auto rr=__builtin_amdgcn_permlane32_swap(__float_as_uint(m),__float_as_uint(m),false,false);
  return max2f(__uint_as_float(rr[0]),__uint_as_float(rr[1]));
}
__device__ __forceinline__ void pv(f32x16*o,int vb,bf16x8 pa0,bf16x8 pa1,bf16x8 pa2,bf16x8 pa3){
  #pragma unroll
  for(int d0=0;d0<2;++d0){s16x4 lo[4],hi[4];
    #pragma unroll
    for(int ks=0;ks<4;++ks){
      asm volatile("ds_read_b64_tr_b16 %0,%1 offset:%c2":"=&v"(lo[ks]):"v"(vb),"i"(d0*4096+ks*1024):"memory");
      asm volatile("ds_read_b64_tr_b16 %0,%1 offset:%c2":"=&v"(hi[ks]):"v"(vb),"i"(d0*4096+ks*1024+512):"memory");}
    asm volatile("s_waitcnt lgkmcnt(0)":::"memory");SBAR();
    #define PK(k) (bf16x8){lo[k][0],lo[k][1],lo[k][2],lo[k][3],hi[k][0],hi[k][1],hi[k][2],hi[k][3]}
    o[d0]=__builtin_amdgcn_mfma_f32_32x32x16_bf16(pa0,PK(0),o[d0],0,0,0);
    o[d0]=__builtin_amdgcn_mfma_f32_32x32x16_bf16(pa1,PK(1),o[d0],0,0,0);
    o[d0]=__builtin_amdgcn_mfma_f32_32x32x16_bf16(pa2,PK(2),o[d0],0,0,0);
    o[d0]=__builtin_amdgcn_mfma_f32_32x32x16_bf16(pa3,PK(3),o[d0],0,0,0);
    #undef PK
  }
}

#ifndef ATTN_STORE16
#define ATTN_STORE16(p,v) (*(u32x4*)(p)=(v))
#endif
template<int THRL> __device__ __forceinline__ void attn_unit(const int b,const int NT,const bf16*Qw0,const int qpitch,const bf16*__restrict__ Kh,const bf16*__restrict__ Vh,const int kvpitch,bf16*Ow0,const int opitch,char*shm){
  const int tid=tid_fresh(),lane=tid&63,r32=lane&31,hi=lane>>5; const int wid=__builtin_amdgcn_readfirstlane(tid>>6);
  const bf16*Qw=Qw0+(long)(wid*QBLK)*qpitch;
  const unsigned lds0=(unsigned)(uintptr_t)shm;
  float*wsf=(float*)(shm+LDS_WS)+wid*64;
  const bf16*ksrc=Kh+(long)lane*kvpitch+wid*8;
  const bf16*vsrc=Vh+(long)(16*(wid&3)+(lane>>2))*kvpitch+(wid>>2)*32+(lane&3)*8;
  const unsigned kdst=lds0+LDS_K+wid*1024, vdst=lds0+LDS_V+wid*1024;
  #define KROW(t) ((long)((t)<4 ? b*256+64*(t) : 2048+b*4096+64*((t)-4)))
  #define DMA_K(t,slot) glds16(ksrc+KROW(t)*kvpitch,(unsigned)__builtin_amdgcn_readfirstlane(kdst+(slot)))
  #define DMA_V(t,slot) glds16(vsrc+KROW(t)*kvpitch,(unsigned)__builtin_amdgcn_readfirstlane(vdst+(slot)))
  const int vb0=(int)(lds0+LDS_V)+((lane>>4)&1)*32+(lane&3)*8+(4*hi+((lane&15)>>2))*64;
  const char*Kbase=shm+LDS_K; bf16x8 kf[8];
  const lds_cptr shm3=(lds_cptr)shm; const lds_cptr kp0=shm3+LDS_K+hi*1024+r32*16; const lds_cptr vp0=shm3+LDS_V+((lane>>4)&1)*32+(lane&3)*8+(4*hi+((lane&15)>>2))*64;
  DMA_K(0,0);DMA_V(0,0);DMA_K(1,SLOTB);
  bf16x8 qr[4];
  #pragma unroll
  for(int d0=0;d0<4;++d0)qr[d0]=*reinterpret_cast<const bf16x8*>(&Qw[(long)r32*qpitch+d0*16+hi*8]);
  float mhat=0.f,l_reg=0.f;f32x16 o[2];o[0]=f32x16{};o[1]=f32x16{};f32x16 negm=f32x16{};asm volatile("":"+v"(negm));
  #define CMASK(P0,P1,t) do{}while(0)
  bool resc=false;
  #define START(P0,P1) do{ const float rm=rowmax(P0,P1); resc=false; \
    { const float dl=rm; mhat=fadd_s(mhat,dl); \
      _Pragma("unroll") for(int r=0;r<16;++r){P0[r]=fsub_s(P0[r],dl);P1[r]=fsub_s(P1[r],dl);} \
      _Pragma("unroll") for(int r=0;r<16;++r)negm[r]=-mhat; asm volatile("":"+v"(negm)); } \
    _Pragma("unroll") for(int r=0;r<16;++r)P0[r]=__builtin_amdgcn_exp2f(P0[r]); }while(0)
  #define RESC() do{ if(resc){ asm volatile("s_waitcnt lgkmcnt(0)":::"memory"); \
      _Pragma("unroll") for(int d_=0;d_<2;++d_) _Pragma("unroll") for(int r=0;r<16;++r)o[d_][r]*=wsf[crow(r,hi)]; } }while(0)
  f32x16 pA0,pA1,pB0,pB1;
  int sl_prev=0,sl_cur=0,sl_next=SLOTB;
  #define ROT() do{sl_prev=sl_cur;sl_cur=sl_next;sl_next=(sl_next==(NSLOT-1)*SLOTB)?0:sl_next+SLOTB;}while(0)
  DMA_K(2,2*SLOTB);
  WAIT_BAR(3);
  qkt(pA0,pA1,Kbase,qr,negm,r32,hi);asm volatile("s_nop 15\n\ts_nop 7":"+v"(pA0),"+v"(pA1));CMASK(pA0,pA1,0);
  START(pA0,pA1);
  _Pragma("unroll") for(int r=0;r<16;++r)pA1[r]=__builtin_amdgcn_exp2f(pA1[r]);
  WAIT_BAR(0);
  DMA_K(3,0);DMA_V(1,SLOTB);
  ROT();
  kload8(kf,kp0+sl_cur);
  WAIT_BAR(2);
  s16x4 vlo[8],vhi[8]; u32x4 pw0,pw1,pw2,pw3;
  #define PKW(P,B) cvtpk_s(P[B],P[B+1])
  #define PAF(k) __builtin_bit_cast(bf16x8,pw##k)
  #define VFR(i) (bf16x8){vlo[i][0],vlo[i][1],vlo[i][2],vlo[i][3],vhi[i][0],vhi[i][1],vhi[i][2],vhi[i][3]}
  #define PIN(x) asm volatile("":"+v"(x))
  #define MX3(a,b,c) __builtin_fmaxf(__builtin_fmaxf((a),(b)),(c))
  #define GAPA(MF,A0,A1,A2,A3,W0,W1,PW) do{ MF; sacc+=A0; sacc+=A1; sacc+=A2; sacc+=A3; PIN(sacc); W0; W1; PIN(PW); SBAR(); }while(0)
  #define EX(v) __builtin_amdgcn_exp2f(v)
  #define GAPB(MF,X,B) do{ MF; X[B]=EX(X[B]); X[B+1]=EX(X[B+1]); X[B+2]=EX(X[B+2]); X[B+3]=EX(X[B+3]); PIN(X); SBAR(); }while(0)
  #define VRD(i) do{ vlo[i]=vtr(vp_+(((i)>>2)*4096+((i)&3)*1024)); vhi[i]=vtr(vp_+(((i)>>2)*4096+((i)&3)*1024+512)); }while(0)
  #define KRD(G,j) do{ if(G){ kload2(kf,kp0+sl_next,j); SBAR(); } }while(0)
  #define STEP(C0,C1,P0,P1,t,GK,GV,GL) do{ SBAR(); \
    const lds_cptr vp_=vp0+sl_prev; \
    VRD(0); SBAR(); float sacc=(P0[0]+P0[1]); \
    GAPA(C0=__builtin_amdgcn_mfma_f32_32x32x16_bf16(kf[0],qr[0],negm,0,0,0), P0[2],P0[3],P0[4],P0[5],     pw0[0]=PKW(P0,0), pw0[1]=PKW(P0,2), pw0); \
    VRD(4); SBAR(); GAPA(C1=__builtin_amdgcn_mfma_f32_32x32x16_bf16(kf[1],qr[0],negm,0,0,0), P0[6],P0[7],P0[8],P0[9],     pw0[2]=PKW(P0,4), pw0[3]=PKW(P0,6), pw0); \
    VRD(1); SBAR(); GAPA(C0=__builtin_amdgcn_mfma_f32_32x32x16_bf16(kf[2],qr[1],C0,0,0,0),   P0[10],P0[11],P0[12],P0[13], pw1[0]=PKW(P0,8), pw1[1]=PKW(P0,10), pw1); \
    VRD(5); SBAR(); GAPA(C1=__builtin_amdgcn_mfma_f32_32x32x16_bf16(kf[3],qr[1],C1,0,0,0),   P0[14],P0[15],P1[0],P1[1],   pw1[2]=PKW(P0,12),pw1[3]=PKW(P0,14), pw1); \
    VRD(2); SBAR(); GAPA(C0=__builtin_amdgcn_mfma_f32_32x32x16_bf16(kf[4],qr[2],C0,0,0,0),   P1[2],P1[3],P1[4],P1[5],     pw2[0]=PKW(P1,0), pw2[1]=PKW(P1,2), pw2); \
    VRD(6); SBAR(); GAPA(C1=__builtin_amdgcn_mfma_f32_32x32x16_bf16(kf[5],qr[2],C1,0,0,0),   P1[6],P1[7],P1[8],P1[9],     pw2[2]=PKW(P1,4), pw2[3]=PKW(P1,6), pw2); \
    VRD(3); SBAR(); GAPA(C0=__builtin_amdgcn_mfma_f32_32x32x16_bf16(kf[6],qr[3],C0,0,0,0),   P1[10],P1[11],P1[12],P1[13], pw3[0]=PKW(P1,8), pw3[1]=PKW(P1,10), pw3); \
    VRD(7); SBAR(); GAPA(C1=__builtin_amdgcn_mfma_f32_32x32x16_bf16(kf[7],qr[3],C1,0,0,0),   P1[14],P1[15],0.f,0.f,       pw3[2]=PKW(P1,12),pw3[3]=PKW(P1,14), pw3); \
    l_reg+=sacc; \
    if(GK){DMA_K((t)+3,sl_cur);} if(GV){DMA_V((t)+1,sl_next);} \
    CMASK(C0,C1,t); \
    { float a=MX3(C0[0],C0[1],C1[0]),b=MX3(C0[2],C0[3],C1[1]); a=MX3(a,C1[2],C1[3]); \
      _Pragma("unroll") for(int r=4;r<16;r+=4){a=MX3(a,C0[r],C0[r+1]);b=MX3(b,C0[r+2],C0[r+3]);a=MX3(a,C1[r],C1[r+1]);b=MX3(b,C1[r+2],C1[r+3]);} \
      float rm=__builtin_fmaxf(a,b); { auto rr=__builtin_amdgcn_permlane32_swap(__float_as_uint(rm),__float_as_uint(rm),false,false); rm=__builtin_fmaxf(__uint_as_float(rr[0]),__uint_as_float(rr[1])); } \
      resc=false; \
      if(__builtin_expect(__any(rm>(float)THRL),0)){ const float dl=__builtin_fmaxf(rm,0.f); mhat+=dl; \
        _Pragma("unroll") for(int r=0;r<16;++r){C0[r]-=dl;C1[r]-=dl;} \
        _Pragma("unroll") for(int r=0;r<16;++r)negm[r]=-mhat; asm volatile("":"+v"(negm)); \
        const float f=__builtin_amdgcn_exp2f(-dl); l_reg*=f; if(hi==0)wsf[r32]=f; resc=true; } } \
    SBAR(); \
    GAPB(o[0]=__builtin_amdgcn_mfma_f32_32x32x16_bf16(PAF(0),VFR(0),o[0],0,0,0), C0,0); \
    GAPB(o[1]=__builtin_amdgcn_mfma_f32_32x32x16_bf16(PAF(0),VFR(4),o[1],0,0,0), C0,4); \
    KRD(GL,0); GAPB(o[0]=__builtin_amdgcn_mfma_f32_32x32x16_bf16(PAF(1),VFR(1),o[0],0,0,0), C0,8); \
    KRD(GL,1); GAPB(o[1]=__builtin_amdgcn_mfma_f32_32x32x16_bf16(PAF(1),VFR(5),o[1],0,0,0), C0,12); \
    KRD(GL,2); GAPB(o[0]=__builtin_amdgcn_mfma_f32_32x32x16_bf16(PAF(2),VFR(2),o[0],0,0,0), C1,0); \
    KRD(GL,3); GAPB(o[1]=__builtin_amdgcn_mfma_f32_32x32x16_bf16(PAF(2),VFR(6),o[1],0,0,0), C1,4); \
    GAPB(o[0]=__builtin_amdgcn_mfma_f32_32x32x16_bf16(PAF(3),VFR(3),o[0],0,0,0), C1,8); \
    GAPB(o[1]=__builtin_amdgcn_mfma_f32_32x32x16_bf16(PAF(3),VFR(7),o[1],0,0,0), C1,12); \
    }while(0)
  int t=1;
  #undef CMASK
  #define CMASK(P0,P1,t) do{}while(0)
  for(;t+5<NT;t+=2){
    STEP(pB0,pB1,pA0,pA1,t,true,true,true);     WAIT_BAR(2); RESC(); ROT();
    STEP(pA0,pA1,pB0,pB1,t+1,true,true,true);   WAIT_BAR(2); RESC(); ROT();
  }
  #undef CMASK
  #define CMASK(P0,P1,t) do{}while(0)
  #define ENDW(tt) do{ if((tt)+3<NT){WAIT_BAR(2);} else if((tt)+2<NT){WAIT_BAR(1);} else {WAIT_BAR(0);} }while(0)
  for(;t+1<NT;t+=2){
    STEP(pB0,pB1,pA0,pA1,t,(t+3<NT),(t+1<NT),(t+1<NT));       ENDW(t);   RESC(); ROT();
    STEP(pA0,pA1,pB0,pB1,t+1,(t+4<NT),(t+2<NT),(t+2<NT));     ENDW(t+1); RESC(); ROT();
  }
  STEP(pB0,pB1,pA0,pA1,NT-1,false,false,false); RESC();
  { float sacc=pB0[0]+pB0[1]; _Pragma("unroll") for(int r=2;r<16;++r)sacc+=pB0[r]; _Pragma("unroll") for(int r=0;r<16;++r)sacc+=pB1[r]; l_reg+=sacc;
    pw0=(u32x4){PKW(pB0,0),PKW(pB0,2),PKW(pB0,4),PKW(pB0,6)};pw1=(u32x4){PKW(pB0,8),PKW(pB0,10),PKW(pB0,12),PKW(pB0,14)};pw2=(u32x4){PKW(pB1,0),PKW(pB1,2),PKW(pB1,4),PKW(pB1,6)};pw3=(u32x4){PKW(pB1,8),PKW(pB1,10),PKW(pB1,12),PKW(pB1,14)};
    SBAR(); pv(o,vb0+sl_cur,PAF(0),PAF(1),PAF(2),PAF(3)); }
  #undef PKW
  #undef PAF
  #undef VFR
  #undef PIN
  #undef MX3
  #undef GAPA
  #undef GAPB
  #undef EX
  #undef VRD
  #undef KRD
  #undef STEP
  #undef ENDW
  {auto rr=__builtin_amdgcn_permlane32_swap(__float_as_uint(l_reg),__float_as_uint(l_reg),false,false);l_reg=__uint_as_float(rr[0])+__uint_as_float(rr[1]);}
  if(hi==0)wsf[32+r32]=l_reg;asm volatile("s_waitcnt lgkmcnt(0)":::"memory");
  float rli[16];
  #pragma unroll
  for(int r=0;r<16;++r)rli[r]=__builtin_amdgcn_rcpf(wsf[32+crow(r,hi)]);
  bf16*Ow=Ow0+(long)(wid*QBLK)*opitch;
  { bf16*stg=(bf16*)(shm+LDS_OST)+wid*2048;
    #pragma unroll
    for(int r=0;r<16;++r){const int orow=crow(r,hi);
      #pragma unroll
      for(int d0=0;d0<2;++d0)stg[orow*64+d0*32+r32]=__float2bfloat16(o[d0][r]*rli[r]);}
    asm volatile("s_waitcnt lgkmcnt(0)":::"memory");
    #pragma unroll
    for(int i=0;i<4;++i){const int row=i*8+(lane>>3),ch=lane&7; const u32x4 v=*(const u32x4*)(stg+row*64+ch*8); ATTN_STORE16(Ow+(long)row*opitch+ch*8,v);} }
  asm volatile("s_waitcnt lgkmcnt(0)\n\ts_barrier":::"memory");
  #undef DMA_K
  #undef KROW
  #undef DMA_V
  #undef CMASK
  #undef START
  #undef RESC
  #undef ROT
}
constexpr int ATTN_LDS_BYTES=LDS_BYTES;
#undef SBAR
#undef WAIT_BAR
}
#define LAS __attribute__((address_space(3)))
typedef unsigned short bfs;
typedef float f32x4 __attribute__((ext_vector_type(4)));
typedef float f32x16 __attribute__((ext_vector_type(16)));
typedef unsigned u32x4 __attribute__((ext_vector_type(4)));
typedef unsigned u32x2 __attribute__((ext_vector_type(2)));
typedef short s16x8 __attribute__((ext_vector_type(8)));
constexpr int DM = 1024, NB = 8, SEQ = 4096, NCTX = 256;
constexpr int RCTX = NB * NCTX, RLAT = NB * SEQ, ROWS = RCTX + RLAT;
constexpr int DFF = 2816, NGU = 2 * DFF;
constexpr int NIN0 = 2336, PIN0 = 2560, NIN1 = 5120;
constexpr int C_GQ = 0, C_GK = 256, C_GV = 512, C_GOG = 1024, C_GZ = 1536, C_AQ = 1568, C_AK = 2080, C_AV = 2208;
constexpr int C_FQ = 0, C_FF = 1024, C_FI = 3072, C_FOG = 4096;
constexpr float RMS_EPS = 1e-6f;
constexpr size_t MiB = 1u << 20;
constexpr size_t WS_CTL = 0, CTL_BYTES = 65536;
constexpr size_t WS_MOD = 1 * MiB;
constexpr size_t WS_LB = WS_MOD + 512 * 1024;
constexpr size_t WS_XCTX = 2 * MiB;
constexpr size_t WS_WIN0 = 10 * MiB, WS_WOUT0 = 15 * MiB, WS_WGU0 = 17 * MiB, WS_WD0 = 28 * MiB;
constexpr size_t WS_WIN1 = 34 * MiB, WS_WOUT1 = 44 * MiB, WS_WGU1 = 46 * MiB, WS_WD1 = 57 * MiB;
constexpr size_t WS_C = 64 * MiB;
constexpr size_t WS_D = 132 * MiB;
constexpr size_t WS_Y = WS_D + 192 * MiB;
constexpr size_t WS_E0 = WS_D + 260 * MiB;
constexpr size_t WS_END = WS_D + 340 * MiB + 40 * MiB;
constexpr int OSPLIT = 16384;
static_assert(WS_WD1 + (size_t)DM * DFF * 2 <= WS_C && WS_C + (size_t)ROWS * DM * 2 <= WS_D && (size_t)ROWS * DFF * 2 <= 192 * MiB && (size_t)ROWS * NIN1 * 2 <= 340 * MiB, "ws map");
constexpr int LDS_CTL_OFF = 153600, LDS_BYTES = 154112;
constexpr int NWAVES = 8, NTHR = 512;

__device__ __forceinline__ float bf2f(unsigned h) { return __uint_as_float(h << 16); }
__device__ __forceinline__ unsigned f2bf(float f) { unsigned u = __float_as_uint(f); return (u + 0x7fffu + ((u >> 16) & 1u)) >> 16; }
__device__ __forceinline__ unsigned pk2(float lo, float hi) { return pg8::cvt_pk_bf16(lo, hi); }
__device__ __forceinline__ float dpp_ror(float x, const int n) {
    switch (n) {
    case 8: return __int_as_float(__builtin_amdgcn_update_dpp(0, __float_as_int(x), 0x128, 0xf, 0xf, false));
    case 4: return __int_as_float(__builtin_amdgcn_update_dpp(0, __float_as_int(x), 0x124, 0xf, 0xf, false));
    case 2: return __int_as_float(__builtin_amdgcn_update_dpp(0, __float_as_int(x), 0x122, 0xf, 0xf, false));
    default: return __int_as_float(__builtin_amdgcn_update_dpp(0, __float_as_int(x), 0x121, 0xf, 0xf, false));
    }
}
__device__ __forceinline__ float wave_sum(float v) {
    v += dpp_ror(v, 8); v += dpp_ror(v, 4); v += dpp_ror(v, 2); v += dpp_ror(v, 1);
    const int vi = __float_as_int(v);
    const float r0 = __int_as_float(__builtin_amdgcn_readlane(vi, 0)), r1 = __int_as_float(__builtin_amdgcn_readlane(vi, 16)), r2 = __int_as_float(__builtin_amdgcn_readlane(vi, 32)), r3 = __int_as_float(__builtin_amdgcn_readlane(vi, 48));
    return (r0 + r1) + (r2 + r3);
}
__device__ __forceinline__ float siluf(float x) { return x * __builtin_amdgcn_rcpf(1.f + __expf(-x)); }

struct Args { const float* in[24]; float* out; unsigned char* ws; };

__device__ __forceinline__ void p0_transpose_item(const float* W, int K, int N, bfs* WT, int k0, int n0, int drow0, LAS float* scr, int lane) {
    float tv[32];
#pragma unroll
    for (int i = 0; i < 32; ++i) tv[i] = W[(size_t)(k0 + 2 * i + (lane >> 5)) * N + n0 + (lane & 31)];
#pragma unroll
    for (int i = 0; i < 32; ++i) scr[(2 * i + (lane >> 5)) * 33 + (lane & 31)] = tv[i];
    asm volatile("s_waitcnt lgkmcnt(0)" ::: "memory");
    const int c = lane & 7;
#pragma unroll
    for (int j = 0; j < 4; ++j) { const int n = (lane >> 3) + 8 * j; const LAS float* s = scr + (8 * c) * 33 + n;
        u32x4 o; o.x = pk2(s[0 * 33], s[1 * 33]); o.y = pk2(s[2 * 33], s[3 * 33]); o.z = pk2(s[4 * 33], s[5 * 33]); o.w = pk2(s[6 * 33], s[7 * 33]);
        *(u32x4*)(WT + (size_t)(drow0 + n) * K + k0 + 8 * c) = o; }
    asm volatile("s_waitcnt lgkmcnt(0)" ::: "memory");
}
__device__ __forceinline__ bool p0_try(int& r, const float* W, int K, int N, bfs* WT, int mode  , LAS float* scr, int lane) {
    const int nblk = N / 32, cnt = (K / 64) * nblk;
    if (r >= cnt) { r -= cnt; return false; }
    const int kb = r / nblk, nb = r % nblk, n0 = 32 * nb;
    const int drow0 = mode == 0 ? n0 : ((n0 >> 7) * 256 + (n0 & 127) + (mode == 2 ? 128 : 0));
    p0_transpose_item(W, K, N, WT, 64 * kb, n0, drow0, scr, lane);
    return true;
}
constexpr int P0_I_IN0 = 16 * (NIN0 / 32), P0_I_SQ = 16 * 32, P0_I_G = 16 * (DFF / 32), P0_I_D = (DFF / 64) * 32, P0_I_IN1 = 16 * (NIN1 / 32);
constexpr int P0_NA = P0_I_IN0 + P0_I_SQ + 2 * P0_I_G + P0_I_D + P0_I_IN1, P0_NITEMS = P0_NA + P0_I_SQ + 2 * P0_I_G + P0_I_D;
__device__ __forceinline__ void p0_weights(const Args& a, LAS unsigned char* lds, int it_lo, int it_hi, int gw, int NGW) {
    const int tid = tid_fresh(), lane = tid & 63, wave = tid >> 6;
    unsigned char* ws = a.ws;
    LAS float* scr = (LAS float*)(lds + wave * 16384);
    for (int it = it_lo + gw; it < it_hi; it += NGW) {
        int r = it;
        if (p0_try(r, a.in[10], 1024, NIN0, (bfs*)(ws + WS_WIN0), 0, scr, lane)) continue;
        if (p0_try(r, a.in[16], 1024, 1024, (bfs*)(ws + WS_WOUT0), 0, scr, lane)) continue;
        if (p0_try(r, a.in[21], 1024, DFF, (bfs*)(ws + WS_WGU0), 1, scr, lane)) continue;
        if (p0_try(r, a.in[22], 1024, DFF, (bfs*)(ws + WS_WGU0), 2, scr, lane)) continue;
        if (p0_try(r, a.in[23], DFF, 1024, (bfs*)(ws + WS_WD0), 0, scr, lane)) continue;
        if (p0_try(r, a.in[17], 1024, NIN1, (bfs*)(ws + WS_WIN1), 0, scr, lane)) continue;
        if (p0_try(r, a.in[20], 1024, 1024, (bfs*)(ws + WS_WOUT1), 0, scr, lane)) continue;
        if (p0_try(r, a.in[21] + (size_t)1024 * DFF, 1024, DFF, (bfs*)(ws + WS_WGU1), 1, scr, lane)) continue;
        if (p0_try(r, a.in[22] + (size_t)1024 * DFF, 1024, DFF, (bfs*)(ws + WS_WGU1), 2, scr, lane)) continue;
        p0_try(r, a.in[23] + (size_t)DFF * 1024, DFF, 1024, (bfs*)(ws + WS_WD1), 0, scr, lane);
    }
}
__device__ __forceinline__ void p0_phase(const Args& a, LAS unsigned char* lds, int G) {
    const int tid = tid_fresh(), lane = tid & 63, wave = tid >> 6;
    unsigned char* ws = a.ws;
    {
        LAS float* sc = (LAS float*)lds;
        LAS float* red = (LAS float*)(lds + 40960);
        for (int i = tid; i < 9 * 1024; i += NTHR) { const float v = i < 8192 ? a.in[1][i] : a.in[3][i - 8192]; sc[i] = siluf(v); }
        __syncthreads();
        float* MOD = (float*)(ws + WS_MOD);
        for (int it = blockIdx.x; it < 192; it += G) {
            const int l = it / 96, cb = it % 96, col = cb * 64 + lane;
            const float* w = a.in[4] + (size_t)l * 1024 * 6144 + (size_t)(wave * 128) * 6144 + col;
            float acc[9];
#pragma unroll
            for (int bb = 0; bb < 9; ++bb) acc[bb] = 0.f;
            for (int k0 = 0; k0 < 128; k0 += 32) {
                float wv[32];
#pragma unroll
                for (int j = 0; j < 32; ++j) wv[j] = w[(size_t)(k0 + j) * 6144];
#pragma unroll
                for (int j = 0; j < 32; ++j)
#pragma unroll
                    for (int bb = 0; bb < 9; ++bb) acc[bb] += sc[bb * 1024 + wave * 128 + k0 + j] * wv[j];
            }
#pragma unroll
            for (int bb = 0; bb < 9; ++bb) red[(wave * 9 + bb) * 64 + lane] = acc[bb];
            __syncthreads();
            for (int i = tid; i < 9 * 64; i += NTHR) { float s = 0.f;
#pragma unroll
                for (int w8 = 0; w8 < 8; ++w8) s += red[w8 * 576 + i];
                const int bb = i / 64, c = cb * 64 + (i & 63);
                MOD[((size_t)l * 9 + bb) * 6144 + c] = s + a.in[5][l * 6144 + c]; }
            __syncthreads();
        }
        float* LB = (float*)(ws + WS_LB);
        for (int i = blockIdx.x * NTHR + tid; i < 2048; i += G * NTHR) { const int d = i >> 10, f = i & 1023; const float x0 = a.in[18][d * 2048 + f], x1 = a.in[18][d * 2048 + 1024 + f]; LB[i] = 1.f / (1.f + __expf(x0 - x1)); }
        { u32x4* z = (u32x4*)(ws + WS_WIN0 + (size_t)NIN0 * 1024 * 2); const int n16 = (PIN0 - NIN0) * 1024 * 2 / 16;
          for (int i = blockIdx.x * NTHR + tid; i < n16; i += G * NTHR) z[i] = (u32x4){0u, 0u, 0u, 0u}; }
        __syncthreads();
    }
    p0_weights(a, lds, 0, (G >= 256) ? P0_NA : P0_NITEMS, blockIdx.x * NWAVES + wave, G * NWAVES);
}

struct RowOp {
    const void* xin_lat; const void* xin_ctx; void* xout_lat; void* xout_ctx;
    const bfs* y; const float* gpost; const float* modg; int gate_idx;
    bfs* h; const float* gpre; const float* modh; int shift_idx, scale_idx;
    int row_lo; int xin_bf, xout_bf;
};
__device__ __forceinline__ void row_phase(const RowOp op, int G) {
    const int tid_ = tid_fresh(); const int lane = tid_ & 63, wave = tid_ >> 6;
    const int gw = blockIdx.x * NWAVES + wave, NGW = G * NWAVES;
    const int rpw = (ROWS - op.row_lo + NGW - 1) / NGW;
    const int r0 = op.row_lo + gw * rpw, r1 = (r0 + rpw < ROWS) ? r0 + rpw : ROWS;
    if (r0 >= r1) return;
    f32x4 gp[4], gpre[4], gt[4], sh[4], sc[4];
#pragma unroll
    for (int j = 0; j < 4; ++j) { const int c = 4 * lane + 256 * j; gp[j] = op.y ? *(const f32x4*)(op.gpost + c) : (f32x4){0.f, 0.f, 0.f, 0.f}; gpre[j] = op.h ? *(const f32x4*)(op.gpre + c) : (f32x4){0.f, 0.f, 0.f, 0.f};
        gt[j] = sh[j] = sc[j] = (f32x4){0.f, 0.f, 0.f, 0.f}; }
    int cur_bb = -1;
    f32x4 xn[4]; u32x2 xnb[4], yn[4];
#pragma unroll
    for (int j = 0; j < 4; ++j) { xn[j] = (f32x4){0.f, 0.f, 0.f, 0.f}; xnb[j] = (u32x2){0u, 0u}; }
#define ROW_LOAD(r) do { const bool ic_ = (r) < RCTX; const size_t ro_ = ic_ ? (size_t)(r) * DM : (size_t)((r) - RCTX) * DM; const void* xb_ = ic_ ? op.xin_ctx : op.xin_lat; \
        if (op.xin_bf) { _Pragma("unroll") for (int j = 0; j < 4; ++j) xnb[j] = *(const u32x2*)((const bfs*)xb_ + ro_ + 4 * lane + 256 * j); } \
        else { _Pragma("unroll") for (int j = 0; j < 4; ++j) xn[j] = *(const f32x4*)((const float*)xb_ + ro_ + 4 * lane + 256 * j); } \
        _Pragma("unroll") for (int j = 0; j < 4; ++j) yn[j] = op.y ? *(const u32x2*)(op.y + (size_t)(r) * DM + 4 * lane + 256 * j) : (u32x2){0u, 0u}; } while (0)
    ROW_LOAD(r0);
    for (int r = r0; r < r1; ++r) {
        const bool isctx = r < RCTX; const int bb = isctx ? 8 : (r - RCTX) / SEQ;
        f32x4 v[4]; u32x2 yw[4];
#pragma unroll
        for (int j = 0; j < 4; ++j) { v[j] = op.xin_bf ? (f32x4){bf2f(xnb[j].x & 0xffffu), bf2f(xnb[j].x >> 16), bf2f(xnb[j].y & 0xffffu), bf2f(xnb[j].y >> 16)} : xn[j]; yw[j] = yn[j]; }
        if (r + 1 < r1) ROW_LOAD(r + 1);
        if (bb != cur_bb) { cur_bb = bb;
#pragma unroll
            for (int j = 0; j < 4; ++j) { const int c = 4 * lane + 256 * j;
                if (op.y) gt[j] = *(const f32x4*)(op.modg + (size_t)bb * 6144 + op.gate_idx * 1024 + c);
                if (op.h) { sh[j] = *(const f32x4*)(op.modh + (size_t)bb * 6144 + op.shift_idx * 1024 + c); sc[j] = *(const f32x4*)(op.modh + (size_t)bb * 6144 + op.scale_idx * 1024 + c) + 1.f; } } }
        if (op.y) {
            f32x4 yv[4]; float ss = 0.f;
#pragma unroll
            for (int j = 0; j < 4; ++j) { yv[j] = (f32x4){bf2f(yw[j].x & 0xffffu), bf2f(yw[j].x >> 16), bf2f(yw[j].y & 0xffffu), bf2f(yw[j].y >> 16)};
                ss += (yv[j].x * yv[j].x + yv[j].y * yv[j].y) + (yv[j].z * yv[j].z + yv[j].w * yv[j].w); }
            const float rinv = rsqrtf(wave_sum(ss) * (1.f / DM) + RMS_EPS);
            void* xob = isctx ? op.xout_ctx : op.xout_lat; const size_t xoo = isctx ? (size_t)r * DM : (size_t)(r - RCTX) * DM;
#pragma unroll
            for (int j = 0; j < 4; ++j) { v[j] = v[j] + gt[j] * (yv[j] * rinv * gp[j]);
                if (xob) { if (op.xout_bf) { u32x2 wx; wx.x = pk2(v[j].x, v[j].y); wx.y = pk2(v[j].z, v[j].w); *(u32x2*)((bfs*)xob + xoo + 4 * lane + 256 * j) = wx;
                        v[j] = (f32x4){bf2f(wx.x & 0xffffu), bf2f(wx.x >> 16), bf2f(wx.y & 0xffffu), bf2f(wx.y >> 16)}; }
                    else *(f32x4*)((float*)xob + xoo + 4 * lane + 256 * j) = v[j]; } }
        }
        if (op.h) {
            float ss = 0.f;
#pragma unroll
            for (int j = 0; j < 4; ++j) ss += (v[j].x * v[j].x + v[j].y * v[j].y) + (v[j].z * v[j].z + v[j].w * v[j].w);
            const float rinv = rsqrtf(wave_sum(ss) * (1.f / DM) + RMS_EPS);
#pragma unroll
            for (int j = 0; j < 4; ++j) { const f32x4 hv = (v[j] * rinv * gpre[j]) * sc[j] + sh[j];
                u32x2 w; w.x = pk2(hv.x, hv.y); w.y = pk2(hv.z, hv.w);
                *(u32x2*)(op.h + (size_t)r * DM + 4 * lane + 256 * j) = w; }
        }
    }
#undef ROW_LOAD
}

__device__ __forceinline__ void qk_phase(bfs* proj, const float* gq, const float* gk, int G) {
    const int tid_ = tid_fresh(); const int lane = tid_ & 63, wave = tid_ >> 6;
    const int gw = blockIdx.x * NWAVES + wave, NGW = G * NWAVES;
    const int sub = lane & 7;
    float gqv[8], gkv[8], inv[4];
#pragma unroll
    for (int e = 0; e < 8; ++e) { gqv[e] = gq[8 * sub + e]; gkv[e] = gk[8 * sub + e]; }
#pragma unroll
    for (int p = 0; p < 4; ++p) { const int pi = (4 * sub + p) & 15; inv[p] = exp2f(-(float)(2 * pi) * (13.287712379549449f / 32.f)); }
    const int rpw = (ROWS + NGW - 1) / NGW; const int r0 = gw * rpw, r1 = (r0 + rpw < ROWS) ? r0 + rpw : ROWS;
    u32x4 qn = (u32x4){0u, 0u, 0u, 0u}, kn = qn;
    if (r0 < r1) { qn = *(const u32x4*)(proj + (size_t)r0 * PIN0 + C_AQ + 8 * lane); kn = *(const u32x4*)(proj + (size_t)r0 * PIN0 + C_AK + 8 * (lane & 15)); }
    for (int r = r0; r < r1; ++r) {
        const bool lat = r >= RCTX; const int t = lat ? (r - RCTX) % SEQ : 0;
        const float pos = (sub < 4) ? (float)(t >> 6) : (float)(t & 63);
        float cs[4], sn[4];
#pragma unroll
        for (int p = 0; p < 4; ++p) { if (lat) { const float ang = pos * inv[p]; cs[p] = __cosf(ang); sn[p] = __sinf(ang);     } else { cs[p] = 1.f; sn[p] = 0.f; } }
        bfs* qp = proj + (size_t)r * PIN0 + C_AQ + 8 * lane;
        bfs* kp = proj + (size_t)r * PIN0 + C_AK + 8 * (lane & 15);
        const u32x4 qw = qn; const u32x4 kw = kn;
        if (r + 1 < r1) { qn = *(const u32x4*)(qp + PIN0); kn = *(const u32x4*)(kp + PIN0); }
        float q[8], k[8]; float sq = 0.f, sk = 0.f;
#pragma unroll
        for (int e = 0; e < 4; ++e) { q[2 * e] = bf2f(qw[e] & 0xffffu); q[2 * e + 1] = bf2f(qw[e] >> 16); k[2 * e] = bf2f(kw[e] & 0xffffu); k[2 * e + 1] = bf2f(kw[e] >> 16); }
#pragma unroll
        for (int e = 0; e < 8; ++e) { sq += q[e] * q[e]; sk += k[e] * k[e]; }
#pragma unroll
        for (int o = 1; o < 8; o <<= 1) { sq += __shfl_xor(sq, o); sk += __shfl_xor(sk, o); }
        const float rq = rsqrtf(sq * (1.f / 64.f) + RMS_EPS) , rk = rsqrtf(sk * (1.f / 64.f) + RMS_EPS);
        const float C2 = 0.125f * 1.4426950408889634f;
        u32x4 qo, ko;
#pragma unroll
        for (int p = 0; p < 4; ++p) {
            const float q0 = q[2 * p] * rq * gqv[2 * p], q1 = q[2 * p + 1] * rq * gqv[2 * p + 1];
            const float k0 = k[2 * p] * rk * gkv[2 * p], k1 = k[2 * p + 1] * rk * gkv[2 * p + 1];
            qo[p] = pk2((q0 * cs[p] - q1 * sn[p]) * C2, (q0 * sn[p] + q1 * cs[p]) * C2);
            ko[p] = pk2(k0 * cs[p] - k1 * sn[p], k0 * sn[p] + k1 * cs[p]);
        }
        *(u32x4*)qp = qo;
        if (lane < 16) *(u32x4*)kp = ko;
    }
}

template <int NCOL> __device__ __forceinline__ void readout_phase(const bfs* of, int pf, const bfs* ob, int pb, const bfs* ob2, int osplit, bfs* out, const bfs* proj, int pitch, int ogcol, const float* gain, int row_lo, int G) {
    constexpr int PL = NCOL / 64;
    constexpr int LPH = 128 / PL;
    const int tid_ = tid_fresh(); const int lane = tid_ & 63, wave = tid_ >> 6;
    const int gw = blockIdx.x * NWAVES + wave, NGW = G * NWAVES;
    float gv[PL];
#pragma unroll
    for (int e = 0; e < PL; ++e) gv[e] = gain[(PL * lane + e) & 127];
    const int rpw = (ROWS - row_lo + NGW - 1) / NGW; const int r0 = row_lo + gw * rpw, r1 = (r0 + rpw < ROWS) ? r0 + rpw : ROWS;
    u32x4 fn[PL / 8], bn[PL / 8], gn[PL / 8];
#define RO_LOAD(r) do { _Pragma("unroll") for (int c = 0; c < PL / 8; ++c) { fn[c] = *(const u32x4*)(of + (size_t)(r) * pf + PL * lane + 8 * c); bn[c] = *(const u32x4*)(((r) >= osplit ? ob2 : ob) + (size_t)(r) * pb + PL * lane + 8 * c); gn[c] = *(const u32x4*)(proj + (size_t)(r) * pitch + ogcol + PL * lane + 8 * c); } } while (0)
    if (r0 < r1) RO_LOAD(r0);
    for (int r = r0; r < r1; ++r) {
        float x[PL], g[PL]; float ss = 0.f;
#pragma unroll
        for (int c = 0; c < PL / 8; ++c) { const u32x4 fw = fn[c], bw = bn[c], gw4 = gn[c];
#pragma unroll
            for (int e = 0; e < 4; ++e) { x[8 * c + 2 * e] = bf2f(fw[e] & 0xffffu) + bf2f(bw[e] & 0xffffu); x[8 * c + 2 * e + 1] = bf2f(fw[e] >> 16) + bf2f(bw[e] >> 16); g[8 * c + 2 * e] = bf2f(gw4[e] & 0xffffu); g[8 * c + 2 * e + 1] = bf2f(gw4[e] >> 16); } }
        if (r + 1 < r1) RO_LOAD(r + 1);
#pragma unroll
        for (int e = 0; e < PL; ++e) ss += x[e] * x[e];
#pragma unroll
        for (int of2 = 1; of2 < LPH; of2 <<= 1) ss += __shfl_xor(ss, of2);
        const float rinv = rsqrtf(ss * (1.f / 128.f) + RMS_EPS);
#pragma unroll
        for (int c = 0; c < PL / 8; ++c) { u32x4 wv;
#pragma unroll
            for (int e = 0; e < 4; ++e) wv[e] = pk2(x[8 * c + 2 * e] * rinv * gv[8 * c + 2 * e] * siluf(g[8 * c + 2 * e]), x[8 * c + 2 * e + 1] * rinv * gv[8 * c + 2 * e + 1] * siluf(g[8 * c + 2 * e + 1]));
            *(u32x4*)(out + (size_t)r * DM + PL * lane + 8 * c) = wv; }
    }
#undef RO_LOAD
}

namespace scan {
#define SC_LBAR() asm volatile("s_waitcnt lgkmcnt(0)\n\ts_barrier" ::: "memory")
template <int PB> __device__ __forceinline__ int swz(int row, int chunk) {
    if (PB == 256) return row * 256 + ((chunk ^ (row & 15) ^ ((row >> 4) & 3)) << 4);
    else return row * 128 + ((chunk ^ (((row >> 1) ^ (row >> 4)) & 7)) << 4);
}
__device__ __forceinline__ int crow(int r, int hi) { return (r & 3) + 8 * (r >> 2) + 4 * hi; }
__device__ __forceinline__ float dpp_shr(float x, float old, const int n) {
    switch (n) {
    case 1: return __int_as_float(__builtin_amdgcn_update_dpp(__float_as_int(old), __float_as_int(x), 0x111, 0xf, 0xf, false));
    case 2: return __int_as_float(__builtin_amdgcn_update_dpp(__float_as_int(old), __float_as_int(x), 0x112, 0xf, 0xf, false));
    case 4: return __int_as_float(__builtin_amdgcn_update_dpp(__float_as_int(old), __float_as_int(x), 0x114, 0xf, 0xf, false));
    default: return __int_as_float(__builtin_amdgcn_update_dpp(__float_as_int(old), __float_as_int(x), 0x118, 0xf, 0xf, false));
    }
}
template <int DK, bool HG, int NV> struct Map {
    static constexpr int PQ = DK * 2;
    static constexpr int O_QG = 0, O_KG = 64 * PQ, O_KGT = 2 * 64 * PQ, O_VT = O_KGT + DK * 128, O_ST = O_VT + NV * 128, O_EGL = O_ST + NV * PQ, O_VR = O_EGL + DK * 4, O_ZB = O_VR + 64 * NV * 2, O_FB = O_ZB + 2048, O_END = HG ? O_ZB : O_FB + 16384;
};
template <int DK, bool HG, int pitch, int NV>
__device__ __forceinline__ void scan_unit(LAS unsigned char* L, const bfs* __restrict__ proj, const int qcol, const int kcol, const int vcol, const int zcol,
                                          const float* __restrict__ wg, const float* __restrict__ bg, bfs* O, bfs* O2, const int osplit, const int opitch, const int ocol, const int b, const int dir, const float qscale) {
    typedef Map<DK, HG, NV> MP;
    constexpr int PQ = MP::PQ, NTG = DK * 4, NVB = NV / 32, NST = (DK / 32) * NVB / 8, WPM = NVB / NST, NPV = NV / 64, VCPR = NV / 8, VPB = NV * 2;
    const int tid = tid_fresh(), lane = tid & 63, r32 = lane & 31, hi = lane >> 5, w = tid >> 6;
    const int c4 = tid >> 4, sg = tid & 15;
    const bool gact = tid < NTG;
    const int mk = w / WPM;
    const int nv0 = (w % WPM) * NST;
    const bool oact = w < 2 * NVB;
    f32x16 S[NST];
#pragma unroll
    for (int i = 0; i < NST; ++i)
#pragma unroll
        for (int r = 0; r < 16; ++r) S[i][r] = 0.f;
    s16x8 wgB = (s16x8){0, 0, 0, 0, 0, 0, 0, 0}; float bias = 0.f;
    if (!HG) {
        const int col = 32 * (w & 1) + r32;
#pragma unroll
        for (int j = 0; j < 8; ++j) wgB[j] = (short)f2bf(wg[(8 * hi + j) * 256 + col]);
        bias = bg[col];
    }
    constexpr int NQ = DK / 64, CPR = DK / 8;
    u32x4 pqA[NQ], pkA[NQ], pvA[NPV]; u32x4 pzA = (u32x4){0u, 0u, 0u, 0u};
#define SC_BASE(s) ({ const int g_ = dir ? ((s) < 4 ? 3 - (s) : 71 - (s)) : (s); (long)(g_ < 4 ? b * 256 + 64 * g_ : 2048 + b * 4096 + 64 * (g_ - 4)); })
#define SC_GROW(base, i) ((base) + (dir ? 63 - (i) : (i)))
#define SC_ISSUE(s) do { const long nb_ = SC_BASE(s); \
        _Pragma("unroll") for (int i = 0; i < NQ; ++i) { const int id = tid + 512 * i, row = id / CPR, c = id % CPR; const bfs* rp = proj + (size_t)SC_GROW(nb_, row) * pitch + 8 * c; pq[i] = *(const u32x4*)(rp + qcol); pk[i] = *(const u32x4*)(rp + kcol); } \
        _Pragma("unroll") for (int i = 0; i < NPV; ++i) { const int id = tid + 512 * i, row = id / VCPR, c = id % VCPR; pv[i] = *(const u32x4*)(proj + (size_t)SC_GROW(nb_, row) * pitch + vcol + 8 * c); } \
        if (!HG) { if (tid < 128) pz = *(const u32x4*)(proj + (size_t)SC_GROW(nb_, tid >> 1) * pitch + zcol + 8 * (tid & 1)); } } while (0)
    { auto& pq = pqA; auto& pk = pkA; auto& pv = pvA; auto& pz = pzA; SC_ISSUE(0); }
    unsigned ost[8]; long pbase = 0;
#pragma unroll
    for (int i = 0; i < 8; ++i) ost[i] = 0u;
#define SC_STORE(bs) do { const int nvt_ = w >> 1, mi_ = w & 1; const int lrow_ = dir ? 63 - (32 * mi_ + 4 * hi) : (32 * mi_ + 4 * hi); const long ostep_ = dir ? -(long)opitch : (long)opitch; \
        bfs* ob_ = (((bs) >= osplit) ? O2 : O) + (size_t)((bs) + lrow_) * opitch + ocol + 32 * nvt_ + r32; \
        _Pragma("unroll") for (int r = 0; r < 16; ++r) ob_[((r & 3) + 8 * (r >> 2)) * ostep_] = (bfs)((r & 1) ? (ost[r >> 1] >> 16) : (ost[r >> 1] & 0xffffu)); } while (0)
    auto body = [&](const int s, u32x4 (&pq)[NQ], u32x4 (&pk)[NQ], u32x4 (&pv)[NPV], u32x4& pz) __attribute__((always_inline)) {
        const long base = SC_BASE(s);
#ifdef PROBE_SEG
        unsigned long long tseg0 = __builtin_amdgcn_s_memrealtime();
#define SEG_MARK(k) do { const unsigned long long tn_ = __builtin_amdgcn_s_memrealtime(); if (HG && blockIdx.x == PROBE_BLK && threadIdx.x == 0 && (PROBE_SEG == (k) || PROBE_SEG == 0)) { volatile LAS unsigned long long* pa_ = (volatile LAS unsigned long long*)(L + 153600 + 64 + 40 * 8); pa_[0] += tn_ - tseg0; } tseg0 = tn_; } while (0)
#else
#define SEG_MARK(k) do {} while (0)
#endif
#pragma unroll
        for (int ti = 0; ti < NST; ++ti) { const int v = 32 * (nv0 + ti) + r32;
#pragma unroll
            for (int r4 = 0; r4 < 4; ++r4) { const int k0 = 32 * mk + 8 * r4 + 4 * hi; u32x2 wv; wv.x = pk2(S[ti][4 * r4], S[ti][4 * r4 + 1]); wv.y = pk2(S[ti][4 * r4 + 2], S[ti][4 * r4 + 3]);
                *(LAS u32x2*)(L + MP::O_ST + swz<PQ>(v, k0 >> 3) + (k0 & 7) * 2) = wv; } }
        if (s > 0 && oact) SC_STORE(pbase);
        pbase = base;
#pragma unroll
        for (int i = 0; i < NQ; ++i) { const int id = tid + 512 * i, row = id / CPR, c = id % CPR;
            *(LAS u32x4*)(L + MP::O_QG + swz<PQ>(row, c)) = pq[i]; *(LAS u32x4*)(L + MP::O_KG + swz<PQ>(row, c)) = pk[i]; }
#pragma unroll
        for (int i = 0; i < NPV; ++i) { const int id = tid + 512 * i, row = id / VCPR, c = id % VCPR; *(LAS u32x4*)(L + MP::O_VR + swz<VPB>(row, c)) = pv[i]; }
        if (!HG) { if (tid < 128) *(LAS u32x4*)(L + MP::O_ZB + (tid >> 1) * 32 + (tid & 1) * 16) = pz; }
        if (s + 1 < 68) SC_ISSUE(s + 1);
        SC_LBAR();
        u32x2 q2[4], k2[4];
#pragma unroll
        for (int r = 0; r < 4; ++r) { q2[r] = (u32x2){0u, 0u}; k2[r] = (u32x2){0u, 0u}; }
        if (gact) {
#pragma unroll
            for (int r = 0; r < 4; ++r) { const int off = swz<PQ>(4 * sg + r, c4 >> 1) + (c4 & 1) * 8; q2[r] = *(const LAS u32x2*)(L + MP::O_QG + off); k2[r] = *(const LAS u32x2*)(L + MP::O_KG + off); } }
        if (c4 < NV / 4) {
            u32x2 v2[4];
#pragma unroll
            for (int r = 0; r < 4; ++r) v2[r] = *(const LAS u32x2*)(L + MP::O_VR + swz<VPB>(4 * sg + r, c4 >> 1) + (c4 & 1) * 8);
            u32x2 t0, t1, t2, t3;
            t0.x = (v2[0].x & 0xffffu) | (v2[1].x << 16); t0.y = (v2[2].x & 0xffffu) | (v2[3].x << 16);
            t1.x = (v2[0].x >> 16) | (v2[1].x & 0xffff0000u); t1.y = (v2[2].x >> 16) | (v2[3].x & 0xffff0000u);
            t2.x = (v2[0].y & 0xffffu) | (v2[1].y << 16); t2.y = (v2[2].y & 0xffffu) | (v2[3].y << 16);
            t3.x = (v2[0].y >> 16) | (v2[1].y & 0xffff0000u); t3.y = (v2[2].y >> 16) | (v2[3].y & 0xffff0000u);
            const int vo = (sg & 1) * 8;
            *(LAS u32x2*)(L + MP::O_VT + swz<128>(4 * c4 + 0, sg >> 1) + vo) = t0; *(LAS u32x2*)(L + MP::O_VT + swz<128>(4 * c4 + 1, sg >> 1) + vo) = t1;
            *(LAS u32x2*)(L + MP::O_VT + swz<128>(4 * c4 + 2, sg >> 1) + vo) = t2; *(LAS u32x2*)(L + MP::O_VT + swz<128>(4 * c4 + 3, sg >> 1) + vo) = t3; }
        float qv[4][4], kv[4][4];
#pragma unroll
        for (int r = 0; r < 4; ++r) { qv[r][0] = bf2f(q2[r].x & 0xffffu); qv[r][1] = bf2f(q2[r].x >> 16); qv[r][2] = bf2f(q2[r].y & 0xffffu); qv[r][3] = bf2f(q2[r].y >> 16);
            kv[r][0] = bf2f(k2[r].x & 0xffffu); kv[r][1] = bf2f(k2[r].x >> 16); kv[r][2] = bf2f(k2[r].y & 0xffffu); kv[r][3] = bf2f(k2[r].y >> 16); }
        if (!HG) {
            if (w < 4) { const int mi = w >> 1, nj = w & 1;
                const s16x8 za = *(const LAS s16x8*)(L + MP::O_ZB + (32 * mi + r32) * 32 + hi * 16);
                f32x16 lg;
#pragma unroll
                for (int r = 0; r < 16; ++r) lg[r] = 0.f;
                lg = __builtin_amdgcn_mfma_f32_32x32x16_bf16(za, wgB, lg, 0, 0, 0);
#pragma unroll
                for (int r = 0; r < 16; ++r) { const float x = lg[r] + bias; const float ls = fminf(x, 0.f) - __logf(1.f + __expf(-fabsf(x)));
                    ((LAS float*)(L + MP::O_FB))[(32 * mi + crow(r, hi)) * 64 + 32 * nj + r32] = __expf(ls * (1.f / 16.f)); } }
            SC_LBAR();
        }
        if (gact) {
            float p[4][4];
#pragma unroll
            for (int r = 0; r < 4; ++r) {
                f32x4 f;
                if (HG) f = (f32x4){1.f - kv[r][0], 1.f - kv[r][1], 1.f - kv[r][2], 1.f - kv[r][3]};
                else f = *(const LAS f32x4*)(L + MP::O_FB + ((4 * sg + r) * 64 + 4 * c4) * 4);
#pragma unroll
                for (int e = 0; e < 4; ++e) p[r][e] = r ? p[r - 1][e] * f[e] : f[e]; }
            float ex[4];
#pragma unroll
            for (int e = 0; e < 4; ++e) { float x = p[3][e];
                x *= dpp_shr(x, 1.f, 1); x *= dpp_shr(x, 1.f, 2); x *= dpp_shr(x, 1.f, 4); x *= dpp_shr(x, 1.f, 8);
                ex[e] = dpp_shr(x, 1.f, 1);
                if (sg == 15) ((LAS float*)(L + MP::O_EGL))[4 * c4 + e] = x; }
            float kg[4][4];
#pragma unroll
            for (int r = 0; r < 4; ++r) { const int row = 4 * sg + r; float qg[4];
#pragma unroll
                for (int e = 0; e < 4; ++e) { const float eG = ex[e] * p[r][e]; qg[e] = qv[r][e] * qscale * eG; kg[r][e] = kv[r][e] * __builtin_amdgcn_rcpf(eG); }
                u32x2 wq, wk; wq.x = pk2(qg[0], qg[1]); wq.y = pk2(qg[2], qg[3]); wk.x = pk2(kg[r][0], kg[r][1]); wk.y = pk2(kg[r][2], kg[r][3]);
                const int off = swz<PQ>(row, c4 >> 1) + (c4 & 1) * 8;
                *(LAS u32x2*)(L + MP::O_QG + off) = wq; *(LAS u32x2*)(L + MP::O_KG + off) = wk; }
#pragma unroll
            for (int e = 0; e < 4; ++e) { u32x2 wt; wt.x = pk2(kg[0][e], kg[1][e]); wt.y = pk2(kg[2][e], kg[3][e]);
                *(LAS u32x2*)(L + MP::O_KGT + swz<128>(4 * c4 + e, sg >> 1) + (sg & 1) * 8) = wt; }
        }
        SC_LBAR();
        SEG_MARK(1);
        f32x16 acc;
#pragma unroll
        for (int r = 0; r < 16; ++r) acc[r] = 0.f;
        { const int mi = (w >> 1) & 1, nj = w & 1;
          if (w < 4 && nj <= mi) {
#pragma unroll
            for (int kk = 0; kk < DK / 16; ++kk) { const s16x8 ka = *(const LAS s16x8*)(L + MP::O_KG + swz<PQ>(32 * nj + r32, 2 * kk + hi)); const s16x8 bq = *(const LAS s16x8*)(L + MP::O_QG + swz<PQ>(32 * mi + r32, 2 * kk + hi));
                acc = __builtin_amdgcn_mfma_f32_32x32x16_bf16(ka, bq, acc, 0, 0, 0); } }
          SC_LBAR();
          if (w < 4) { const int i = 32 * mi + r32;
#pragma unroll
            for (int r4 = 0; r4 < 4; ++r4) { const int j0 = 32 * nj + 8 * r4 + 4 * hi; float pp[4];
#pragma unroll
              for (int e = 0; e < 4; ++e) pp[e] = (j0 + e <= i) ? acc[4 * r4 + e] : 0.f;
              u32x2 wv; wv.x = pk2(pp[0], pp[1]); wv.y = pk2(pp[2], pp[3]);
              *(LAS u32x2*)(L + MP::O_KG + swz<128>(i, j0 >> 3) + (j0 & 7) * 2) = wv; } } }
        SC_LBAR();
        SEG_MARK(2);
        if (oact) { const int nvt = w >> 1, mi = w & 1;
#pragma unroll
          for (int r = 0; r < 16; ++r) acc[r] = 0.f;
#pragma unroll
          for (int kk = 0; kk < 4; ++kk) { const s16x8 va = *(const LAS s16x8*)(L + MP::O_VT + swz<128>(32 * nvt + r32, 2 * kk + hi)); const s16x8 bp = *(const LAS s16x8*)(L + MP::O_KG + swz<128>(32 * mi + r32, 2 * kk + hi));
              acc = __builtin_amdgcn_mfma_f32_32x32x16_bf16(bp, va, acc, 0, 0, 0); }
#pragma unroll
          for (int kk = 0; kk < DK / 16; ++kk) { const s16x8 sa = *(const LAS s16x8*)(L + MP::O_ST + swz<PQ>(32 * nvt + r32, 2 * kk + hi)); const s16x8 bq = *(const LAS s16x8*)(L + MP::O_QG + swz<PQ>(32 * mi + r32, 2 * kk + hi));
              acc = __builtin_amdgcn_mfma_f32_32x32x16_bf16(bq, sa, acc, 0, 0, 0); }
#pragma unroll
          for (int i = 0; i < 8; ++i) ost[i] = pk2(acc[2 * i], acc[2 * i + 1]);
          }
#pragma unroll
        for (int ti = 0; ti < NST; ++ti) {
#pragma unroll
            for (int kk = 0; kk < 4; ++kk) { const s16x8 ka = *(const LAS s16x8*)(L + MP::O_KGT + swz<128>(32 * mk + r32, 2 * kk + hi)); const s16x8 bv = *(const LAS s16x8*)(L + MP::O_VT + swz<128>(32 * (nv0 + ti) + r32, 2 * kk + hi));
                S[ti] = __builtin_amdgcn_mfma_f32_32x32x16_bf16(ka, bv, S[ti], 0, 0, 0); }
#pragma unroll
            for (int r = 0; r < 16; ++r) S[ti][r] *= ((const LAS float*)(L + MP::O_EGL))[32 * mk + crow(r, hi)]; }
        SC_LBAR();
        SEG_MARK(3);
    };
    for (int s2 = 0; s2 < 68; ++s2) body(s2, pqA, pkA, pvA, pzA);
    if (oact) SC_STORE(pbase);
    asm volatile("s_waitcnt vmcnt(0)" ::: "memory");
#undef SC_STORE
#undef SC_BASE
#undef SC_GROW
#undef SC_ISSUE
}
}

#define XB_TMO      128
#define XB_XCNT(j)  (256  + 64 * (j))
#define XB_XSUB(j)  (1280 + 64 * (j))
#define XB_XGEN(j)  (2304 + 64 * (j))
#define XB_TOP      3328
#define XB_TOPGEN   3392
#define XCD_BAR_WORDS 3456
#define XB_SPIN_CAP (1u << 18)

__device__ __forceinline__ unsigned xb_ld(unsigned* p)              { return __hip_atomic_load(p, __ATOMIC_RELAXED, __HIP_MEMORY_SCOPE_AGENT); }
__device__ __forceinline__ unsigned xb_add(unsigned* p, unsigned v) { return __hip_atomic_fetch_add(p, v, __ATOMIC_RELAXED, __HIP_MEMORY_SCOPE_AGENT); }
__device__ __forceinline__ unsigned xb_xcc_id() { return (unsigned)__builtin_amdgcn_s_getreg((3 << 11) | 20) & 0xFu; }
#define XB_SPIN(cond, bar) do { unsigned _sp = 0; while (cond) { __builtin_amdgcn_s_sleep(1); \
    if ((++_sp & 255u) == 0u) { if (xb_ld(&(bar)[XB_TMO])) break; if (_sp > XB_SPIN_CAP) { atomicAdd(&(bar)[XB_TMO], 1u); break; } } } } while (0)

struct XcdBarrier {
    unsigned* bar; unsigned x;
    volatile LAS unsigned* st;
};

__device__ __forceinline__ XcdBarrier xcd_barrier_post(unsigned* bar, volatile LAS unsigned* st) {
    XcdBarrier b; b.bar = bar; b.x = xb_xcc_id(); b.st = st;
    if (threadIdx.x == 0) (void)xb_add(&bar[XB_XCNT(b.x)], 1u);
    return b;
}
__device__ __forceinline__ void xcd_barrier_complete(unsigned* bar, unsigned x, unsigned& nloc, unsigned& nx) {
    const unsigned G = gridDim.x * gridDim.y * gridDim.z;
    unsigned sum, cnt, mine, sp = 0u;
    for (;;) {
        sum = 0u; cnt = 0u; mine = 0u;
#pragma unroll
        for (unsigned j = 0; j < 16; ++j) { const unsigned c = xb_ld(&bar[XB_XCNT(j)]); sum += c; cnt += (c > 0u) ? 1u : 0u; mine = (j == x) ? c : mine; }
        if (sum == G) break;
        __builtin_amdgcn_s_sleep(1);
        if ((++sp & 255u) == 0u) { if (xb_ld(&bar[XB_TMO])) break; if (sp > XB_SPIN_CAP) { atomicAdd(&bar[XB_TMO], 1u); break; } }
    }
    nloc = mine > 0u ? mine : 1u; nx = cnt > 0u ? cnt : 1u;
}

__device__ __forceinline__ void xcd_barrier(const XcdBarrier& b) {
    asm volatile("s_waitcnt vmcnt(0)" ::: "memory");
    __syncthreads();
    if (threadIdx.x == 0) {
        unsigned* bar = b.bar;
        __builtin_amdgcn_s_waitcnt(0);
        unsigned nloc = b.st[0], nx = b.st[1];
        if (nloc == 0u) { xcd_barrier_complete(bar, b.x, nloc, nx); b.st[0] = nloc; b.st[1] = nx; }
        const unsigned old = xb_add(&bar[XB_XSUB(b.x)], 1u);
        const unsigned gen = old / nloc;
        if (old + 1u == (gen + 1u) * nloc) {
            __builtin_amdgcn_fence(__ATOMIC_RELEASE, "agent");
            asm volatile("s_waitcnt vmcnt(0)" ::: "memory");
            const unsigned og = xb_add(&bar[XB_TOP], 1u);
            const unsigned tg = og / nx;
            if (og + 1u == (tg + 1u) * nx) xb_add(&bar[XB_TOPGEN], 1u);
            else XB_SPIN(xb_ld(&bar[XB_TOPGEN]) == tg, bar);
            __builtin_amdgcn_fence(__ATOMIC_ACQUIRE, "agent");
            xb_add(&bar[XB_XGEN(b.x)], 1u);
            asm volatile("s_waitcnt vmcnt(0)" ::: "memory");
        } else {
            XB_SPIN(xb_ld(&bar[XB_XGEN(b.x)]) == gen, bar);
            __builtin_amdgcn_fence(__ATOMIC_ACQUIRE, "agent");
            asm volatile("s_waitcnt vmcnt(0)" ::: "memory");
        }
    }
    __syncthreads();
}

#ifdef PROBE_MASK
#define STAMP() do { if (blockIdx.x == PROBE_BLK && threadIdx.x == 0) { pst[pn] = __builtin_amdgcn_s_memrealtime(); } ++pn; } while (0)
#else
#define STAMP() do {} while (0)
#endif
#define GRID_SYNC() do { xcd_barrier(xbar); STAMP(); } while (0)
#define GRID_SYNC_CG() do { if (a.ws == nullptr) grid.sync(); xcd_barrier(xbar); STAMP(); } while (0)
__global__ void __launch_bounds__(NTHR, 2) fwd_megakernel(Args a) {
    extern __shared__ __attribute__((aligned(16))) unsigned char lds_raw[];
    cg::grid_group grid = cg::this_grid();
    LAS unsigned char* lds = (LAS unsigned char*)lds_raw;
    const int G = gridDim.x, tid = threadIdx.x;
    unsigned char* ws = a.ws;
    float* MOD = (float*)(ws + WS_MOD); const float* LB = (const float*)(ws + WS_LB);
    bfs* XB1 = (bfs*)a.out;
    bfs* X2 = (bfs*)(ws + WS_D + 264 * MiB);
    bfs* CB = (bfs*)(ws + WS_C); bfs* DB = (bfs*)(ws + WS_D); bfs* YB = (bfs*)(ws + WS_Y); bfs* EB = (bfs*)(ws + WS_E0);
    unsigned* ctl = (unsigned*)(ws + WS_CTL);
    { volatile LAS unsigned* st0 = (volatile LAS unsigned*)(lds + LDS_CTL_OFF + 16); if (tid == 0) { st0[0] = 0u; st0[1] = 0u; } __syncthreads(); }
    XcdBarrier xbar = xcd_barrier_post(ctl + 1024, (volatile LAS unsigned*)(lds + LDS_CTL_OFF + 16));
#ifdef PROBE_MASK
    volatile LAS unsigned long long* pst = (volatile LAS unsigned long long*)(lds + LDS_CTL_OFF + 64); int pn = 1;
    if (threadIdx.x == 0) { pst[0] = __builtin_amdgcn_s_memrealtime(); pst[40] = 0; }
#endif

    p0_phase(a, lds, G);
    GRID_SYNC_CG();
    { RowOp op{a.in[0], a.in[2], nullptr, nullptr, nullptr, nullptr, nullptr, 0, CB, a.in[6], MOD, 0, 1, 0, 0, 0}; row_phase(op, G); }
    GRID_SYNC();
    for (int l = 0; l < 2; ++l) {
        const float* MODL = MOD + (size_t)l * 9 * 6144;
        const bfs* Win = (const bfs*)(ws + (l ? WS_WIN1 : WS_WIN0)); const bfs* Wout = (const bfs*)(ws + (l ? WS_WOUT1 : WS_WOUT0));
        const bfs* Wgu = (const bfs*)(ws + (l ? WS_WGU1 : WS_WGU0)); const bfs* Wd = (const bfs*)(ws + (l ? WS_WD1 : WS_WD0));
        const int pitch = l ? NIN1 : PIN0;
        { pg8::Gemm g{CB, Win, ROWS, pitch, DM}; pg8::StaticOrder S; S.init(ROWS, pitch, G, (int)blockIdx.x);
          pg8::EpiStore E{DB, pitch, l, LB};
#ifndef NO_GEMM
          pg8::gemm_phase<pg8::EpiStore, pg8::StaticOrder, true, true>(lds, g, S, E);
#endif
 }
        GRID_SYNC();
        if (l == 0) {
            qk_phase(DB, a.in[14], a.in[15], G);
            GRID_SYNC();
            volatile LAS unsigned* lctl = (volatile LAS unsigned*)(lds + LDS_CTL_OFF);
            constexpr int N_GLA = 64, N_ATL = 1024, N_ATC = 64, N_ITEMS = N_GLA + N_ATL + N_ATC;
            for (;;) {
                if (tid == 0) lctl[0] = __hip_atomic_fetch_add(ctl + 64, 1u, __ATOMIC_RELAXED, __HIP_MEMORY_SCOPE_AGENT);
                __syncthreads();
                const int it = (int)lctl[0];
                __syncthreads();
                if (it >= N_ITEMS) break;
                if (it < N_GLA) {
                    const int b = it >> 3, h = (it >> 1) & 3, dir = it & 1;
#ifndef NO_GLA
                    scan::scan_unit<64, false, PIN0, 128>(lds, DB, C_GQ + 64 * h, C_GK + 64 * h, C_GV + 128 * h, C_GZ + 16 * dir, a.in[11] + dir * 16 * 256 + 64 * h, a.in[12] + dir * 256 + 64 * h,
                                               dir ? EB : CB, dir ? EB : CB, 0, dir ? 512 : DM, 128 * h, b, dir, 0.125f);
#endif
                } else if (it < N_GLA + N_ATL) {
                    const int u = it - N_GLA, gq = u & 3, qb = (u >> 2) & 15, kvh = (u >> 6) & 1, b = u >> 7, h = kvh * 4 + gq;
                    const size_t qrow = (size_t)RCTX + (size_t)b * SEQ + (size_t)qb * 256;
#ifndef NO_ATTN
                    attn_body::attn_unit<8>(b, 68, (const attn_body::bf16*)(DB + qrow * PIN0 + C_AQ + 64 * h), PIN0, (const attn_body::bf16*)(DB + C_AK + 64 * kvh), (const attn_body::bf16*)(DB + C_AV + 64 * kvh), PIN0,
                                            (attn_body::bf16*)(CB + qrow * DM + 512 + 64 * h), DM, (char*)lds_raw);
#endif
                } else {
                    const int u = it - N_GLA - N_ATL, h = u & 7, b = u >> 3, kvh = h >> 2;
                    const size_t qrow = (size_t)b * NCTX;
#ifndef NO_ATTN2
                    attn_body::attn_unit<8>(b, 4, (const attn_body::bf16*)(DB + qrow * PIN0 + C_AQ + 64 * h), PIN0, (const attn_body::bf16*)(DB + C_AK + 64 * kvh), (const attn_body::bf16*)(DB + C_AV + 64 * kvh), PIN0,
                                            (attn_body::bf16*)(CB + qrow * DM + 512 + 64 * h), DM, (char*)lds_raw);
#endif
                }
            }
            if (G >= 256) p0_weights(a, lds, P0_NA, P0_NITEMS, (int)blockIdx.x * NWAVES + (tid >> 6), G * NWAVES);
            GRID_SYNC();
            readout_phase<512>(CB, DM, EB, 512, EB, 0, CB, DB, PIN0, C_GOG, a.in[13], 0, G);
        } else {
            bfs* OA = (bfs*)(ws + 2 * MiB); bfs* OT2 = (bfs*)(ws + WS_D + 340 * MiB) - (size_t)OSPLIT * DM;
            for (int u = blockIdx.x; u < 256; u += G) {
                const int b = u >> 5, hh = (u >> 2) & 7, dir = (u >> 1) & 1, vh = u & 1;
#ifndef NO_HG
                scan::scan_unit<128, true, NIN1, 64>(lds, DB, C_FQ + 128 * hh, C_FF + 1024 * dir + 128 * hh, C_FI + 128 * hh + 64 * vh, 0, nullptr, nullptr,
                                                     dir ? OA : CB, dir ? OT2 : CB, dir ? OSPLIT : 0, DM, 128 * hh + 64 * vh, b, dir, 1.0f);
#endif
            }
            GRID_SYNC();
            readout_phase<1024>(CB, DM, OA, DM, OT2, OSPLIT, CB, DB, NIN1, C_FOG, a.in[19], RCTX, G);
        }
        GRID_SYNC();
        const int row_lo = l ? RCTX : 0; const int Mg = ROWS - row_lo;
        { pg8::Gemm g{CB + (size_t)row_lo * DM, Wout, Mg, DM, DM}; pg8::StaticOrder S; S.init(Mg, DM, G, (int)blockIdx.x);
          pg8::EpiStore E{YB + (size_t)row_lo * DM, DM, 0, nullptr};
#ifndef NO_GEMM
          pg8::gemm_phase<pg8::EpiStore, pg8::StaticOrder, true, true>(lds, g, S, E);
#endif
 }
        GRID_SYNC();
        { RowOp op{l ? (const void*)(XB1 + (size_t)RCTX * DM) : (const void*)a.in[0], l ? (const void*)XB1 : (const void*)a.in[2], l ? (void*)X2 : (void*)(XB1 + (size_t)RCTX * DM), l ? (void*)nullptr : (void*)XB1,
                   YB, a.in[7] + l * DM, MODL, 2, CB, a.in[8] + l * DM, MODL, 3, 4, row_lo, l, 1}; row_phase(op, G); }
        GRID_SYNC();
        { pg8::Gemm g{CB + (size_t)row_lo * DM, Wgu, Mg, NGU, DM}; pg8::StaticOrder S; S.init(Mg, NGU, G, (int)blockIdx.x);
          pg8::EpiSwiGLU E{DB + (size_t)row_lo * DFF, DFF};
#ifndef NO_GEMM
          pg8::gemm_phase<pg8::EpiSwiGLU, pg8::StaticOrder, true, true>(lds, g, S, E);
#endif
 }
        GRID_SYNC();
        { pg8::Gemm g{DB + (size_t)row_lo * DFF, Wd, Mg, DM, DFF}; pg8::StaticOrder S; S.init(Mg, DM, G, (int)blockIdx.x);
          pg8::EpiStore E{YB + (size_t)row_lo * DM, DM, 0, nullptr};
#ifndef NO_GEMM
          pg8::gemm_phase<pg8::EpiStore, pg8::StaticOrder, true, true>(lds, g, S, E);
#endif
 }
        GRID_SYNC();
        if (l == 0) { RowOp op{XB1 + (size_t)RCTX * DM, XB1, XB1 + (size_t)RCTX * DM, XB1, YB, a.in[9], MODL, 5, CB, a.in[6] + DM, MOD + (size_t)9 * 6144, 0, 1, 0, 1, 1}; row_phase(op, G); GRID_SYNC(); }
        else { RowOp op{X2, nullptr, a.out, nullptr, YB, a.in[9] + DM, MODL, 5, nullptr, nullptr, nullptr, 0, 0, RCTX, 1, 0}; row_phase(op, G); }
    }
#ifdef PROBE_SYNCS
    for (int i = 0; i < PROBE_SYNCS; ++i) xcd_barrier(xbar);
#endif
#ifdef PROBE_MASK
    STAMP();
    if (blockIdx.x == PROBE_BLK && threadIdx.x == 0) {
        unsigned long long extra = 0;
        for (int i = 1; i < pn; ++i) if ((PROBE_MASK >> (i - 1)) & 1u) extra += pst[i] - pst[i - 1];
        extra += pst[40];
        const unsigned long long t0 = __builtin_amdgcn_s_memrealtime();
        while (__builtin_amdgcn_s_memrealtime() - t0 < extra) __builtin_amdgcn_s_sleep(8);
    }
#endif
}

extern "C" void kernel_launch(void* const* d_in, const int* in_sizes, int n_in, void* d_out, int out_size, void* d_ws, size_t ws_size, hipStream_t stream) {
    static int grid = 0;
    if (grid == 0) {
        if (n_in != 24 || ws_size < WS_END) { fprintf(stderr, "kernel_launch: unexpected inputs (n_in %d, ws %zu < %zu)\n", n_in, ws_size, (size_t)WS_END); grid = -1; return; }
        int dev = 0, cus = 0, per_cu = 0;
        hipGetDevice(&dev);
        hipDeviceGetAttribute(&cus, hipDeviceAttributeMultiprocessorCount, dev);
        if (hipFuncSetAttribute((const void*)fwd_megakernel, hipFuncAttributeMaxDynamicSharedMemorySize, LDS_BYTES) != hipSuccess) { fprintf(stderr, "kernel_launch: hipFuncSetAttribute failed\n"); grid = -1; return; }
        if (hipOccupancyMaxActiveBlocksPerMultiprocessor(&per_cu, (const void*)fwd_megakernel, NTHR, LDS_BYTES) != hipSuccess || per_cu < 1) { fprintf(stderr, "kernel_launch: occupancy query gave %d\n", per_cu); per_cu = 1; }
        (void)hipGetLastError();
        grid = cus * 1;
        fprintf(stderr, "kernel_launch: grid %d (cus %d, per_cu %d)\n", grid, cus, per_cu);
    }
    if (grid < 0) return;
    hipMemsetAsync((char*)d_ws + WS_CTL, 0, CTL_BYTES, stream);
    Args a{};
    for (int i = 0; i < 24; ++i) a.in[i] = (const float*)d_in[i];
    a.out = (float*)d_out; a.ws = (unsigned char*)d_ws;
    void* args[] = {&a};
    hipError_t e = hipLaunchCooperativeKernel((const void*)fwd_megakernel, dim3(grid), dim3(NTHR), args, LDS_BYTES, stream);
    if (e != hipSuccess) fprintf(stderr, "cooperative launch failed: %s (grid %d)\n", hipGetErrorString(e), grid);
}
```

```cpp
#include <hip/hip_runtime.h>
#include <hip/hip_cooperative_groups.h>
#include <hip/hip_bf16.h>
#include <cstdio>
#include <cstdint>
#include <cmath>
namespace cg = cooperative_groups;
__device__ __forceinline__ int tid_fresh() { int t = threadIdx.x; asm volatile("" : "+v"(t)); return t; }
namespace pg8 {
#define PG8_LAS __attribute__((address_space(3)))
typedef unsigned short bf16_t;
typedef short bf16x8 __attribute__((ext_vector_type(8)));
typedef float f32x4 __attribute__((ext_vector_type(4)));
typedef unsigned u32x4 __attribute__((ext_vector_type(4)));
constexpr int BM = 256, BK = 64, HALF = 128, HTB = HALF * BK * 2  , STAGE_BYTES = 8 * HTB, NXCD = 8, WGM = 8;

__host__ __device__ __forceinline__ int lds_byte(int r, int c) { const int st = (r >> 4) * 2 + (c >> 5), rr = r & 15, cc = c & 31, ob = rr * 64 + cc * 2; return st * 1024 + (ob ^ (((ob >> 9) & 1) << 5)); }
__host__ __device__ __forceinline__ void stage_rc(int b, int& R, int& C) { const int st = b / 1024, sb = b % 1024, swz = sb ^ (((sb >> 9) & 1) << 5); R = (st >> 1) * 16 + swz / 64; C = (st & 1) * 32 + (swz % 64) / 2; }
__host__ __device__ __forceinline__ int perm32(int rho) { const int n = rho >> 4, i = rho & 15; return 8 * (i >> 2) + 4 * n + (i & 3); }

struct Unit { int pm, pn; };
struct Gemm { const bf16_t* A; const bf16_t* Bt; int M, N, K; };

struct StaticOrder {
    int nM, nN, nwg, G, c;
    __host__ __device__ void init(int M, int N, int G_, int c_) { nM = M / BM; nN = N / BM; nwg = nM * nN; G = G_; c = c_; }
    __host__ __device__ bool next(int i, Unit& u) const {
        const long L = (long)i * G + c; if (L >= nwg) return false;
        int wgid = (int)L; { const int q = nwg / NXCD, r = nwg % NXCD, xcd = wgid % NXCD, off = wgid / NXCD; wgid = (xcd < r ? xcd * (q + 1) : r * (q + 1) + (xcd - r) * q) + off; }
        const int nig = WGM * nN, gid = wgid / nig, fm = gid * WGM, gsz = (nM - fm) < WGM ? (nM - fm) : WGM;
        u.pm = fm + ((wgid % nig) % gsz); u.pn = (wgid % nig) / gsz; return true;
    }
    __device__ __forceinline__ void a_ready(const Unit&) const {}
    __device__ __forceinline__ void done(const Unit&) const {}
};

typedef float f32x2_cv __attribute__((ext_vector_type(2))); typedef __bf16 bf16x2_cv __attribute__((ext_vector_type(2)));
__device__ __forceinline__ unsigned cvt_pk_bf16(float lo, float hi) { f32x2_cv v = {lo, hi}; bf16x2_cv b = __builtin_convertvector(v, bf16x2_cv); return __builtin_bit_cast(unsigned, b); }
typedef float f32x2 __attribute__((ext_vector_type(2)));
struct PanelOrder {
    int nM, G, c, i0, i1;
    __host__ __device__ bool next(int i, Unit& u) const {
        const int r = i + i0; if (r >= i1) return false;
        if (G == 256) { const int x = c & 7, j = c >> 3; u.pm = r * 64 + x * 8 + (j >> 2); u.pn = j & 3; }
        else { const int L = r * G + c; u.pm = L >> 2; u.pn = L & 3; }
        return u.pm < nM;
    }
    __device__ __forceinline__ void a_ready(const Unit&) const {}
    __device__ __forceinline__ void done(const Unit&) const {}
};
typedef float f32x2 __attribute__((ext_vector_type(2)));
struct EpiStore {
    static constexpr bool PERM = true, AFTER_DRAIN = false;
    bf16_t* O; int ldc; int mode; const float* lb;
    __device__ __forceinline__ void operator()(const f32x4 (&acc)[2][2][4][2], const Unit& u, int wr, int wc, int fr, int fq) const {
        const int row0 = u.pm * BM + wr * 64 + fr; const int col0 = u.pn * BM + wc * 32 + 8 * fq;
#pragma unroll
        for (int bj = 0; bj < 2; ++bj) {
            const int col = col0 + bj * HALF;
            int cls = 0; f32x4 l0 = (f32x4){0.f,0.f,0.f,0.f}, l1 = l0;
            if (mode == 1) { if (col < 1024) cls = 1; else if (col < 3072) { cls = 2; l0 = *(const f32x4*)(lb + col - 1024); l1 = *(const f32x4*)(lb + col - 1024 + 4); } }
#pragma unroll
            for (int ai = 0; ai < 2; ++ai)
#pragma unroll
                for (int m = 0; m < 4; ++m) {
                    f32x4 v0 = acc[ai][bj][m][0], v1 = acc[ai][bj][m][1];
                    if (cls == 1) {
#pragma unroll
                        for (int e = 0; e < 4; ++e) { v0[e] = v0[e] * __builtin_amdgcn_rcpf(1.f + __expf(-v0[e])); v1[e] = v1[e] * __builtin_amdgcn_rcpf(1.f + __expf(-v1[e])); }
                    } else if (cls == 2) {
#pragma unroll
                        for (int e = 0; e < 4; ++e) { const float s0 = __builtin_amdgcn_rcpf(1.f + __expf(v0[e])), s1 = __builtin_amdgcn_rcpf(1.f + __expf(v1[e]));
                            v0[e] = (1.f - l0[e]) * s0; v1[e] = (1.f - l1[e]) * s1; }
                    }
                    u32x4 w; w.x = cvt_pk_bf16(v0[0], v0[1]); w.y = cvt_pk_bf16(v0[2], v0[3]); w.z = cvt_pk_bf16(v1[0], v1[1]); w.w = cvt_pk_bf16(v1[2], v1[3]);
                    *(u32x4*)(O + (size_t)(row0 + ai * HALF + m * 16) * ldc + col) = w;
                }
        }
    }
};
struct EpiSwiGLU {
    static constexpr bool PERM = true, AFTER_DRAIN = false;
    bf16_t* O; int ldc;
    __device__ __forceinline__ void operator()(const f32x4 (&acc)[2][2][4][2], const Unit& u, int wr, int wc, int fr, int fq) const {
        const int row0 = u.pm * BM + wr * 64 + fr; const int col = u.pn * HALF + wc * 32 + 8 * fq;
#pragma unroll
        for (int ai = 0; ai < 2; ++ai)
#pragma unroll
            for (int m = 0; m < 4; ++m) {
                f32x4 g0 = acc[ai][0][m][0], g1 = acc[ai][0][m][1]; const f32x4 u0 = acc[ai][1][m][0], u1 = acc[ai][1][m][1];
#pragma unroll
                for (int e = 0; e < 4; ++e) { g0[e] = g0[e] * __builtin_amdgcn_rcpf(1.f + __expf(-g0[e])) * u0[e]; g1[e] = g1[e] * __builtin_amdgcn_rcpf(1.f + __expf(-g1[e])) * u1[e]; }
                u32x4 w; w.x = cvt_pk_bf16(g0[0], g0[1]); w.y = cvt_pk_bf16(g0[2], g0[3]); w.z = cvt_pk_bf16(g1[0], g1[1]); w.w = cvt_pk_bf16(g1[2], g1[3]);
                *(u32x4*)(O + (size_t)(row0 + ai * HALF + m * 16) * ldc + col) = w;
            }
    }
};
template <class Epi, class Sched, bool ALIGN_EPI = false, bool SP2 = false>
__device__ __forceinline__ void gemm_phase(PG8_LAS unsigned char* lds, const Gemm g, const Sched& S, const Epi& E) {
    const int tid = tid_fresh(), wid = __builtin_amdgcn_readfirstlane(tid >> 6), lane = tid & 63, wr = wid >> 2, wc = wid & 3, fr = lane & 15, fq = lane >> 4;
    const int K = g.K, nt = K / BK;
    unsigned voffA[2], voffB[2];
#pragma unroll
    for (int i = 0; i < 2; ++i) { int R, C; stage_rc(tid * 16 + i * 8192, R, C); const int Rb = Epi::PERM ? ((R & ~31) + perm32(R & 31)) : R;
        voffA[i] = (unsigned)(R * K + C) * 2u; voffB[i] = (unsigned)(Rb * K + C) * 2u; }
    const size_t kstep = (size_t)(BK * 2);
    const size_t hstep = (size_t)HALF * K * 2;
    const size_t tstep = 2 * hstep;
    const unsigned ldsw = (unsigned)wid * 1024u;
    const int aoff = lds_byte(wr * 64 + fr, fq * 8), boff = lds_byte(wc * 32 + fr, fq * 8);
#define PG8_SA(b, h) (((b) * 2 + (h)) * HTB)
#define PG8_SB(b, h) ((4 + (b) * 2 + (h)) * HTB)
#define PG8_STAGE(bufoff, gbase, voff) do { _Pragma("unroll") for (int _i = 0; _i < 2; ++_i) \
        __builtin_amdgcn_global_load_lds((const unsigned*)((const char*)(gbase) + (voff)[_i]), (PG8_LAS unsigned*)(lds + (bufoff) + ldsw + _i * 8192), 16, 0, 0); } while (0)
#define PG8_LDA(dst, b, h) do { _Pragma("unroll") for (int m = 0; m < 4; ++m) _Pragma("unroll") for (int k = 0; k < 2; ++k) dst[m][k] = *(const PG8_LAS bf16x8*)(lds + PG8_SA(b, h) + aoff + m * 2048 + k * 1024); } while (0)
#define PG8_LDB(dst, b, h) do { _Pragma("unroll") for (int n = 0; n < 2; ++n) _Pragma("unroll") for (int k = 0; k < 2; ++k) dst[n][k] = *(const PG8_LAS bf16x8*)(lds + PG8_SB(b, h) + boff + n * 2048 + k * 1024); } while (0)
#define PG8_MMA(ai, bj, At, Bt) do { __builtin_amdgcn_s_setprio(1); _Pragma("unroll") for (int m = 0; m < 4; ++m) _Pragma("unroll") for (int n = 0; n < 2; ++n) _Pragma("unroll") for (int k = 0; k < 2; ++k) \
        acc[ai][bj][m][n] = __builtin_amdgcn_mfma_f32_16x16x32_bf16(Bt[n][k], At[m][k], acc[ai][bj][m][n], 0, 0, 0); __builtin_amdgcn_s_setprio(0); } while (0)
#define PG8_WAIT_V(n) asm volatile("s_waitcnt vmcnt(" #n ")" ::: "memory")
#define PG8_WAIT_L(n) asm volatile("s_waitcnt lgkmcnt(" #n ")" ::: "memory")
#define PG8_BAR __builtin_amdgcn_s_barrier()
#define PG8_SCHED __builtin_amdgcn_sched_barrier(0)
    Unit cur, nxt; int ui = 0;
    if (!S.next(0, cur)) return;
    f32x4 acc[2][2][4][2];
#pragma unroll
    for (int a = 0; a < 2; ++a)
#pragma unroll
        for (int b = 0; b < 2; ++b)
#pragma unroll
            for (int m = 0; m < 4; ++m)
#pragma unroll
                for (int n = 0; n < 2; ++n) acc[a][b][m][n] = (f32x4){0.f, 0.f, 0.f, 0.f};
    bf16x8 At[4][2], B0[2][2], B1[2][2];
    const char* cA = (const char*)g.A + (size_t)cur.pm * tstep; const char* cB = (const char*)g.Bt + (size_t)cur.pn * tstep;
    S.a_ready(cur);
    if constexpr (SP2) {
        PG8_STAGE(PG8_SB(0, 0), cB, voffB); PG8_STAGE(PG8_SB(0, 1), cB + hstep, voffB); PG8_STAGE(PG8_SA(0, 0), cA, voffA); PG8_STAGE(PG8_SA(0, 1), cA + hstep, voffA);
        if (wr == 1) PG8_BAR;
        PG8_WAIT_V(2); PG8_BAR;
        PG8_STAGE(PG8_SB(1, 0), cB + kstep, voffB); PG8_STAGE(PG8_SA(1, 0), cA + kstep, voffA); PG8_STAGE(PG8_SB(1, 1), cB + hstep + kstep, voffB);
        PG8_WAIT_V(6); PG8_BAR;
    } else {
        PG8_STAGE(PG8_SB(0, 0), cB, voffB); PG8_STAGE(PG8_SA(0, 0), cA, voffA); PG8_STAGE(PG8_SB(0, 1), cB + hstep, voffB); PG8_STAGE(PG8_SA(0, 1), cA + hstep, voffA);
        if (wr == 1) PG8_BAR;
        PG8_WAIT_V(4); PG8_BAR;
        PG8_STAGE(PG8_SB(1, 0), cB + kstep, voffB); PG8_STAGE(PG8_SA(1, 0), cA + kstep, voffA); PG8_STAGE(PG8_SB(1, 1), cB + hstep + kstep, voffB);
        PG8_WAIT_V(6); PG8_BAR;
    }
    for (;;) {
        const bool has_next = S.next(ui + 1, nxt);
        const char* nA = has_next ? (const char*)g.A + (size_t)nxt.pm * tstep : cA; const char* nB = has_next ? (const char*)g.Bt + (size_t)nxt.pn * tstep : cB;
        for (int t = 0; t < nt; t += 2) {
            const bool last = (t == nt - 2);
            const char* a1 = cA + (size_t)(t + 1) * kstep;
            const char* a2 = last ? nA : cA + (size_t)(t + 2) * kstep; const char* b2 = last ? nB : cB + (size_t)(t + 2) * kstep;
            const char* a3 = a2 + kstep; const char* b3 = b2 + kstep;
            if (last && has_next) S.a_ready(nxt);
            if constexpr (SP2) {
            PG8_LDB(B0, 0, 0); PG8_LDB(B1, 0, 1); PG8_SCHED; PG8_LDA(At, 0, 0); PG8_STAGE(PG8_SA(1, 1), a1 + hstep, voffA);
            PG8_WAIT_V(8); PG8_WAIT_L(0); PG8_BAR; PG8_MMA(0, 0, At, B0); PG8_MMA(0, 1, At, B1); PG8_BAR; PG8_SCHED;
            PG8_LDA(At, 0, 1); PG8_STAGE(PG8_SB(0, 0), b2, voffB); PG8_STAGE(PG8_SB(0, 1), b2 + hstep, voffB); PG8_STAGE(PG8_SA(0, 0), a2, voffA);
            PG8_WAIT_V(8); PG8_WAIT_L(0); PG8_BAR; PG8_MMA(1, 0, At, B0); PG8_MMA(1, 1, At, B1); PG8_BAR; PG8_SCHED;
            PG8_LDB(B0, 1, 0); PG8_LDB(B1, 1, 1); PG8_SCHED; PG8_LDA(At, 1, 0); PG8_STAGE(PG8_SA(0, 1), a2 + hstep, voffA);
            PG8_WAIT_V(8); PG8_WAIT_L(0); PG8_BAR; PG8_MMA(0, 0, At, B0); PG8_MMA(0, 1, At, B1); PG8_BAR; PG8_SCHED;
            PG8_LDA(At, 1, 1); PG8_STAGE(PG8_SB(1, 0), b3, voffB); PG8_STAGE(PG8_SB(1, 1), b3 + hstep, voffB); PG8_STAGE(PG8_SA(1, 0), a3, voffA);
            PG8_WAIT_V(8); PG8_WAIT_L(0); PG8_BAR; PG8_MMA(1, 0, At, B0); PG8_MMA(1, 1, At, B1); PG8_BAR; PG8_SCHED;
            } else {
            PG8_LDB(B0, 0, 0); PG8_SCHED; PG8_LDA(At, 0, 0); PG8_STAGE(PG8_SA(1, 1), a1 + hstep, voffA);
            PG8_WAIT_L(8); PG8_BAR; PG8_WAIT_L(0); PG8_MMA(0, 0, At, B0); PG8_BAR; PG8_SCHED;
            PG8_LDB(B1, 0, 1); PG8_STAGE(PG8_SB(0, 0), b2, voffB);
            PG8_BAR; PG8_WAIT_L(0); PG8_MMA(0, 1, At, B1); PG8_BAR;
            PG8_LDA(At, 0, 1); PG8_STAGE(PG8_SA(0, 0), a2, voffA);
            PG8_BAR; PG8_WAIT_L(0); PG8_MMA(1, 0, At, B0); PG8_BAR; PG8_SCHED;
            PG8_STAGE(PG8_SB(0, 1), b2 + hstep, voffB);
            PG8_WAIT_V(6); PG8_BAR; PG8_MMA(1, 1, At, B1); PG8_BAR;
            PG8_LDB(B0, 1, 0); PG8_SCHED; PG8_LDA(At, 1, 0); PG8_STAGE(PG8_SA(0, 1), a2 + hstep, voffA);
            PG8_WAIT_L(8); PG8_BAR; PG8_WAIT_L(0); PG8_MMA(0, 0, At, B0); PG8_BAR; PG8_SCHED;
            PG8_LDB(B1, 1, 1); PG8_STAGE(PG8_SB(1, 0), b3, voffB);
            PG8_BAR; PG8_WAIT_L(0); PG8_MMA(0, 1, At, B1); PG8_BAR;
            PG8_LDA(At, 1, 1); PG8_STAGE(PG8_SA(1, 0), a3, voffA);
            PG8_BAR; PG8_WAIT_L(0); PG8_MMA(1, 0, At, B0); PG8_BAR; PG8_SCHED;
            PG8_STAGE(PG8_SB(1, 1), b3 + hstep, voffB);
            PG8_WAIT_V(6); PG8_BAR; PG8_MMA(1, 1, At, B1); PG8_BAR;
            }
        }
        if constexpr (ALIGN_EPI) { if (wr == 0) PG8_BAR; }
        if constexpr (!Epi::AFTER_DRAIN) { E(acc, cur, wr, wc, fr, fq); S.done(cur); }
        if (!has_next) break;
#pragma unroll
        for (int a = 0; a < 2; ++a)
#pragma unroll
            for (int b = 0; b < 2; ++b)
#pragma unroll
                for (int m = 0; m < 4; ++m)
#pragma unroll
                    for (int n = 0; n < 2; ++n) acc[a][b][m][n] = (f32x4){0.f, 0.f, 0.f, 0.f};
        cur = nxt; cA = nA; cB = nB; ++ui;
        if constexpr (ALIGN_EPI) { if (wr == 1) PG8_BAR; }
    }
    PG8_WAIT_V(0);
    if constexpr (!ALIGN_EPI) { if (wr == 0) PG8_BAR; }
    PG8_BAR;
    if constexpr (Epi::AFTER_DRAIN) { E.fused(acc, cur, wr, wc, fr, fq, lds, wid, lane); S.done(cur); }
#undef PG8_SA
#undef PG8_SB
#undef PG8_STAGE
#undef PG8_LDA
#undef PG8_LDB
#undef PG8_MMA
#undef PG8_WAIT_V
#undef PG8_WAIT_L
#undef PG8_BAR
#undef PG8_SCHED
}
}
#include <hip/hip_bf16.h>
#include <cmath>
namespace attn_body {
using bf16=__hip_bfloat16;
using bf16x8=__attribute__((ext_vector_type(8)))short;
using s16x4=__attribute__((ext_vector_type(4)))short;
using f32x16=__attribute__((ext_vector_type(16)))float;
using u32x4=__attribute__((ext_vector_type(4)))unsigned;
constexpr int D=64;
constexpr int NW=8,QBLK=32,QB=QBLK*NW,KVBLK=64;
__device__ __forceinline__ int crow(int r,int hi){return (r&3)+8*(r>>2)+4*hi;}
#define SBAR() __builtin_amdgcn_sched_barrier(0)
__device__ __forceinline__ void cmask(f32x16&p0,f32x16&p1,int jb,int qrel,int hi){
  const float NEG=-INFINITY; int kb=64*jb+4*hi;
  #pragma unroll
  for(int r=0;r<16;++r){int kv=kb+(r&3)+8*(r>>2); if(kv>qrel)p0[r]=NEG; if(kv+32>qrel)p1[r]=NEG;}
}

constexpr int NSLOT=3, SLOTB=8192;
constexpr int LDS_K=0, LDS_V=NSLOT*SLOTB, LDS_WS=2*NSLOT*SLOTB, LDS_OST=LDS_WS+NW*64*4, LDS_BYTES=LDS_OST+NW*4096;
constexpr float C2=0.125f*1.4426950408889634f;
__device__ __forceinline__ void glds16(const void*gsrc,unsigned lds_dst){unsigned keep;
  asm volatile("s_mov_b32 %0, m0\n\ts_mov_b32 m0, %2\n\ts_nop 0\n\tglobal_load_lds_dwordx4 %1, off\n\ts_mov_b32 m0, %0":"=&s"(keep):"v"(gsrc),"s"(lds_dst):"memory");}
__device__ __forceinline__ float max3f(float a,float b,float c){float r;asm("v_max3_f32 %0, %1, %2, %3":"=v"(r):"v"(a),"v"(b),"v"(c));return r;}
__device__ __forceinline__ float max2f(float a,float b){float r;asm("v_max_f32_e32 %0, %1, %2":"=v"(r):"v"(a),"v"(b));return r;}
__device__ __forceinline__ float fadd_s(float a,float b){float r;asm("v_add_f32_e32 %0, %1, %2":"=v"(r):"v"(a),"v"(b));return r;}
__device__ __forceinline__ float fsub_s(float a,float b){float r;asm("v_sub_f32_e32 %0, %1, %2":"=v"(r):"v"(a),"v"(b));return r;}
typedef float f32x2_t __attribute__((ext_vector_type(2))); typedef __bf16 bf16x2_t __attribute__((ext_vector_type(2)));
__device__ __forceinline__ unsigned cvtpk_s(float lo,float hi){f32x2_t v={lo,hi};bf16x2_t b=__builtin_convertvector(v,bf16x2_t);return __builtin_bit_cast(unsigned,b);}
#define WAIT_BAR(N) asm volatile("s_waitcnt vmcnt(" #N ") lgkmcnt(0)\n\ts_barrier":::"memory")

__device__ __forceinline__ void qkt(f32x16&p0,f32x16&p1,const char*Kslot,const bf16x8*qr,const f32x16&negm,int r32,int hi){
  const char*kb=Kslot+hi*1024+r32*16;
  #pragma unroll
  for(int d0=0;d0<4;++d0){
    const bf16x8 b0=*reinterpret_cast<const bf16x8*>(kb+d0*2048);
    const bf16x8 b1=*reinterpret_cast<const bf16x8*>(kb+d0*2048+512);
    if(d0==0){p0=__builtin_amdgcn_mfma_f32_32x32x16_bf16(b0,qr[0],negm,0,0,0);p1=__builtin_amdgcn_mfma_f32_32x32x16_bf16(b1,qr[0],negm,0,0,0);}
    else{p0=__builtin_amdgcn_mfma_f32_32x32x16_bf16(b0,qr[d0],p0,0,0,0);p1=__builtin_amdgcn_mfma_f32_32x32x16_bf16(b1,qr[d0],p1,0,0,0);}}
}
typedef __attribute__((address_space(3))) const char* lds_cptr;
typedef short v4i16_t __attribute__((ext_vector_type(4)));
__device__ __forceinline__ void kload8(bf16x8*kf,lds_cptr kp){
  kf[0]=*(const __attribute__((address_space(3))) bf16x8*)(kp);      kf[1]=*(const __attribute__((address_space(3))) bf16x8*)(kp+512);
  kf[2]=*(const __attribute__((address_space(3))) bf16x8*)(kp+2048); kf[3]=*(const __attribute__((address_space(3))) bf16x8*)(kp+2560);
  kf[4]=*(const __attribute__((address_space(3))) bf16x8*)(kp+4096); kf[5]=*(const __attribute__((address_space(3))) bf16x8*)(kp+4608);
  kf[6]=*(const __attribute__((address_space(3))) bf16x8*)(kp+6144); kf[7]=*(const __attribute__((address_space(3))) bf16x8*)(kp+6656);
}
__device__ __forceinline__ void kload2(bf16x8*kf,lds_cptr kp,int j){ kf[2*j]=*(const __attribute__((address_space(3))) bf16x8*)(kp+j*2048); kf[2*j+1]=*(const __attribute__((address_space(3))) bf16x8*)(kp+j*2048+512); }
__device__ __forceinline__ s16x4 vtr(lds_cptr p){ return __builtin_bit_cast(s16x4,__builtin_amdgcn_ds_read_tr16_b64_v4i16((__attribute__((address_space(3))) v4i16_t*)p)); }
__device__ __forceinline__ float rowmax(const f32x16&p0,const f32x16&p1){
  float a=max3f(p0[0],p0[1],p1[0]),b=max3f(p0[2],p0[3],p1[1]);a=max3f(a,p1[2],p1[3]);
  #pragma unroll
  for(int r=4;r<16;r+=4){a=max3f(a,p0[r],p0[r+1]);b=max3f(b,p0[r+2],p0[r+3]);a=max3f(a,p1[r],p1[r+1]);b=max3f(b,p1[r+2],p1[r+3]);}
  const float m=max2f(a,b);
  auto rr=__builtin_amdgcn_permlane32_swap(__float_as_uint(m),__float_as_uint(m),false,false);
  return max2f(__uint_as_float(rr[0]),__uint_as_float(rr[1]));
}
__device__ __forceinline__ void pv(f32x16*o,int vb,bf16x8 pa0,bf16x8 pa1,bf16x8 pa2,bf16x8 pa3){
  #pragma unroll
  for(int d0=0;d0<2;++d0){s16x4 lo[4],hi[4];
    #pragma unroll
    for(int ks=0;ks<4;++ks){
      asm volatile("ds_read_b64_tr_b16 %0,%1 offset:%c2":"=&v"(lo[ks]):"v"(vb),"i"(d0*4096+ks*1024):"memory");
      asm volatile("ds_read_b64_tr_b16 %0,%1 offset:%c2":"=&v"(hi[ks]):"v"(vb),"i"(d0*4096+ks*1024+512):"memory");}
    asm volatile("s_waitcnt lgkmcnt(0)":::"memory");SBAR();
    #define PK(k) (bf16x8){lo[k][0],lo[k][1],lo[k][2],lo[k][3],hi[k][0],hi[k][1],hi[k][2],hi[k][3]}
    o[d0]=__builtin_amdgcn_mfma_f32_32x32x16_bf16(pa0,PK(0),o[d0],0,0,0);
    o[d0]=__builtin_amdgcn_mfma_f32_32x32x16_bf16(pa1,PK(1),o[d0],0,0,0);
    o[d0]=__builtin_amdgcn_mfma_f32_32x32x16_bf16(pa2,PK(2),o[d0],0,0,0);
    o[d0]=__builtin_amdgcn_mfma_f32_32x32x16_bf16(pa3,PK(3),o[d0],0,0,0);
    #undef PK
  }
}

#ifndef ATTN_STORE16
#define ATTN_STORE16(p,v) (*(u32x4*)(p)=(v))
#endif
template<int THRL> __device__ __forceinline__ void attn_unit(const int b,const int NT,const bf16*Qw0,const int qpitch,const bf16*__restrict__ Kh,const bf16*__restrict__ Vh,const int kvpitch,bf16*Ow0,const int opitch,char*shm){
  const int tid=tid_fresh(),lane=tid&63,r32=lane&31,hi=lane>>5; const int wid=__builtin_amdgcn_readfirstlane(tid>>6);
  const bf16*Qw=Qw0+(long)(wid*QBLK)*qpitch;
  const unsigned lds0=(unsigned)(uintptr_t)shm;
  float*wsf=(float*)(shm+LDS_WS)+wid*64;
  const bf16*ksrc=Kh+(long)lane*kvpitch+wid*8;
  const bf16*vsrc=Vh+(long)(16*(wid&3)+(lane>>2))*kvpitch+(wid>>2)*32+(lane&3)*8;
  const unsigned kdst=lds0+LDS_K+wid*1024, vdst=lds0+LDS_V+wid*1024;
  #define KROW(t) ((long)((t)<4 ? b*256+64*(t) : 2048+b*4096+64*((t)-4)))
  #define DMA_K(t,slot) glds16(ksrc+KROW(t)*kvpitch,(unsigned)__builtin_amdgcn_readfirstlane(kdst+(slot)))
  #define DMA_V(t,slot) glds16(vsrc+KROW(t)*kvpitch,(unsigned)__builtin_amdgcn_readfirstlane(vdst+(slot)))
  const int vb0=(int)(lds0+LDS_V)+((lane>>4)&1)*32+(lane&3)*8+(4*hi+((lane&15)>>2))*64;
  const char*Kbase=shm+LDS_K; bf16x8 kf[8];
  const lds_cptr shm3=(lds_cptr)shm; const lds_cptr kp0=shm3+LDS_K+hi*1024+r32*16; const lds_cptr vp0=shm3+LDS_V+((lane>>4)&1)*32+(lane&3)*8+(4*hi+((lane&15)>>2))*64;
  DMA_K(0,0);DMA_V(0,0);DMA_K(1,SLOTB);
  bf16x8 qr[4];
  #pragma unroll
  for(int d0=0;d0<4;++d0)qr[d0]=*reinterpret_cast<const bf16x8*>(&Qw[(long)r32*qpitch+d0*16+hi*8]);
  float mhat=0.f,l_reg=0.f;f32x16 o[2];o[0]=f32x16{};o[1]=f32x16{};f32x16 negm=f32x16{};asm volatile("":"+v"(negm));
  #define CMASK(P0,P1,t) do{}while(0)
  bool resc=false;
  #define START(P0,P1) do{ const float rm=rowmax(P0,P1); resc=false; \
    { const float dl=rm; mhat=fadd_s(mhat,dl); \
      _Pragma("unroll") for(int r=0;r<16;++r){P0[r]=fsub_s(P0[r],dl);P1[r]=fsub_s(P1[r],dl);} \
      _Pragma("unroll") for(int r=0;r<16;++r)negm[r]=-mhat; asm volatile("":"+v"(negm)); } \
    _Pragma("unroll") for(int r=0;r<16;++r)P0[r]=__builtin_amdgcn_exp2f(P0[r]); }while(0)
  #define RESC() do{ if(resc){ asm volatile("s_waitcnt lgkmcnt(0)":::"memory"); \
      _Pragma("unroll") for(int d_=0;d_<2;++d_) _Pragma("unroll") for(int r=0;r<16;++r)o[d_][r]*=wsf[crow(r,hi)]; } }while(0)
  f32x16 pA0,pA1,pB0,pB1;
  int sl_prev=0,sl_cur=0,sl_next=SLOTB;
  #define ROT() do{sl_prev=sl_cur;sl_cur=sl_next;sl_next=(sl_next==(NSLOT-1)*SLOTB)?0:sl_next+SLOTB;}while(0)
  DMA_K(2,2*SLOTB);
  WAIT_BAR(3);
  qkt(pA0,pA1,Kbase,qr,negm,r32,hi);asm volatile("s_nop 15\n\ts_nop 7":"+v"(pA0),"+v"(pA1));CMASK(pA0,pA1,0);
  START(pA0,pA1);
  _Pragma("unroll") for(int r=0;r<16;++r)pA1[r]=__builtin_amdgcn_exp2f(pA1[r]);
  WAIT_BAR(0);
  DMA_K(3,0);DMA_V(1,SLOTB);
  ROT();
  kload8(kf,kp0+sl_cur);
  WAIT_BAR(2);
  s16x4 vlo[8],vhi[8]; u32x4 pw0,pw1,pw2,pw3;
  #define PKW(P,B) cvtpk_s(P[B],P[B+1])
  #define PAF(k) __builtin_bit_cast(bf16x8,pw##k)
  #define VFR(i) (bf16x8){vlo[i][0],vlo[i][1],vlo[i][2],vlo[i][3],vhi[i][0],vhi[i][1],vhi[i][2],vhi[i][3]}
  #define PIN(x) asm volatile("":"+v"(x))
  #define MX3(a,b,c) __builtin_fmaxf(__builtin_fmaxf((a),(b)),(c))
  #define GAPA(MF,A0,A1,A2,A3,W0,W1,PW) do{ MF; sacc+=A0; sacc+=A1; sacc+=A2; sacc+=A3; PIN(sacc); W0; W1; PIN(PW); SBAR(); }while(0)
  #define EX(v) __builtin_amdgcn_exp2f(v)
  #define GAPB(MF,X,B) do{ MF; X[B]=EX(X[B]); X[B+1]=EX(X[B+1]); X[B+2]=EX(X[B+2]); X[B+3]=EX(X[B+3]); PIN(X); SBAR(); }while(0)
  #define VRD(i) do{ vlo[i]=vtr(vp_+(((i)>>2)*4096+((i)&3)*1024)); vhi[i]=vtr(vp_+(((i)>>2)*4096+((i)&3)*1024+512)); }while(0)
  #define KRD(G,j) do{ if(G){ kload2(kf,kp0+sl_next,j); SBAR(); } }while(0)
  #define STEP(C0,C1,P0,P1,t,GK,GV,GL) do{ SBAR(); \
    const lds_cptr vp_=vp0+sl_prev; \
    VRD(0); SBAR(); float sacc=(P0[0]+P0[1]); \
    GAPA(C0=__builtin_amdgcn_mfma_f32_32x32x16_bf16(kf[0],qr[0],negm,0,0,0), P0[2],P0[3],P0[4],P0[5],     pw0[0]=PKW(P0,0), pw0[1]=PKW(P0,2), pw0); \
    VRD(4); SBAR(); GAPA(C1=__builtin_amdgcn_mfma_f32_32x32x16_bf16(kf[1],qr[0],negm,0,0,0), P0[6],P0[7],P0[8],P0[9],     pw0[2]=PKW(P0,4), pw0[3]=PKW(P0,6), pw0); \
    VRD(1); SBAR(); GAPA(C0=__builtin_amdgcn_mfma_f32_32x32x16_bf16(kf[2],qr[1],C0,0,0,0),   P0[10],P0[11],P0[12],P0[13], pw1[0]=PKW(P0,8), pw1[1]=PKW(P0,10), pw1); \
    VRD(5); SBAR(); GAPA(C1=__builtin_amdgcn_mfma_f32_32x32x16_bf16(kf[3],qr[1],C1,0,0,0),   P0[14],P0[15],P1[0],P1[1],   pw1[2]=PKW(P0,12),pw1[3]=PKW(P0,14), pw1); \
    VRD(2); SBAR(); GAPA(C0=__builtin_amdgcn_mfma_f32_32x32x16_bf16(kf[4],qr[2],C0,0,0,0),   P1[2],P1[3],P1[4],P1[5],     pw2[0]=PKW(P1,0), pw2[1]=PKW(P1,2), pw2); \
    VRD(6); SBAR(); GAPA(C1=__builtin_amdgcn_mfma_f32_32x32x16_bf16(kf[5],qr[2],C1,0,0,0),   P1[6],P1[7],P1[8],P1[9],     pw2[2]=PKW(P1,4), pw2[3]=PKW(P1,6), pw2); \
    VRD(3); SBAR(); GAPA(C0=__builtin_amdgcn_mfma_f32_32x32x16_bf16(kf[6],qr[3],C0,0,0,0),   P1[10],P1[11],P1[12],P1[13], pw3[0]=PKW(P1,8), pw3[1]=PKW(P1,10), pw3); \
    VRD(7); SBAR(); GAPA(C1=__builtin_amdgcn_mfma_f32_32x32x16_bf16(kf[7],qr[3],C1,0,0,0),   P1[14],P1[15],0.f,0.f,       pw3[2]=PKW(P1,12),pw3[3]=PKW(P1,14), pw3); \
    l_reg+=sacc; \
    if(GK){DMA_K((t)+3,sl_cur);} if(GV){DMA_V((t)+1,sl_next);} \
    CMASK(C0,C1,t); \
    { float a=MX3(C0[0],C0[1],C1[0]),b=MX3(C0[2],C0[3],C1[1]); a=MX3(a,C1[2],C1[3]); \
      _Pragma("unroll") for(int r=4;r<16;r+=4){a=MX3(a,C0[r],C0[r+1]);b=MX3(b,C0[r+2],C0[r+3]);a=MX3(a,C1[r],C1[r+1]);b=MX3(b,C1[r+2],C1[r+3]);} \
      float rm=__builtin_fmaxf(a,b); { auto rr=__builtin_amdgcn_permlane32_swap(__float_as_uint(rm),__float_as_uint(rm),false,false); rm=__builtin_fmaxf(__uint_as_float(rr[0]),__uint_as_float(rr[1])); } \
      resc=false; \
      if(__builtin_expect(__any(rm>(float)THRL),0)){ const float dl=__builtin_fmaxf(rm,0.f); mhat+=dl; \
        _Pragma("unroll") for(int r=0;r<16;++r){C0[r]-=dl;C1[r]-=dl;} \
        _Pragma("unroll") for(int r=0;r<16;++r)negm[r]=-mhat; asm volatile("":"+v"(negm)); \
        const float f=__builtin_amdgcn_exp2f(-dl); l_reg*=f; if(hi==0)wsf[r32]=f; resc=true; } } \
    SBAR(); \
    GAPB(o[0]=__builtin_amdgcn_mfma_f32_32x32x16_bf16(PAF(0),VFR(0),o[0],0,0,0), C0,0); \
    GAPB(o[1]=__builtin_amdgcn_mfma_f32_32x32x16_bf16(PAF(0),VFR(4),o[1],0,0,0), C0,4); \
    KRD(GL,0); GAPB(o[0]=__builtin_amdgcn_mfma_f32_32x32x16_bf16(PAF(1),VFR(1),o[0],0,0,0), C0,8); \
    KRD(GL,1); GAPB(o[1]=__builtin_amdgcn_mfma_f32_32x32x16_bf16(PAF(1),VFR(5),o[1],0,0,0), C0,12); \
    KRD(GL,2); GAPB(o[0]=__builtin_amdgcn_mfma_f32_32x32x16_bf16(PAF(2),VFR(2),o[0],0,0,0), C1,0); \
    KRD(GL,3); GAPB(o[1]=__builtin_amdgcn_mfma_f32_32x32x16_bf16(PAF(2),VFR(6),o[1],0,0,0), C1,4); \
    GAPB(o[0]=__builtin_amdgcn_mfma_f32_32x32x16_bf16(PAF(3),VFR(3),o[0],0,0,0), C1,8); \
    GAPB(o[1]=__builtin_amdgcn_mfma_f32_32x32x16_bf16(PAF(3),VFR(7),o[1],0,0,0), C1,12); \
    }while(0)
  int t=1;
  #undef CMASK
  #define CMASK(P0,P1,t) do{}while(0)
  for(;t+5<NT;t+=2){
    STEP(pB0,pB1,pA0,pA1,t,true,true,true);     WAIT_BAR(2); RESC(); ROT();
    STEP(pA0,pA1,pB0,pB1,t+1,true,true,true);   WAIT_BAR(2); RESC(); ROT();
  }
  #undef CMASK
  #define CMASK(P0,P1,t) do{}while(0)
  #define ENDW(tt) do{ if((tt)+3<NT){WAIT_BAR(2);} else if((tt)+2<NT){WAIT_BAR(1);} else {WAIT_BAR(0);} }while(0)
  for(;t+1<NT;t+=2){
    STEP(pB0,pB1,pA0,pA1,t,(t+3<NT),(t+1<NT),(t+1<NT));       ENDW(t);   RESC(); ROT();
    STEP(pA0,pA1,pB0,pB1,t+1,(t+4<NT),(t+2<NT),(t+2<NT));     ENDW(t+1); RESC(); ROT();
  }
  STEP(pB0,pB1,pA0,pA1,NT-1,false,false,false); RESC();
  { float sacc=pB0[0]+pB0[1]; _Pragma("unroll") for(int r=2;r<16;++r)sacc+=pB0[r]; _Pragma("unroll") for(int r=0;r<16;++r)sacc+=pB1[r]; l_reg+=sacc;
    pw0=(u32x4){PKW(pB0,0),PKW(pB0,2),PKW(pB0,4),PKW(pB0,6)};pw1=(u32x4){PKW(pB0,8),PKW(pB0,10),PKW(pB0,12),PKW(pB0,14)};pw2=(u32x4){PKW(pB1,0),PKW(pB1,2),PKW(pB1,4),PKW(pB1,6)};pw3=(u32x4){PKW(pB1,8),PKW(pB1,10),PKW(pB1,12),PKW(pB1,14)};
    SBAR(); pv(o,vb0+sl_cur,PAF(0),PAF(1),PAF(2),PAF(3)); }
  #undef PKW
  #undef PAF
  #undef VFR
  #undef PIN
  #undef MX3
  #undef GAPA
  #undef GAPB
  #undef EX
  #undef VRD
  #undef KRD
  #undef STEP
  #undef ENDW
  {auto rr=__builtin_amdgcn_permlane32_swap(__float_as_uint(l_reg),__float_as_uint(l_reg),false,false);l_reg=__uint_as_float(rr[0])+__uint_as_float(rr[1]);}
  if(hi==0)wsf[32+r32]=l_reg;asm volatile("s_waitcnt lgkmcnt(0)":::"memory");
  float rli[16];
  #pragma unroll
  for(int r=0;r<16;++r)rli[r]=__builtin_amdgcn_rcpf(wsf[32+crow(r,hi)]);
  bf16*Ow=Ow0+(long)(wid*QBLK)*opitch;
  { bf16*stg=(bf16*)(shm+LDS_OST)+wid*2048;
    #pragma unroll
    for(int r=0;r<16;++r){const int orow=crow(r,hi);
      #pragma unroll
      for(int d0=0;d0<2;++d0)stg[orow*64+d0*32+r32]=__float2bfloat16(o[d0][r]*rli[r]);}
    asm volatile("s_waitcnt lgkmcnt(0)":::"memory");
    #pragma unroll
    for(int i=0;i<4;++i){const int row=i*8+(lane>>3),ch=lane&7; const u32x4 v=*(const u32x4*)(stg+row*64+ch*8); ATTN_STORE16(Ow+(long)row*opitch+ch*8,v);} }
  asm volatile("s_waitcnt lgkmcnt(0)\n\ts_barrier":::"memory");
  #undef DMA_K
  #undef KROW
  #undef DMA_V
  #undef CMASK
  #undef START
  #undef RESC
  #undef ROT
}
constexpr int ATTN_LDS_BYTES=LDS_BYTES;
#undef SBAR
#undef WAIT_BAR
}
#define LAS __attribute__((address_space(3)))
typedef unsigned short bfs;
typedef float f32x4 __attribute__((ext_vector_type(4)));
typedef float f32x16 __attribute__((ext_vector_type(16)));
typedef unsigned u32x4 __attribute__((ext_vector_type(4)));
typedef unsigned u32x2 __attribute__((ext_vector_type(2)));
typedef short s16x8 __attribute__((ext_vector_type(8)));
constexpr int DM = 1024, NB = 8, SEQ = 4096, NCTX = 256;
constexpr int RCTX = NB * NCTX, RLAT = NB * SEQ, ROWS = RCTX + RLAT;
constexpr int DFF = 2816, NGU = 2 * DFF;
constexpr int NIN0 = 2336, PIN0 = 2560, NIN1 = 5120;
constexpr int C_GQ = 0, C_GK = 256, C_GV = 512, C_GOG = 1024, C_GZ = 1536, C_AQ = 1568, C_AK = 2080, C_AV = 2208;
constexpr int C_FQ = 0, C_FF = 1024, C_FI = 3072, C_FOG = 4096;
constexpr float RMS_EPS = 1e-6f;
constexpr size_t MiB = 1u << 20;
constexpr size_t WS_CTL = 0, CTL_BYTES = 65536;
constexpr size_t WS_MOD = 1 * MiB;
constexpr size_t WS_LB = WS_MOD + 512 * 1024;
constexpr size_t WS_XCTX = 2 * MiB;
constexpr size_t WS_WIN0 = 10 * MiB, WS_WOUT0 = 15 * MiB, WS_WGU0 = 17 * MiB, WS_WD0 = 28 * MiB;
constexpr size_t WS_WIN1 = 34 * MiB, WS_WOUT1 = 44 * MiB, WS_WGU1 = 46 * MiB, WS_WD1 = 57 * MiB;
constexpr size_t WS_C = 64 * MiB;
constexpr size_t WS_D = 132 * MiB;
constexpr size_t WS_Y = WS_D + 192 * MiB;
constexpr size_t WS_E0 = WS_D + 260 * MiB;
constexpr size_t WS_END = WS_D + 340 * MiB + 40 * MiB;
constexpr int OSPLIT = 16384;
static_assert(WS_WD1 + (size_t)DM * DFF * 2 <= WS_C && WS_C + (size_t)ROWS * DM * 2 <= WS_D && (size_t)ROWS * DFF * 2 <= 192 * MiB && (size_t)ROWS * NIN1 * 2 <= 340 * MiB, "ws map");
constexpr int LDS_CTL_OFF = 153600, LDS_BYTES = 154112;
constexpr int NWAVES = 8, NTHR = 512;

__device__ __forceinline__ float bf2f(unsigned h) { return __uint_as_float(h << 16); }
__device__ __forceinline__ unsigned f2bf(float f) { unsigned u = __float_as_uint(f); return (u + 0x7fffu + ((u >> 16) & 1u)) >> 16; }
__device__ __forceinline__ unsigned pk2(float lo, float hi) { return pg8::cvt_pk_bf16(lo, hi); }
__device__ __forceinline__ float dpp_ror(float x, const int n) {
    switch (n) {
    case 8: return __int_as_float(__builtin_amdgcn_update_dpp(0, __float_as_int(x), 0x128, 0xf, 0xf, false));
    case 4: return __int_as_float(__builtin_amdgcn_update_dpp(0, __float_as_int(x), 0x124, 0xf, 0xf, false));
    case 2: return __int_as_float(__builtin_amdgcn_update_dpp(0, __float_as_int(x), 0x122, 0xf, 0xf, false));
    default: return __int_as_float(__builtin_amdgcn_update_dpp(0, __float_as_int(x), 0x121, 0xf, 0xf, false));
    }
}
__device__ __forceinline__ float wave_sum(float v) {
    v += dpp_ror(v, 8); v += dpp_ror(v, 4); v += dpp_ror(v, 2); v += dpp_ror(v, 1);
    const int vi = __float_as_int(v);
    const float r0 = __int_as_float(__builtin_amdgcn_readlane(vi, 0)), r1 = __int_as_float(__builtin_amdgcn_readlane(vi, 16)), r2 = __int_as_float(__builtin_amdgcn_readlane(vi, 32)), r3 = __int_as_float(__builtin_amdgcn_readlane(vi, 48));
    return (r0 + r1) + (r2 + r3);
}
__device__ __forceinline__ float siluf(float x) { return x * __builtin_amdgcn_rcpf(1.f + __expf(-x)); }

struct Args { const float* in[24]; float* out; unsigned char* ws; };

__device__ __forceinline__ void p0_transpose_item(const float* W, int K, int N, bfs* WT, int k0, int n0, int drow0, LAS float* scr, int lane) {
    float tv[32];
#pragma unroll
    for (int i = 0; i < 32; ++i) tv[i] = W[(size_t)(k0 + 2 * i + (lane >> 5)) * N + n0 + (lane & 31)];
#pragma unroll
    for (int i = 0; i < 32; ++i) scr[(2 * i + (lane >> 5)) * 33 + (lane & 31)] = tv[i];
    asm volatile("s_waitcnt lgkmcnt(0)" ::: "memory");
    const int c = lane & 7;
#pragma unroll
    for (int j = 0; j < 4; ++j) { const int n = (lane >> 3) + 8 * j; const LAS float* s = scr + (8 * c) * 33 + n;
        u32x4 o; o.x = pk2(s[0 * 33], s[1 * 33]); o.y = pk2(s[2 * 33], s[3 * 33]); o.z = pk2(s[4 * 33], s[5 * 33]); o.w = pk2(s[6 * 33], s[7 * 33]);
        *(u32x4*)(WT + (size_t)(drow0 + n) * K + k0 + 8 * c) = o; }
    asm volatile("s_waitcnt lgkmcnt(0)" ::: "memory");
}
__device__ __forceinline__ bool p0_try(int& r, const float* W, int K, int N, bfs* WT, int mode  , LAS float* scr, int lane) {
    const int nblk = N / 32, cnt = (K / 64) * nblk;
    if (r >= cnt) { r -= cnt; return false; }
    const int kb = r / nblk, nb = r % nblk, n0 = 32 * nb;
    const int drow0 = mode == 0 ? n0 : ((n0 >> 7) * 256 + (n0 & 127) + (mode == 2 ? 128 : 0));
    p0_transpose_item(W, K, N, WT, 64 * kb, n0, drow0, scr, lane);
    return true;
}
constexpr int P0_I_IN0 = 16 * (NIN0 / 32), P0_I_SQ = 16 * 32, P0_I_G = 16 * (DFF / 32), P0_I_D = (DFF / 64) * 32, P0_I_IN1 = 16 * (NIN1 / 32);
constexpr int P0_NA = P0_I_IN0 + P0_I_SQ + 2 * P0_I_G + P0_I_D + P0_I_IN1, P0_NITEMS = P0_NA + P0_I_SQ + 2 * P0_I_G + P0_I_D;
__device__ __forceinline__ void p0_weights(const Args& a, LAS unsigned char* lds, int it_lo, int it_hi, int gw, int NGW) {
    const int tid = tid_fresh(), lane = tid & 63, wave = tid >> 6;
    unsigned char* ws = a.ws;
    LAS float* scr = (LAS float*)(lds + wave * 16384);
    for (int it = it_lo + gw; it < it_hi; it += NGW) {
        int r = it;
        if (p0_try(r, a.in[10], 1024, NIN0, (bfs*)(ws + WS_WIN0), 0, scr, lane)) continue;
        if (p0_try(r, a.in[16], 1024, 1024, (bfs*)(ws + WS_WOUT0), 0, scr, lane)) continue;
        if (p0_try(r, a.in[21], 1024, DFF, (bfs*)(ws + WS_WGU0), 1, scr, lane)) continue;
        if (p0_try(r, a.in[22], 1024, DFF, (bfs*)(ws + WS_WGU0), 2, scr, lane)) continue;
        if (p0_try(r, a.in[23], DFF, 1024, (bfs*)(ws + WS_WD0), 0, scr, lane)) continue;
        if (p0_try(r, a.in[17], 1024, NIN1, (bfs*)(ws + WS_WIN1), 0, scr, lane)) continue;
        if (p0_try(r, a.in[20], 1024, 1024, (bfs*)(ws + WS_WOUT1), 0, scr, lane)) continue;
        if (p0_try(r, a.in[21] + (size_t)1024 * DFF, 1024, DFF, (bfs*)(ws + WS_WGU1), 1, scr, lane)) continue;
        if (p0_try(r, a.in[22] + (size_t)1024 * DFF, 1024, DFF, (bfs*)(ws + WS_WGU1), 2, scr, lane)) continue;
        p0_try(r, a.in[23] + (size_t)DFF * 1024, DFF, 1024, (bfs*)(ws + WS_WD1), 0, scr, lane);
    }
}
__device__ __forceinline__ void p0_phase(const Args& a, LAS unsigned char* lds, int G) {
    const int tid = tid_fresh(), lane = tid & 63, wave = tid >> 6;
    unsigned char* ws = a.ws;
    {
        LAS float* sc = (LAS float*)lds;
        LAS float* red = (LAS float*)(lds + 40960);
        for (int i = tid; i < 9 * 1024; i += NTHR) { const float v = i < 8192 ? a.in[1][i] : a.in[3][i - 8192]; sc[i] = siluf(v); }
        __syncthreads();
        float* MOD = (float*)(ws + WS_MOD);
        for (int it = blockIdx.x; it < 192; it += G) {
            const int l = it / 96, cb = it % 96, col = cb * 64 + lane;
            const float* w = a.in[4] + (size_t)l * 1024 * 6144 + (size_t)(wave * 128) * 6144 + col;
            float acc[9];
#pragma unroll
            for (int bb = 0; bb < 9; ++bb) acc[bb] = 0.f;
            for (int k0 = 0; k0 < 128; k0 += 32) {
                float wv[32];
#pragma unroll
                for (int j = 0; j < 32; ++j) wv[j] = w[(size_t)(k0 + j) * 6144];
#pragma unroll
                for (int j = 0; j < 32; ++j)
#pragma unroll
                    for (int bb = 0; bb < 9; ++bb) acc[bb] += sc[bb * 1024 + wave * 128 + k0 + j] * wv[j];
            }
#pragma unroll
            for (int bb = 0; bb < 9; ++bb) red[(wave * 9 + bb) * 64 + lane] = acc[bb];
            __syncthreads();
            for (int i = tid; i < 9 * 64; i += NTHR) { float s = 0.f;
#pragma unroll
                for (int w8 = 0; w8 < 8; ++w8) s += red[w8 * 576 + i];
                const int bb = i / 64, c = cb * 64 + (i & 63);
                MOD[((size_t)l * 9 + bb) * 6144 + c] = s + a.in[5][l * 6144 + c]; }
            __syncthreads();
        }
        float* LB = (float*)(ws + WS_LB);
        for (int i = blockIdx.x * NTHR + tid; i < 2048; i += G * NTHR) { const int d = i >> 10, f = i & 1023; const float x0 = a.in[18][d * 2048 + f], x1 = a.in[18][d * 2048 + 1024 + f]; LB[i] = 1.f / (1.f + __expf(x0 - x1)); }
        { u32x4* z = (u32x4*)(ws + WS_WIN0 + (size_t)NIN0 * 1024 * 2); const int n16 = (PIN0 - NIN0) * 1024 * 2 / 16;
          for (int i = blockIdx.x * NTHR + tid; i < n16; i += G * NTHR) z[i] = (u32x4){0u, 0u, 0u, 0u}; }
        __syncthreads();
    }
    p0_weights(a, lds, 0, (G >= 256) ? P0_NA : P0_NITEMS, blockIdx.x * NWAVES + wave, G * NWAVES);
}

struct RowOp {
    const void* xin_lat; const void* xin_ctx; void* xout_lat; void* xout_ctx;
    const bfs* y; const float* gpost; const float* modg; int gate_idx;
    bfs* h; const float* gpre; const float* modh; int shift_idx, scale_idx;
    int row_lo; int xin_bf, xout_bf;
};
__device__ __forceinline__ void row_phase(const RowOp op, int G, int row_lo_ = -1, int row_hi_ = ROWS, int blk_ = -1, int nblk_ = 0) {
    const int tid_ = tid_fresh(); const int lane = tid_ & 63, wave = tid_ >> 6;
    const int rlo = row_lo_ < 0 ? op.row_lo : row_lo_;
    const int gw = (blk_ < 0 ? (int)blockIdx.x : blk_) * NWAVES + wave, NGW = (blk_ < 0 ? G : nblk_) * NWAVES;
    const int rpw = (row_hi_ - rlo + NGW - 1) / NGW;
    const int r0 = rlo + gw * rpw, r1 = (r0 + rpw < row_hi_) ? r0 + rpw : row_hi_;
    if (r0 >= r1) return;
    f32x4 gp[4], gpre[4], gt[4], sh[4], sc[4];
#pragma unroll
    for (int j = 0; j < 4; ++j) { const int c = 4 * lane + 256 * j; gp[j] = op.y ? *(const f32x4*)(op.gpost + c) : (f32x4){0.f, 0.f, 0.f, 0.f}; gpre[j] = op.h ? *(const f32x4*)(op.gpre + c) : (f32x4){0.f, 0.f, 0.f, 0.f};
        gt[j] = sh[j] = sc[j] = (f32x4){0.f, 0.f, 0.f, 0.f}; }
    int cur_bb = -1;
    f32x4 xn[4]; u32x2 xnb[4], yn[4];
#pragma unroll
    for (int j = 0; j < 4; ++j) { xn[j] = (f32x4){0.f, 0.f, 0.f, 0.f}; xnb[j] = (u32x2){0u, 0u}; }
#define ROW_LOAD(r) do { const bool ic_ = (r) < RCTX; const size_t ro_ = ic_ ? (size_t)(r) * DM : (size_t)((r) - RCTX) * DM; const void* xb_ = ic_ ? op.xin_ctx : op.xin_lat; \
        if (op.xin_bf) { _Pragma("unroll") for (int j = 0; j < 4; ++j) xnb[j] = *(const u32x2*)((const bfs*)xb_ + ro_ + 4 * lane + 256 * j); } \
        else { _Pragma("unroll") for (int j = 0; j < 4; ++j) xn[j] = *(const f32x4*)((const float*)xb_ + ro_ + 4 * lane + 256 * j); } \
        _Pragma("unroll") for (int j = 0; j < 4; ++j) yn[j] = op.y ? *(const u32x2*)(op.y + (size_t)(r) * DM + 4 * lane + 256 * j) : (u32x2){0u, 0u}; } while (0)
    ROW_LOAD(r0);
    for (int r = r0; r < r1; ++r) {
        const bool isctx = r < RCTX; const int bb = isctx ? 8 : (r - RCTX) / SEQ;
        f32x4 v[4]; u32x2 yw[4];
#pragma unroll
        for (int j = 0; j < 4; ++j) { v[j] = op.xin_bf ? (f32x4){bf2f(xnb[j].x & 0xffffu), bf2f(xnb[j].x >> 16), bf2f(xnb[j].y & 0xffffu), bf2f(xnb[j].y >> 16)} : xn[j]; yw[j] = yn[j]; }
        if (r + 1 < r1) ROW_LOAD(r + 1);
        if (bb != cur_bb) { cur_bb = bb;
#pragma unroll
            for (int j = 0; j < 4; ++j) { const int c = 4 * lane + 256 * j;
                if (op.y) gt[j] = *(const f32x4*)(op.modg + (size_t)bb * 6144 + op.gate_idx * 1024 + c);
                if (op.h) { sh[j] = *(const f32x4*)(op.modh + (size_t)bb * 6144 + op.shift_idx * 1024 + c); sc[j] = *(const f32x4*)(op.modh + (size_t)bb * 6144 + op.scale_idx * 1024 + c) + 1.f; } } }
        if (op.y) {
            f32x4 yv[4]; float ss = 0.f;
#pragma unroll
            for (int j = 0; j < 4; ++j) { yv[j] = (f32x4){bf2f(yw[j].x & 0xffffu), bf2f(yw[j].x >> 16), bf2f(yw[j].y & 0xffffu), bf2f(yw[j].y >> 16)};
                ss += (yv[j].x * yv[j].x + yv[j].y * yv[j].y) + (yv[j].z * yv[j].z + yv[j].w * yv[j].w); }
            const float rinv = rsqrtf(wave_sum(ss) * (1.f / DM) + RMS_EPS);
            void* xob = isctx ? op.xout_ctx : op.xout_lat; const size_t xoo = isctx ? (size_t)r * DM : (size_t)(r - RCTX) * DM;
#pragma unroll
            for (int j = 0; j < 4; ++j) { v[j] = v[j] + gt[j] * (yv[j] * rinv * gp[j]);
                if (xob) { if (op.xout_bf) { u32x2 wx; wx.x = pk2(v[j].x, v[j].y); wx.y = pk2(v[j].z, v[j].w); *(u32x2*)((bfs*)xob + xoo + 4 * lane + 256 * j) = wx;
                        v[j] = (f32x4){bf2f(wx.x & 0xffffu), bf2f(wx.x >> 16), bf2f(wx.y & 0xffffu), bf2f(wx.y >> 16)}; }
                    else *(f32x4*)((float*)xob + xoo + 4 * lane + 256 * j) = v[j]; } }
        }
        if (op.h) {
            float ss = 0.f;
#pragma unroll
            for (int j = 0; j < 4; ++j) ss += (v[j].x * v[j].x + v[j].y * v[j].y) + (v[j].z * v[j].z + v[j].w * v[j].w);
            const float rinv = rsqrtf(wave_sum(ss) * (1.f / DM) + RMS_EPS);
#pragma unroll
            for (int j = 0; j < 4; ++j) { const f32x4 hv = (v[j] * rinv * gpre[j]) * sc[j] + sh[j];
                u32x2 w; w.x = pk2(hv.x, hv.y); w.y = pk2(hv.z, hv.w);
                *(u32x2*)(op.h + (size_t)r * DM + 4 * lane + 256 * j) = w; }
        }
    }
#undef ROW_LOAD
}

__device__ __forceinline__ void qk_phase(bfs* proj, const float* gq, const float* gk, int G) {
    const int tid_ = tid_fresh(); const int lane = tid_ & 63, wave = tid_ >> 6;
    const int gw = blockIdx.x * NWAVES + wave, NGW = G * NWAVES;
    const int sub = lane & 7;
    float gqv[8], gkv[8], inv[4];
#pragma unroll
    for (int e = 0; e < 8; ++e) { gqv[e] = gq[8 * sub + e]; gkv[e] = gk[8 * sub + e]; }
#pragma unroll
    for (int p = 0; p < 4; ++p) { const int pi = (4 * sub + p) & 15; inv[p] = exp2f(-(float)(2 * pi) * (13.287712379549449f / 32.f)); }
    const int rpw = (ROWS + NGW - 1) / NGW; const int r0 = gw * rpw, r1 = (r0 + rpw < ROWS) ? r0 + rpw : ROWS;
    u32x4 qn = (u32x4){0u, 0u, 0u, 0u}, kn = qn;
    if (r0 < r1) { qn = *(const u32x4*)(proj + (size_t)r0 * PIN0 + C_AQ + 8 * lane); kn = *(const u32x4*)(proj + (size_t)r0 * PIN0 + C_AK + 8 * (lane & 15)); }
    for (int r = r0; r < r1; ++r) {
        const bool lat = r >= RCTX; const int t = lat ? (r - RCTX) % SEQ : 0;
        const float pos = (sub < 4) ? (float)(t >> 6) : (float)(t & 63);
        float cs[4], sn[4];
#pragma unroll
        for (int p = 0; p < 4; ++p) { if (lat) { const float ang = pos * inv[p]; cs[p] = __cosf(ang); sn[p] = __sinf(ang);     } else { cs[p] = 1.f; sn[p] = 0.f; } }
        bfs* qp = proj + (size_t)r * PIN0 + C_AQ + 8 * lane;
        bfs* kp = proj + (size_t)r * PIN0 + C_AK + 8 * (lane & 15);
        const u32x4 qw = qn; const u32x4 kw = kn;
        if (r + 1 < r1) { qn = *(const u32x4*)(qp + PIN0); kn = *(const u32x4*)(kp + PIN0); }
        float q[8], k[8]; float sq = 0.f, sk = 0.f;
#pragma unroll
        for (int e = 0; e < 4; ++e) { q[2 * e] = bf2f(qw[e] & 0xffffu); q[2 * e + 1] = bf2f(qw[e] >> 16); k[2 * e] = bf2f(kw[e] & 0xffffu); k[2 * e + 1] = bf2f(kw[e] >> 16); }
#pragma unroll
        for (int e = 0; e < 8; ++e) { sq += q[e] * q[e]; sk += k[e] * k[e]; }
#pragma unroll
        for (int o = 1; o < 8; o <<= 1) { sq += __shfl_xor(sq, o); sk += __shfl_xor(sk, o); }
        const float rq = rsqrtf(sq * (1.f / 64.f) + RMS_EPS) , rk = rsqrtf(sk * (1.f / 64.f) + RMS_EPS);
        const float C2 = 0.125f * 1.4426950408889634f;
        u32x4 qo, ko;
#pragma unroll
        for (int p = 0; p < 4; ++p) {
            const float q0 = q[2 * p] * rq * gqv[2 * p], q1 = q[2 * p + 1] * rq * gqv[2 * p + 1];
            const float k0 = k[2 * p] * rk * gkv[2 * p], k1 = k[2 * p + 1] * rk * gkv[2 * p + 1];
            qo[p] = pk2((q0 * cs[p] - q1 * sn[p]) * C2, (q0 * sn[p] + q1 * cs[p]) * C2);
            ko[p] = pk2(k0 * cs[p] - k1 * sn[p], k0 * sn[p] + k1 * cs[p]);
        }
        *(u32x4*)qp = qo;
        if (lane < 16) *(u32x4*)kp = ko;
    }
}

template <int NCOL> __device__ __forceinline__ void readout_phase(const bfs* of, int pf, const bfs* ob, int pb, const bfs* ob2, int osplit, bfs* out, const bfs* proj, int pitch, int ogcol, const float* gain, int row_lo, int G) {
    constexpr int PL = NCOL / 64;
    constexpr int LPH = 128 / PL;
    const int tid_ = tid_fresh(); const int lane = tid_ & 63, wave = tid_ >> 6;
    const int gw = blockIdx.x * NWAVES + wave, NGW = G * NWAVES;
    float gv[PL];
#pragma unroll
    for (int e = 0; e < PL; ++e) gv[e] = gain[(PL * lane + e) & 127];
    const int rpw = (ROWS - row_lo + NGW - 1) / NGW; const int r0 = row_lo + gw * rpw, r1 = (r0 + rpw < ROWS) ? r0 + rpw : ROWS;
    u32x4 fn[PL / 8], bn[PL / 8], gn[PL / 8];
#define RO_LOAD(r) do { _Pragma("unroll") for (int c = 0; c < PL / 8; ++c) { fn[c] = *(const u32x4*)(of + (size_t)(r) * pf + PL * lane + 8 * c); bn[c] = *(const u32x4*)(((r) >= osplit ? ob2 : ob) + (size_t)(r) * pb + PL * lane + 8 * c); gn[c] = *(const u32x4*)(proj + (size_t)(r) * pitch + ogcol + PL * lane + 8 * c); } } while (0)
    if (r0 < r1) RO_LOAD(r0);
    for (int r = r0; r < r1; ++r) {
        float x[PL], g[PL]; float ss = 0.f;
#pragma unroll
        for (int c = 0; c < PL / 8; ++c) { const u32x4 fw = fn[c], bw = bn[c], gw4 = gn[c];
#pragma unroll
            for (int e = 0; e < 4; ++e) { x[8 * c + 2 * e] = bf2f(fw[e] & 0xffffu) + bf2f(bw[e] & 0xffffu); x[8 * c + 2 * e + 1] = bf2f(fw[e] >> 16) + bf2f(bw[e] >> 16); g[8 * c + 2 * e] = bf2f(gw4[e] & 0xffffu); g[8 * c + 2 * e + 1] = bf2f(gw4[e] >> 16); } }
        if (r + 1 < r1) RO_LOAD(r + 1);
#pragma unroll
        for (int e = 0; e < PL; ++e) ss += x[e] * x[e];
#pragma unroll
        for (int of2 = 1; of2 < LPH; of2 <<= 1) ss += __shfl_xor(ss, of2);
        const float rinv = rsqrtf(ss * (1.f / 128.f) + RMS_EPS);
#pragma unroll
        for (int c = 0; c < PL / 8; ++c) { u32x4 wv;
#pragma unroll
            for (int e = 0; e < 4; ++e) wv[e] = pk2(x[8 * c + 2 * e] * rinv * gv[8 * c + 2 * e] * siluf(g[8 * c + 2 * e]), x[8 * c + 2 * e + 1] * rinv * gv[8 * c + 2 * e + 1] * siluf(g[8 * c + 2 * e + 1]));
            *(u32x4*)(out + (size_t)r * DM + PL * lane + 8 * c) = wv; }
    }
#undef RO_LOAD
}

namespace scan {
#define SC_LBAR() asm volatile("s_waitcnt lgkmcnt(0)\n\ts_barrier" ::: "memory")
template <int PB> __device__ __forceinline__ int swz(int row, int chunk) {
    if (PB == 256) return row * 256 + ((chunk ^ (row & 15) ^ ((row >> 4) & 3)) << 4);
    else return row * 128 + ((chunk ^ (((row >> 1) ^ (row >> 4)) & 7)) << 4);
}
__device__ __forceinline__ int crow(int r, int hi) { return (r & 3) + 8 * (r >> 2) + 4 * hi; }
__device__ __forceinline__ float dpp_shr(float x, float old, const int n) {
    switch (n) {
    case 1: return __int_as_float(__builtin_amdgcn_update_dpp(__float_as_int(old), __float_as_int(x), 0x111, 0xf, 0xf, false));
    case 2: return __int_as_float(__builtin_amdgcn_update_dpp(__float_as_int(old), __float_as_int(x), 0x112, 0xf, 0xf, false));
    case 4: return __int_as_float(__builtin_amdgcn_update_dpp(__float_as_int(old), __float_as_int(x), 0x114, 0xf, 0xf, false));
    default: return __int_as_float(__builtin_amdgcn_update_dpp(__float_as_int(old), __float_as_int(x), 0x118, 0xf, 0xf, false));
    }
}
template <int DK, bool HG, int NV> struct Map {
    static constexpr int PQ = DK * 2;
    static constexpr int O_QG = 0, O_KG = 64 * PQ, O_KGT = 2 * 64 * PQ, O_VT = O_KGT + DK * 128, O_ST = O_VT + NV * 128, O_EGL = O_ST + NV * PQ, O_VR = O_EGL + DK * 4, O_ZB = O_VR + 64 * NV * 2, O_FB = O_ZB + 2048, O_END = HG ? O_ZB : O_FB + 16384;
};
template <int DK, bool HG, int pitch, int NV>
__device__ __forceinline__ void scan_unit(LAS unsigned char* L, const bfs* __restrict__ proj, const int qcol, const int kcol, const int vcol, const int zcol,
                                          const float* __restrict__ wg, const float* __restrict__ bg, bfs* O, bfs* O2, const int osplit, const int opitch, const int ocol, const int b, const int dir, const float qscale) {
    typedef Map<DK, HG, NV> MP;
    constexpr int PQ = MP::PQ, NTG = DK * 4, NVB = NV / 32, NST = (DK / 32) * NVB / 8, WPM = NVB / NST, NPV = NV / 64, VCPR = NV / 8, VPB = NV * 2;
    const int tid = tid_fresh(), lane = tid & 63, r32 = lane & 31, hi = lane >> 5, w = tid >> 6;
    const int c4 = tid >> 4, sg = tid & 15;
    const bool gact = tid < NTG;
    const int mk = w / WPM;
    const int nv0 = (w % WPM) * NST;
    const bool oact = w < 2 * NVB;
    f32x16 S[NST];
#pragma unroll
    for (int i = 0; i < NST; ++i)
#pragma unroll
        for (int r = 0; r < 16; ++r) S[i][r] = 0.f;
    s16x8 wgB = (s16x8){0, 0, 0, 0, 0, 0, 0, 0}; float bias = 0.f;
    if (!HG) {
        const int col = 32 * (w & 1) + r32;
#pragma unroll
        for (int j = 0; j < 8; ++j) wgB[j] = (short)f2bf(wg[(8 * hi + j) * 256 + col]);
        bias = bg[col];
    }
    constexpr int NQ = DK / 64, CPR = DK / 8;
    u32x4 pqA[NQ], pkA[NQ], pvA[NPV]; u32x4 pzA = (u32x4){0u, 0u, 0u, 0u};
#define SC_BASE(s) ({ const int g_ = dir ? ((s) < 4 ? 3 - (s) : 71 - (s)) : (s); (long)(g_ < 4 ? b * 256 + 64 * g_ : 2048 + b * 4096 + 64 * (g_ - 4)); })
#define SC_GROW(base, i) ((base) + (dir ? 63 - (i) : (i)))
#define SC_ISSUE(s) do { const long nb_ = SC_BASE(s); \
        _Pragma("unroll") for (int i = 0; i < NQ; ++i) { const int id = tid + 512 * i, row = id / CPR, c = id % CPR; const bfs* rp = proj + (size_t)SC_GROW(nb_, row) * pitch + 8 * c; pq[i] = *(const u32x4*)(rp + qcol); pk[i] = *(const u32x4*)(rp + kcol); } \
        _Pragma("unroll") for (int i = 0; i < NPV; ++i) { const int id = tid + 512 * i, row = id / VCPR, c = id % VCPR; pv[i] = *(const u32x4*)(proj + (size_t)SC_GROW(nb_, row) * pitch + vcol + 8 * c); } \
        if (!HG) { if (tid < 128) pz = *(const u32x4*)(proj + (size_t)SC_GROW(nb_, tid >> 1) * pitch + zcol + 8 * (tid & 1)); } } while (0)
    { auto& pq = pqA; auto& pk = pkA; auto& pv = pvA; auto& pz = pzA; SC_ISSUE(0); }
    unsigned ost[8]; long pbase = 0;
#pragma unroll
    for (int i = 0; i < 8; ++i) ost[i] = 0u;
#define SC_STORE(bs) do { const int nvt_ = w >> 1, mi_ = w & 1; const int lrow_ = dir ? 63 - (32 * mi_ + 4 * hi) : (32 * mi_ + 4 * hi); const long ostep_ = dir ? -(long)opitch : (long)opitch; \
        bfs* ob_ = (((bs) >= osplit) ? O2 : O) + (size_t)((bs) + lrow_) * opitch + ocol + 32 * nvt_ + r32; \
        _Pragma("unroll") for (int r = 0; r < 16; ++r) ob_[((r & 3) + 8 * (r >> 2)) * ostep_] = (bfs)((r & 1) ? (ost[r >> 1] >> 16) : (ost[r >> 1] & 0xffffu)); } while (0)
    auto body = [&](const int s, u32x4 (&pq)[NQ], u32x4 (&pk)[NQ], u32x4 (&pv)[NPV], u32x4& pz) __attribute__((always_inline)) {
        const long base = SC_BASE(s);
#ifdef PROBE_SEG
        unsigned long long tseg0 = __builtin_amdgcn_s_memrealtime();
#define SEG_MARK(k) do { const unsigned long long tn_ = __builtin_amdgcn_s_memrealtime(); if (HG && blockIdx.x == PROBE_BLK && threadIdx.x == 0 && (PROBE_SEG == (k) || PROBE_SEG == 0)) { volatile LAS unsigned long long* pa_ = (volatile LAS unsigned long long*)(L + 153600 + 64 + 40 * 8); pa_[0] += tn_ - tseg0; } tseg0 = tn_; } while (0)
#else
#define SEG_MARK(k) do {} while (0)
#endif
#pragma unroll
        for (int ti = 0; ti < NST; ++ti) { const int v = 32 * (nv0 + ti) + r32;
#pragma unroll
            for (int r4 = 0; r4 < 4; ++r4) { const int k0 = 32 * mk + 8 * r4 + 4 * hi; u32x2 wv; wv.x = pk2(S[ti][4 * r4], S[ti][4 * r4 + 1]); wv.y = pk2(S[ti][4 * r4 + 2], S[ti][4 * r4 + 3]);
                *(LAS u32x2*)(L + MP::O_ST + swz<PQ>(v, k0 >> 3) + (k0 & 7) * 2) = wv; } }
        if (s > 0 && oact) SC_STORE(pbase);
        pbase = base;
#pragma unroll
        for (int i = 0; i < NQ; ++i) { const int id = tid + 512 * i, row = id / CPR, c = id % CPR;
            *(LAS u32x4*)(L + MP::O_QG + swz<PQ>(row, c)) = pq[i]; *(LAS u32x4*)(L + MP::O_KG + swz<PQ>(row, c)) = pk[i]; }
#pragma unroll
        for (int i = 0; i < NPV; ++i) { const int id = tid + 512 * i, row = id / VCPR, c = id % VCPR; *(LAS u32x4*)(L + MP::O_VR + swz<VPB>(row, c)) = pv[i]; }
        if (!HG) { if (tid < 128) *(LAS u32x4*)(L + MP::O_ZB + (tid >> 1) * 32 + (tid & 1) * 16) = pz; }
        if (s + 1 < 68) SC_ISSUE(s + 1);
        SC_LBAR();
        u32x2 q2[4], k2[4];
#pragma unroll
        for (int r = 0; r < 4; ++r) { q2[r] = (u32x2){0u, 0u}; k2[r] = (u32x2){0u, 0u}; }
        if (gact) {
#pragma unroll
            for (int r = 0; r < 4; ++r) { const int off = swz<PQ>(4 * sg + r, c4 >> 1) + (c4 & 1) * 8; q2[r] = *(const LAS u32x2*)(L + MP::O_QG + off); k2[r] = *(const LAS u32x2*)(L + MP::O_KG + off); } }
        if (c4 < NV / 4) {
            u32x2 v2[4];
#pragma unroll
            for (int r = 0; r < 4; ++r) v2[r] = *(const LAS u32x2*)(L + MP::O_VR + swz<VPB>(4 * sg + r, c4 >> 1) + (c4 & 1) * 8);
            u32x2 t0, t1, t2, t3;
            t0.x = (v2[0].x & 0xffffu) | (v2[1].x << 16); t0.y = (v2[2].x & 0xffffu) | (v2[3].x << 16);
            t1.x = (v2[0].x >> 16) | (v2[1].x & 0xffff0000u); t1.y = (v2[2].x >> 16) | (v2[3].x & 0xffff0000u);
            t2.x = (v2[0].y & 0xffffu) | (v2[1].y << 16); t2.y = (v2[2].y & 0xffffu) | (v2[3].y << 16);
            t3.x = (v2[0].y >> 16) | (v2[1].y & 0xffff0000u); t3.y = (v2[2].y >> 16) | (v2[3].y & 0xffff0000u);
            const int vo = (sg & 1) * 8;
            *(LAS u32x2*)(L + MP::O_VT + swz<128>(4 * c4 + 0, sg >> 1) + vo) = t0; *(LAS u32x2*)(L + MP::O_VT + swz<128>(4 * c4 + 1, sg >> 1) + vo) = t1;
            *(LAS u32x2*)(L + MP::O_VT + swz<128>(4 * c4 + 2, sg >> 1) + vo) = t2; *(LAS u32x2*)(L + MP::O_VT + swz<128>(4 * c4 + 3, sg >> 1) + vo) = t3; }
        float qv[4][4], kv[4][4];
#pragma unroll
        for (int r = 0; r < 4; ++r) { qv[r][0] = bf2f(q2[r].x & 0xffffu); qv[r][1] = bf2f(q2[r].x >> 16); qv[r][2] = bf2f(q2[r].y & 0xffffu); qv[r][3] = bf2f(q2[r].y >> 16);
            kv[r][0] = bf2f(k2[r].x & 0xffffu); kv[r][1] = bf2f(k2[r].x >> 16); kv[r][2] = bf2f(k2[r].y & 0xffffu); kv[r][3] = bf2f(k2[r].y >> 16); }
        if (!HG) {
            if (w < 4) { const int mi = w >> 1, nj = w & 1;
                const s16x8 za = *(const LAS s16x8*)(L + MP::O_ZB + (32 * mi + r32) * 32 + hi * 16);
                f32x16 lg;
#pragma unroll
                for (int r = 0; r < 16; ++r) lg[r] = 0.f;
                lg = __builtin_amdgcn_mfma_f32_32x32x16_bf16(za, wgB, lg, 0, 0, 0);
#pragma unroll
                for (int r = 0; r < 16; ++r) { const float x = lg[r] + bias; const float ls = fminf(x, 0.f) - __logf(1.f + __expf(-fabsf(x)));
                    ((LAS float*)(L + MP::O_FB))[(32 * mi + crow(r, hi)) * 64 + 32 * nj + r32] = __expf(ls * (1.f / 16.f)); } }
            SC_LBAR();
        }
        if (gact) {
            float p[4][4];
#pragma unroll
            for (int r = 0; r < 4; ++r) {
                f32x4 f;
                if (HG) f = (f32x4){1.f - kv[r][0], 1.f - kv[r][1], 1.f - kv[r][2], 1.f - kv[r][3]};
                else f = *(const LAS f32x4*)(L + MP::O_FB + ((4 * sg + r) * 64 + 4 * c4) * 4);
#pragma unroll
                for (int e = 0; e < 4; ++e) p[r][e] = r ? p[r - 1][e] * f[e] : f[e]; }
            float ex[4];
#pragma unroll
            for (int e = 0; e < 4; ++e) { float x = p[3][e];
                x *= dpp_shr(x, 1.f, 1); x *= dpp_shr(x, 1.f, 2); x *= dpp_shr(x, 1.f, 4); x *= dpp_shr(x, 1.f, 8);
                ex[e] = dpp_shr(x, 1.f, 1);
                if (sg == 15) ((LAS float*)(L + MP::O_EGL))[4 * c4 + e] = x; }
            float kg[4][4];
#pragma unroll
            for (int r = 0; r < 4; ++r) { const int row = 4 * sg + r; float qg[4];
#pragma unroll
                for (int e = 0; e < 4; ++e) { const float eG = ex[e] * p[r][e]; qg[e] = qv[r][e] * qscale * eG; kg[r][e] = kv[r][e] * __builtin_amdgcn_rcpf(eG); }
                u32x2 wq, wk; wq.x = pk2(qg[0], qg[1]); wq.y = pk2(qg[2], qg[3]); wk.x = pk2(kg[r][0], kg[r][1]); wk.y = pk2(kg[r][2], kg[r][3]);
                const int off = swz<PQ>(row, c4 >> 1) + (c4 & 1) * 8;
                *(LAS u32x2*)(L + MP::O_QG + off) = wq; *(LAS u32x2*)(L + MP::O_KG + off) = wk; }
#pragma unroll
            for (int e = 0; e < 4; ++e) { u32x2 wt; wt.x = pk2(kg[0][e], kg[1][e]); wt.y = pk2(kg[2][e], kg[3][e]);
                *(LAS u32x2*)(L + MP::O_KGT + swz<128>(4 * c4 + e, sg >> 1) + (sg & 1) * 8) = wt; }
        }
        SC_LBAR();
        SEG_MARK(1);
        f32x16 acc;
#pragma unroll
        for (int r = 0; r < 16; ++r) acc[r] = 0.f;
        { const int mi = (w >> 1) & 1, nj = w & 1;
          if (w < 4 && nj <= mi) {
#pragma unroll
            for (int kk = 0; kk < DK / 16; ++kk) { const s16x8 ka = *(const LAS s16x8*)(L + MP::O_KG + swz<PQ>(32 * nj + r32, 2 * kk + hi)); const s16x8 bq = *(const LAS s16x8*)(L + MP::O_QG + swz<PQ>(32 * mi + r32, 2 * kk + hi));
                acc = __builtin_amdgcn_mfma_f32_32x32x16_bf16(ka, bq, acc, 0, 0, 0); } }
          SC_LBAR();
          if (w < 4) { const int i = 32 * mi + r32;
#pragma unroll
            for (int r4 = 0; r4 < 4; ++r4) { const int j0 = 32 * nj + 8 * r4 + 4 * hi; float pp[4];
#pragma unroll
              for (int e = 0; e < 4; ++e) pp[e] = (j0 + e <= i) ? acc[4 * r4 + e] : 0.f;
              u32x2 wv; wv.x = pk2(pp[0], pp[1]); wv.y = pk2(pp[2], pp[3]);
              *(LAS u32x2*)(L + MP::O_KG + swz<128>(i, j0 >> 3) + (j0 & 7) * 2) = wv; } } }
        SC_LBAR();
        SEG_MARK(2);
        if (oact) { const int nvt = w >> 1, mi = w & 1;
#pragma unroll
          for (int r = 0; r < 16; ++r) acc[r] = 0.f;
#pragma unroll
          for (int kk = 0; kk < 4; ++kk) { const s16x8 va = *(const LAS s16x8*)(L + MP::O_VT + swz<128>(32 * nvt + r32, 2 * kk + hi)); const s16x8 bp = *(const LAS s16x8*)(L + MP::O_KG + swz<128>(32 * mi + r32, 2 * kk + hi));
              acc = __builtin_amdgcn_mfma_f32_32x32x16_bf16(bp, va, acc, 0, 0, 0); }
#pragma unroll
          for (int kk = 0; kk < DK / 16; ++kk) { const s16x8 sa = *(const LAS s16x8*)(L + MP::O_ST + swz<PQ>(32 * nvt + r32, 2 * kk + hi)); const s16x8 bq = *(const LAS s16x8*)(L + MP::O_QG + swz<PQ>(32 * mi + r32, 2 * kk + hi));
              acc = __builtin_amdgcn_mfma_f32_32x32x16_bf16(bq, sa, acc, 0, 0, 0); }
#pragma unroll
          for (int i = 0; i < 8; ++i) ost[i] = pk2(acc[2 * i], acc[2 * i + 1]);
          }
#pragma unroll
        for (int ti = 0; ti < NST; ++ti) {
#pragma unroll
            for (int kk = 0; kk < 4; ++kk) { const s16x8 ka = *(const LAS s16x8*)(L + MP::O_KGT + swz<128>(32 * mk + r32, 2 * kk + hi)); const s16x8 bv = *(const LAS s16x8*)(L + MP::O_VT + swz<128>(32 * (nv0 + ti) + r32, 2 * kk + hi));
                S[ti] = __builtin_amdgcn_mfma_f32_32x32x16_bf16(ka, bv, S[ti], 0, 0, 0); }
#pragma unroll
            for (int r = 0; r < 16; ++r) S[ti][r] *= ((const LAS float*)(L + MP::O_EGL))[32 * mk + crow(r, hi)]; }
        SC_LBAR();
        SEG_MARK(3);
    };
    for (int s2 = 0; s2 < 68; ++s2) body(s2, pqA, pkA, pvA, pzA);
    if (oact) SC_STORE(pbase);
    asm volatile("s_waitcnt vmcnt(0)" ::: "memory");
#undef SC_STORE
#undef SC_BASE
#undef SC_GROW
#undef SC_ISSUE
}
}

#define XB_TMO      128
#define XB_XCNT(j)  (256  + 64 * (j))
#define XB_XSUB(j)  (1280 + 64 * (j))
#define XB_XGEN(j)  (2304 + 64 * (j))
#define XB_TOP      3328
#define XB_TOPGEN   3392
#define XCD_BAR_WORDS 3456
#define XB_SPIN_CAP (1u << 18)

__device__ __forceinline__ unsigned xb_ld(unsigned* p)              { return __hip_atomic_load(p, __ATOMIC_RELAXED, __HIP_MEMORY_SCOPE_AGENT); }
__device__ __forceinline__ unsigned xb_add(unsigned* p, unsigned v) { return __hip_atomic_fetch_add(p, v, __ATOMIC_RELAXED, __HIP_MEMORY_SCOPE_AGENT); }
__device__ __forceinline__ unsigned xb_xcc_id() { return (unsigned)__builtin_amdgcn_s_getreg((3 << 11) | 20) & 0xFu; }
#define XB_SPIN(cond, bar) do { unsigned _sp = 0; while (cond) { __builtin_amdgcn_s_sleep(1); \
    if ((++_sp & 255u) == 0u) { if (xb_ld(&(bar)[XB_TMO])) break; if (_sp > XB_SPIN_CAP) { atomicAdd(&(bar)[XB_TMO], 1u); break; } } } } while (0)

struct XcdBarrier {
    unsigned* bar; unsigned x;
    volatile LAS unsigned* st;
};

__device__ __forceinline__ XcdBarrier xcd_barrier_post(unsigned* bar, volatile LAS unsigned* st) {
    XcdBarrier b; b.bar = bar; b.x = xb_xcc_id(); b.st = st;
    if (threadIdx.x == 0) (void)xb_add(&bar[XB_XCNT(b.x)], 1u);
    return b;
}
__device__ __forceinline__ void xcd_barrier_complete(unsigned* bar, unsigned x, unsigned& nloc, unsigned& nx) {
    const unsigned G = gridDim.x * gridDim.y * gridDim.z;
    unsigned sum, cnt, mine, sp = 0u;
    for (;;) {
        sum = 0u; cnt = 0u; mine = 0u;
#pragma unroll
        for (unsigned j = 0; j < 16; ++j) { const unsigned c = xb_ld(&bar[XB_XCNT(j)]); sum += c; cnt += (c > 0u) ? 1u : 0u; mine = (j == x) ? c : mine; }
        if (sum == G) break;
        __builtin_amdgcn_s_sleep(1);
        if ((++sp & 255u) == 0u) { if (xb_ld(&bar[XB_TMO])) break; if (sp > XB_SPIN_CAP) { atomicAdd(&bar[XB_TMO], 1u); break; } }
    }
    nloc = mine > 0u ? mine : 1u; nx = cnt > 0u ? cnt : 1u;
}

__device__ __forceinline__ void xcd_barrier(const XcdBarrier& b) {
    asm volatile("s_waitcnt vmcnt(0)" ::: "memory");
    __syncthreads();
    if (threadIdx.x == 0) {
        unsigned* bar = b.bar;
        __builtin_amdgcn_s_waitcnt(0);
        unsigned nloc = b.st[0], nx = b.st[1];
        if (nloc == 0u) { xcd_barrier_complete(bar, b.x, nloc, nx); b.st[0] = nloc; b.st[1] = nx; }
        const unsigned old = xb_add(&bar[XB_XSUB(b.x)], 1u);
        const unsigned gen = old / nloc;
        if (old + 1u == (gen + 1u) * nloc) {
            __builtin_amdgcn_fence(__ATOMIC_RELEASE, "agent");
            asm volatile("s_waitcnt vmcnt(0)" ::: "memory");
            const unsigned og = xb_add(&bar[XB_TOP], 1u);
            const unsigned tg = og / nx;
            if (og + 1u == (tg + 1u) * nx) xb_add(&bar[XB_TOPGEN], 1u);
            else XB_SPIN(xb_ld(&bar[XB_TOPGEN]) == tg, bar);
            __builtin_amdgcn_fence(__ATOMIC_ACQUIRE, "agent");
            xb_add(&bar[XB_XGEN(b.x)], 1u);
            asm volatile("s_waitcnt vmcnt(0)" ::: "memory");
        } else {
            XB_SPIN(xb_ld(&bar[XB_XGEN(b.x)]) == gen, bar);
            __builtin_amdgcn_fence(__ATOMIC_ACQUIRE, "agent");
            asm volatile("s_waitcnt vmcnt(0)" ::: "memory");
        }
    }
    __syncthreads();
}

#ifdef PROBE_MASK
#define STAMP() do { if (blockIdx.x == PROBE_BLK && threadIdx.x == 0) { pst[pn] = __builtin_amdgcn_s_memrealtime(); } ++pn; } while (0)
#else
#define STAMP() do {} while (0)
#endif
#define GRID_SYNC() do { xcd_barrier(xbar); STAMP(); } while (0)
#define GRID_SYNC_CG() do { if (a.ws == nullptr) grid.sync(); xcd_barrier(xbar); STAMP(); } while (0)
__global__ void __launch_bounds__(NTHR, 2) fwd_megakernel(Args a) {
    extern __shared__ __attribute__((aligned(16))) unsigned char lds_raw[];
    cg::grid_group grid = cg::this_grid();
    LAS unsigned char* lds = (LAS unsigned char*)lds_raw;
    const int G = gridDim.x, tid = threadIdx.x;
    unsigned char* ws = a.ws;
    float* MOD = (float*)(ws + WS_MOD); const float* LB = (const float*)(ws + WS_LB);
    bfs* XB1 = (bfs*)a.out;
    bfs* X2 = (bfs*)(ws + WS_D + 264 * MiB);
    bfs* CB = (bfs*)(ws + WS_C); bfs* DB = (bfs*)(ws + WS_D); bfs* YB = (bfs*)(ws + WS_Y); bfs* EB = (bfs*)(ws + WS_E0);
    unsigned* ctl = (unsigned*)(ws + WS_CTL);
    { volatile LAS unsigned* st0 = (volatile LAS unsigned*)(lds + LDS_CTL_OFF + 16); if (tid == 0) { st0[0] = 0u; st0[1] = 0u; } __syncthreads(); }
    XcdBarrier xbar = xcd_barrier_post(ctl + 1024, (volatile LAS unsigned*)(lds + LDS_CTL_OFF + 16));
#ifdef PROBE_MASK
    volatile LAS unsigned long long* pst = (volatile LAS unsigned long long*)(lds + LDS_CTL_OFF + 64); int pn = 1;
    if (threadIdx.x == 0) { pst[0] = __builtin_amdgcn_s_memrealtime(); pst[40] = 0; }
#endif

    p0_phase(a, lds, G);
    GRID_SYNC_CG();
    { RowOp op{a.in[0], a.in[2], nullptr, nullptr, nullptr, nullptr, nullptr, 0, CB, a.in[6], MOD, 0, 1, 0, 0, 0}; row_phase(op, G); }
    GRID_SYNC();
    for (int l = 0; l < 2; ++l) {
        const float* MODL = MOD + (size_t)l * 9 * 6144;
        const bfs* Win = (const bfs*)(ws + (l ? WS_WIN1 : WS_WIN0)); const bfs* Wout = (const bfs*)(ws + (l ? WS_WOUT1 : WS_WOUT0));
        const bfs* Wgu = (const bfs*)(ws + (l ? WS_WGU1 : WS_WGU0)); const bfs* Wd = (const bfs*)(ws + (l ? WS_WD1 : WS_WD0));
        const int pitch = l ? NIN1 : PIN0;
        { pg8::Gemm g{CB, Win, ROWS, pitch, DM}; pg8::StaticOrder S; S.init(ROWS, pitch, G, (int)blockIdx.x);
          pg8::EpiStore E{DB, pitch, l, LB};
#ifndef NO_GEMM
          pg8::gemm_phase<pg8::EpiStore, pg8::StaticOrder, true, true>(lds, g, S, E);
#endif
 }
        GRID_SYNC();
        if (l == 0) {
            qk_phase(DB, a.in[14], a.in[15], G);
            GRID_SYNC();
            volatile LAS unsigned* lctl = (volatile LAS unsigned*)(lds + LDS_CTL_OFF);
            constexpr int N_GLA = 64, N_ATL = 1024, N_ATC = 64, N_ITEMS = N_GLA + N_ATL + N_ATC;
            for (;;) {
                if (tid == 0) lctl[0] = __hip_atomic_fetch_add(ctl + 64, 1u, __ATOMIC_RELAXED, __HIP_MEMORY_SCOPE_AGENT);
                __syncthreads();
                const int it = (int)lctl[0];
                __syncthreads();
                if (it >= N_ITEMS) break;
                if (it < N_GLA) {
                    const int b = it >> 3, h = (it >> 1) & 3, dir = it & 1;
#ifndef NO_GLA
                    scan::scan_unit<64, false, PIN0, 128>(lds, DB, C_GQ + 64 * h, C_GK + 64 * h, C_GV + 128 * h, C_GZ + 16 * dir, a.in[11] + dir * 16 * 256 + 64 * h, a.in[12] + dir * 256 + 64 * h,
                                               dir ? EB : CB, dir ? EB : CB, 0, dir ? 512 : DM, 128 * h, b, dir, 0.125f);
#endif
                } else if (it < N_GLA + N_ATL) {
                    const int u = it - N_GLA, gq = u & 3, qb = (u >> 2) & 15, kvh = (u >> 6) & 1, b = u >> 7, h = kvh * 4 + gq;
                    const size_t qrow = (size_t)RCTX + (size_t)b * SEQ + (size_t)qb * 256;
#ifndef NO_ATTN
                    attn_body::attn_unit<8>(b, 68, (const attn_body::bf16*)(DB + qrow * PIN0 + C_AQ + 64 * h), PIN0, (const attn_body::bf16*)(DB + C_AK + 64 * kvh), (const attn_body::bf16*)(DB + C_AV + 64 * kvh), PIN0,
                                            (attn_body::bf16*)(CB + qrow * DM + 512 + 64 * h), DM, (char*)lds_raw);
#endif
                } else {
                    const int u = it - N_GLA - N_ATL, h = u & 7, b = u >> 3, kvh = h >> 2;
                    const size_t qrow = (size_t)b * NCTX;
#ifndef NO_ATTN2
                    attn_body::attn_unit<8>(b, 4, (const attn_body::bf16*)(DB + qrow * PIN0 + C_AQ + 64 * h), PIN0, (const attn_body::bf16*)(DB + C_AK + 64 * kvh), (const attn_body::bf16*)(DB + C_AV + 64 * kvh), PIN0,
                                            (attn_body::bf16*)(CB + qrow * DM + 512 + 64 * h), DM, (char*)lds_raw);
#endif
                }
            }
            if (G >= 256) p0_weights(a, lds, P0_NA, P0_NITEMS, (int)blockIdx.x * NWAVES + (tid >> 6), G * NWAVES);
            GRID_SYNC();
            readout_phase<512>(CB, DM, EB, 512, EB, 0, CB, DB, PIN0, C_GOG, a.in[13], 0, G);
        } else {
            bfs* OA = (bfs*)(ws + 2 * MiB); bfs* OT2 = (bfs*)(ws + WS_D + 340 * MiB) - (size_t)OSPLIT * DM;
            for (int u = blockIdx.x; u < 256; u += G) {
                const int b = u >> 5, hh = (u >> 2) & 7, dir = (u >> 1) & 1, vh = u & 1;
#ifndef NO_HG
                scan::scan_unit<128, true, NIN1, 64>(lds, DB, C_FQ + 128 * hh, C_FF + 1024 * dir + 128 * hh, C_FI + 128 * hh + 64 * vh, 0, nullptr, nullptr,
                                                     dir ? OA : CB, dir ? OT2 : CB, dir ? OSPLIT : 0, DM, 128 * hh + 64 * vh, b, dir, 1.0f);
#endif
            }
            GRID_SYNC();
            readout_phase<1024>(CB, DM, OA, DM, OT2, OSPLIT, CB, DB, NIN1, C_FOG, a.in[19], RCTX, G);
        }
        GRID_SYNC();
        const int row_lo = l ? RCTX : 0; const int Mg = ROWS - row_lo;
#define PANEL_VARS const int nMg = Mg / 256, ncomp = nMg < G / 2 ? nMg : G / 2, nthird = (nMg - ncomp) * 4; \
        const bool third = (G == 256) ? (((int)blockIdx.x & 7) == 0 && 128 + ((int)blockIdx.x >> 5) < nMg) : ((int)blockIdx.x < nthird); \
        const int rrank = !nthird ? (int)blockIdx.x : (G == 256 ? ((int)blockIdx.x - ((int)blockIdx.x >> 3) - 1) : (int)blockIdx.x - nthird)
#define ROWOP_MIX RowOp op{l ? (const void*)(XB1 + (size_t)RCTX * DM) : (const void*)a.in[0], l ? (const void*)XB1 : (const void*)a.in[2], l ? (void*)X2 : (void*)(XB1 + (size_t)RCTX * DM), l ? (void*)nullptr : (void*)XB1, \
                   YB, a.in[7] + l * DM, MODL, 2, CB, a.in[8] + l * DM, MODL, 3, 4, row_lo, l, 1}
        for (int part = 0; part < 2; ++part) {
            { PANEL_VARS; (void)third; (void)rrank; (void)nthird; (void)ncomp;
              pg8::Gemm g{CB + (size_t)row_lo * DM, Wout, Mg, DM, DM}; pg8::EpiStore E{YB + (size_t)row_lo * DM, DM, 0, nullptr};
              pg8::PanelOrder S{nMg, G, (int)blockIdx.x, part ? 2 : 0, part ? 3 : 2};
#ifndef NO_GEMM
              pg8::gemm_phase<pg8::EpiStore, pg8::PanelOrder, true, true>(lds, g, S, E);
#endif
            }
            if (part == 1) { PANEL_VARS; if (!third) { ROWOP_MIX; row_phase(op, G, row_lo, row_lo + ncomp * 256, rrank, G - nthird); } }
            GRID_SYNC();
        }
        { PANEL_VARS; (void)third; (void)rrank; (void)nthird; if (ncomp < nMg) { ROWOP_MIX; row_phase(op, G, row_lo + ncomp * 256, ROWS); GRID_SYNC(); } }
        { pg8::Gemm g{CB + (size_t)row_lo * DM, Wgu, Mg, NGU, DM}; pg8::StaticOrder S; S.init(Mg, NGU, G, (int)blockIdx.x);
          pg8::EpiSwiGLU E{DB + (size_t)row_lo * DFF, DFF};
#ifndef NO_GEMM
          pg8::gemm_phase<pg8::EpiSwiGLU, pg8::StaticOrder, true, true>(lds, g, S, E);
#endif
 }
        GRID_SYNC();
#define ROWOP_FFN RowOp op{l ? (const void*)X2 : (const void*)(XB1 + (size_t)RCTX * DM), l ? (const void*)nullptr : (const void*)XB1, l ? (void*)a.out : (void*)(XB1 + (size_t)RCTX * DM), l ? (void*)nullptr : (void*)XB1, \
                   YB, a.in[9] + l * DM, MODL, 5, l ? (bfs*)nullptr : CB, l ? (const float*)nullptr : a.in[6] + DM, l ? (const float*)nullptr : MOD + (size_t)9 * 6144, 0, l ? 0 : 1, l ? RCTX : 0, 1, l ? 0 : 1}
        for (int part = 0; part < 2; ++part) {
            { PANEL_VARS; (void)third; (void)rrank; (void)nthird; (void)ncomp;
              pg8::Gemm g{DB + (size_t)row_lo * DFF, Wd, Mg, DM, DFF}; pg8::EpiStore E{YB + (size_t)row_lo * DM, DM, 0, nullptr};
              pg8::PanelOrder S{nMg, G, (int)blockIdx.x, part ? 2 : 0, part ? 3 : 2};
#ifndef NO_GEMM
              pg8::gemm_phase<pg8::EpiStore, pg8::PanelOrder, true, true>(lds, g, S, E);
#endif
            }
            if (part == 1) { PANEL_VARS; if (!third) { ROWOP_FFN; row_phase(op, G, row_lo, row_lo + ncomp * 256, rrank, G - nthird); } }
            if (part == 0 || l == 0) GRID_SYNC();
        }
        { PANEL_VARS; (void)third; (void)rrank; (void)nthird; if (ncomp < nMg) { ROWOP_FFN; row_phase(op, G, row_lo + ncomp * 256, ROWS); GRID_SYNC(); } }
    }
#ifdef PROBE_SYNCS
    for (int i = 0; i < PROBE_SYNCS; ++i) xcd_barrier(xbar);
#endif
#ifdef PROBE_MASK
    STAMP();
    if (blockIdx.x == PROBE_BLK && threadIdx.x == 0) {
        unsigned long long extra = 0;
        for (int i = 1; i < pn; ++i) if ((PROBE_MASK >> (i - 1)) & 1u) extra += pst[i] - pst[i - 1];
        extra += pst[40];
        const unsigned long long t0 = __builtin_amdgcn_s_memrealtime();
        while (__builtin_amdgcn_s_memrealtime() - t0 < extra) __builtin_amdgcn_s_sleep(8);
    }
#endif
}

extern "C" void kernel_launch(void* const* d_in, const int* in_sizes, int n_in, void* d_out, int out_size, void* d_ws, size_t ws_size, hipStream_t stream) {
    static int grid = 0;
    if (grid == 0) {
        if (n_in != 24 || ws_size < WS_END) { fprintf(stderr, "kernel_launch: unexpected inputs (n_in %d, ws %zu < %zu)\n", n_in, ws_size, (size_t)WS_END); grid = -1; return; }
        int dev = 0, cus = 0, per_cu = 0;
        hipGetDevice(&dev);
        hipDeviceGetAttribute(&cus, hipDeviceAttributeMultiprocessorCount, dev);
        if (hipFuncSetAttribute((const void*)fwd_megakernel, hipFuncAttributeMaxDynamicSharedMemorySize, LDS_BYTES) != hipSuccess) { fprintf(stderr, "kernel_launch: hipFuncSetAttribute failed\n"); grid = -1; return; }
        if (hipOccupancyMaxActiveBlocksPerMultiprocessor(&per_cu, (const void*)fwd_megakernel, NTHR, LDS_BYTES) != hipSuccess || per_cu < 1) { fprintf(stderr, "kernel_launch: occupancy query gave %d\n", per_cu); per_cu = 1; }
        (void)hipGetLastError();
        grid = cus * 1;
        fprintf(stderr, "kernel_launch: grid %d (cus %d, per_cu %d)\n", grid, cus, per_cu);
    }
    if (grid < 0) return;
    hipMemsetAsync((char*)d_ws + WS_CTL, 0, CTL_BYTES, stream);
    Args a{};
    for (int i = 0; i < 24; ++i) a.in[i] = (const float*)d_in[i];
    a.out = (float*)d_out; a.ws = (unsigned char*)d_ws;
    void* args[] = {&a};
    hipError_t e = hipLaunchCooperativeKernel((const void*)fwd_megakernel, dim3(grid), dim3(NTHR), args, LDS_BYTES, stream);
    if (e != hipSuccess) fprintf(stderr, "cooperative launch failed: %s (grid %d)\n", hipGetErrorString(e), grid);
}
```

```cpp
#include <hip/hip_runtime.h>
#include <hip/hip_cooperative_groups.h>
#include <hip/hip_bf16.h>
#include <cstdio>
#include <cstdint>
#include <cmath>
namespace cg = cooperative_groups;
__device__ __forceinline__ int tid_fresh() { int t = threadIdx.x; asm volatile("" : "+v"(t)); return t; }
namespace pg8 {
#define PG8_LAS __attribute__((address_space(3)))
typedef unsigned short bf16_t;
typedef short bf16x8 __attribute__((ext_vector_type(8)));
typedef float f32x4 __attribute__((ext_vector_type(4)));
typedef unsigned u32x4 __attribute__((ext_vector_type(4)));
constexpr int BM = 256, BK = 64, HALF = 128, HTB = HALF * BK * 2  , STAGE_BYTES = 8 * HTB, NXCD = 8, WGM = 8;

__host__ __device__ __forceinline__ int lds_byte(int r, int c) { const int st = (r >> 4) * 2 + (c >> 5), rr = r & 15, cc = c & 31, ob = rr * 64 + cc * 2; return st * 1024 + (ob ^ (((ob >> 9) & 1) << 5)); }
__host__ __device__ __forceinline__ void stage_rc(int b, int& R, int& C) { const int st = b / 1024, sb = b % 1024, swz = sb ^ (((sb >> 9) & 1) << 5); R = (st >> 1) * 16 + swz / 64; C = (st & 1) * 32 + (swz % 64) / 2; }
__host__ __device__ __forceinline__ int perm32(int rho) { const int n = rho >> 4, i = rho & 15; return 8 * (i >> 2) + 4 * n + (i & 3); }

struct Unit { int pm, pn; };
struct Gemm { const bf16_t* A; const bf16_t* Bt; int M, N, K; };

struct StaticOrder {
    int nM, nN, nwg, G, c;
    __host__ __device__ void init(int M, int N, int G_, int c_) { nM = M / BM; nN = N / BM; nwg = nM * nN; G = G_; c = c_; }
    __host__ __device__ bool next(int i, Unit& u) const {
        const long L = (long)i * G + c; if (L >= nwg) return false;
        int wgid = (int)L; { const int q = nwg / NXCD, r = nwg % NXCD, xcd = wgid % NXCD, off = wgid / NXCD; wgid = (xcd < r ? xcd * (q + 1) : r * (q + 1) + (xcd - r) * q) + off; }
        const int nig = WGM * nN, gid = wgid / nig, fm = gid * WGM, gsz = (nM - fm) < WGM ? (nM - fm) : WGM;
        u.pm = fm + ((wgid % nig) % gsz); u.pn = (wgid % nig) / gsz; return true;
    }
    __device__ __forceinline__ void a_ready(const Unit&) const {}
    __device__ __forceinline__ void done(const Unit&) const {}
};

typedef float f32x2_cv __attribute__((ext_vector_type(2))); typedef __bf16 bf16x2_cv __attribute__((ext_vector_type(2)));
__device__ __forceinline__ unsigned cvt_pk_bf16(float lo, float hi) { f32x2_cv v = {lo, hi}; bf16x2_cv b = __builtin_convertvector(v, bf16x2_cv); return __builtin_bit_cast(unsigned, b); }
typedef float f32x2 __attribute__((ext_vector_type(2)));
struct PanelOrder {
    int nM, G, c, i0, i1;
    __host__ __device__ bool next(int i, Unit& u) const {
        const int r = i + i0; if (r >= i1) return false;
        if (G == 256) { const int x = c & 7, j = c >> 3; u.pm = r * 64 + x * 8 + (j >> 2); u.pn = j & 3; }
        else { const int L = r * G + c; u.pm = L >> 2; u.pn = L & 3; }
        return u.pm < nM;
    }
    __device__ __forceinline__ void a_ready(const Unit&) const {}
    __device__ __forceinline__ void done(const Unit&) const {}
};
typedef float f32x2 __attribute__((ext_vector_type(2)));
struct EpiStore {
    static constexpr bool PERM = true, AFTER_DRAIN = false;
    bf16_t* O; int ldc; int mode; const float* lb;
    __device__ __forceinline__ void operator()(const f32x4 (&acc)[2][2][4][2], const Unit& u, int wr, int wc, int fr, int fq) const {
        const int row0 = u.pm * BM + wr * 64 + fr; const int col0 = u.pn * BM + wc * 32 + 8 * fq;
#pragma unroll
        for (int bj = 0; bj < 2; ++bj) {
            const int col = col0 + bj * HALF;
            int cls = 0; f32x4 l0 = (f32x4){0.f,0.f,0.f,0.f}, l1 = l0;
            if (mode == 1) { if (col < 1024) cls = 1; else if (col < 3072) { cls = 2; l0 = *(const f32x4*)(lb + col - 1024); l1 = *(const f32x4*)(lb + col - 1024 + 4); } }
#pragma unroll
            for (int ai = 0; ai < 2; ++ai)
#pragma unroll
                for (int m = 0; m < 4; ++m) {
                    f32x4 v0 = acc[ai][bj][m][0], v1 = acc[ai][bj][m][1];
                    if (cls == 1) {
#pragma unroll
                        for (int e = 0; e < 4; ++e) { v0[e] = v0[e] * __builtin_amdgcn_rcpf(1.f + __expf(-v0[e])); v1[e] = v1[e] * __builtin_amdgcn_rcpf(1.f + __expf(-v1[e])); }
                    } else if (cls == 2) {
#pragma unroll
                        for (int e = 0; e < 4; ++e) { const float s0 = __builtin_amdgcn_rcpf(1.f + __expf(v0[e])), s1 = __builtin_amdgcn_rcpf(1.f + __expf(v1[e]));
                            v0[e] = (1.f - l0[e]) * s0; v1[e] = (1.f - l1[e]) * s1; }
                    }
                    u32x4 w; w.x = cvt_pk_bf16(v0[0], v0[1]); w.y = cvt_pk_bf16(v0[2], v0[3]); w.z = cvt_pk_bf16(v1[0], v1[1]); w.w = cvt_pk_bf16(v1[2], v1[3]);
                    *(u32x4*)(O + (size_t)(row0 + ai * HALF + m * 16) * ldc + col) = w;
                }
        }
    }
};
struct EpiSwiGLU {
    static constexpr bool PERM = true, AFTER_DRAIN = false;
    bf16_t* O; int ldc;
    __device__ __forceinline__ void operator()(const f32x4 (&acc)[2][2][4][2], const Unit& u, int wr, int wc, int fr, int fq) const {
        const int row0 = u.pm * BM + wr * 64 + fr; const int col = u.pn * HALF + wc * 32 + 8 * fq;
#pragma unroll
        for (int ai = 0; ai < 2; ++ai)
#pragma unroll
            for (int m = 0; m < 4; ++m) {
                f32x4 g0 = acc[ai][0][m][0], g1 = acc[ai][0][m][1]; const f32x4 u0 = acc[ai][1][m][0], u1 = acc[ai][1][m][1];
#pragma unroll
                for (int e = 0; e < 4; ++e) { g0[e] = g0[e] * __builtin_amdgcn_rcpf(1.f + __expf(-g0[e])) * u0[e]; g1[e] = g1[e] * __builtin_amdgcn_rcpf(1.f + __expf(-g1[e])) * u1[e]; }
                u32x4 w; w.x = cvt_pk_bf16(g0[0], g0[1]); w.y = cvt_pk_bf16(g0[2], g0[3]); w.z = cvt_pk_bf16(g1[0], g1[1]); w.w = cvt_pk_bf16(g1[2], g1[3]);
                *(u32x4*)(O + (size_t)(row0 + ai * HALF + m * 16) * ldc + col) = w;
            }
    }
};
template <class Epi, class Sched, bool ALIGN_EPI = false, bool SP2 = false>
__device__ __forceinline__ void gemm_phase(PG8_LAS unsigned char* lds, const Gemm g, const Sched& S, const Epi& E) {
    const int tid = tid_fresh(), wid = __builtin_amdgcn_readfirstlane(tid >> 6), lane = tid & 63, wr = wid >> 2, wc = wid & 3, fr = lane & 15, fq = lane >> 4;
    const int K = g.K, nt = K / BK;
    unsigned voffA[2], voffB[2];
#pragma unroll
    for (int i = 0; i < 2; ++i) { int R, C; stage_rc(tid * 16 + i * 8192, R, C); const int Rb = Epi::PERM ? ((R & ~31) + perm32(R & 31)) : R;
        voffA[i] = (unsigned)(R * K + C) * 2u; voffB[i] = (unsigned)(Rb * K + C) * 2u; }
    const size_t kstep = (size_t)(BK * 2);
    const size_t hstep = (size_t)HALF * K * 2;
    const size_t tstep = 2 * hstep;
    const unsigned ldsw = (unsigned)wid * 1024u;
    const int aoff = lds_byte(wr * 64 + fr, fq * 8), boff = lds_byte(wc * 32 + fr, fq * 8);
#define PG8_SA(b, h) (((b) * 2 + (h)) * HTB)
#define PG8_SB(b, h) ((4 + (b) * 2 + (h)) * HTB)
#define PG8_STAGE(bufoff, gbase, voff) do { _Pragma("unroll") for (int _i = 0; _i < 2; ++_i) \
        __builtin_amdgcn_global_load_lds((const unsigned*)((const char*)(gbase) + (voff)[_i]), (PG8_LAS unsigned*)(lds + (bufoff) + ldsw + _i * 8192), 16, 0, 0); } while (0)
#define PG8_LDA(dst, b, h) do { _Pragma("unroll") for (int m = 0; m < 4; ++m) _Pragma("unroll") for (int k = 0; k < 2; ++k) dst[m][k] = *(const PG8_LAS bf16x8*)(lds + PG8_SA(b, h) + aoff + m * 2048 + k * 1024); } while (0)
#define PG8_LDB(dst, b, h) do { _Pragma("unroll") for (int n = 0; n < 2; ++n) _Pragma("unroll") for (int k = 0; k < 2; ++k) dst[n][k] = *(const PG8_LAS bf16x8*)(lds + PG8_SB(b, h) + boff + n * 2048 + k * 1024); } while (0)
#define PG8_MMA(ai, bj, At, Bt) do { __builtin_amdgcn_s_setprio(1); _Pragma("unroll") for (int m = 0; m < 4; ++m) _Pragma("unroll") for (int n = 0; n < 2; ++n) _Pragma("unroll") for (int k = 0; k < 2; ++k) \
        acc[ai][bj][m][n] = __builtin_amdgcn_mfma_f32_16x16x32_bf16(Bt[n][k], At[m][k], acc[ai][bj][m][n], 0, 0, 0); __builtin_amdgcn_s_setprio(0); } while (0)
#define PG8_WAIT_V(n) asm volatile("s_waitcnt vmcnt(" #n ")" ::: "memory")
#define PG8_WAIT_L(n) asm volatile("s_waitcnt lgkmcnt(" #n ")" ::: "memory")
#define PG8_BAR __builtin_amdgcn_s_barrier()
#define PG8_SCHED __builtin_amdgcn_sched_barrier(0)
    Unit cur, nxt; int ui = 0;
    if (!S.next(0, cur)) return;
    f32x4 acc[2][2][4][2];
#pragma unroll
    for (int a = 0; a < 2; ++a)
#pragma unroll
        for (int b = 0; b < 2; ++b)
#pragma unroll
            for (int m = 0; m < 4; ++m)
#pragma unroll
                for (int n = 0; n < 2; ++n) acc[a][b][m][n] = (f32x4){0.f, 0.f, 0.f, 0.f};
    bf16x8 At[4][2], B0[2][2], B1[2][2];
    const char* cA = (const char*)g.A + (size_t)cur.pm * tstep; const char* cB = (const char*)g.Bt + (size_t)cur.pn * tstep;
    S.a_ready(cur);
    if constexpr (SP2) {
        PG8_STAGE(PG8_SB(0, 0), cB, voffB); PG8_STAGE(PG8_SB(0, 1), cB + hstep, voffB); PG8_STAGE(PG8_SA(0, 0), cA, voffA); PG8_STAGE(PG8_SA(0, 1), cA + hstep, voffA);
        if (wr == 1) PG8_BAR;
        PG8_WAIT_V(2); PG8_BAR;
        PG8_STAGE(PG8_SB(1, 0), cB + kstep, voffB); PG8_STAGE(PG8_SA(1, 0), cA + kstep, voffA); PG8_STAGE(PG8_SB(1, 1), cB + hstep + kstep, voffB);
        PG8_WAIT_V(6); PG8_BAR;
    } else {
        PG8_STAGE(PG8_SB(0, 0), cB, voffB); PG8_STAGE(PG8_SA(0, 0), cA, voffA); PG8_STAGE(PG8_SB(0, 1), cB + hstep, voffB); PG8_STAGE(PG8_SA(0, 1), cA + hstep, voffA);
        if (wr == 1) PG8_BAR;
        PG8_WAIT_V(4); PG8_BAR;
        PG8_STAGE(PG8_SB(1, 0), cB + kstep, voffB); PG8_STAGE(PG8_SA(1, 0), cA + kstep, voffA); PG8_STAGE(PG8_SB(1, 1), cB + hstep + kstep, voffB);
        PG8_WAIT_V(6); PG8_BAR;
    }
    for (;;) {
        const bool has_next = S.next(ui + 1, nxt);
        const char* nA = has_next ? (const char*)g.A + (size_t)nxt.pm * tstep : cA; const char* nB = has_next ? (const char*)g.Bt + (size_t)nxt.pn * tstep : cB;
        for (int t = 0; t < nt; t += 2) {
            const bool last = (t == nt - 2);
            const char* a1 = cA + (size_t)(t + 1) * kstep;
            const char* a2 = last ? nA : cA + (size_t)(t + 2) * kstep; const char* b2 = last ? nB : cB + (size_t)(t + 2) * kstep;
            const char* a3 = a2 + kstep; const char* b3 = b2 + kstep;
            if (last && has_next) S.a_ready(nxt);
            if constexpr (SP2) {
            PG8_LDB(B0, 0, 0); PG8_LDB(B1, 0, 1); PG8_SCHED; PG8_LDA(At, 0, 0); PG8_STAGE(PG8_SA(1, 1), a1 + hstep, voffA);
            PG8_WAIT_V(8); PG8_WAIT_L(0); PG8_BAR; PG8_MMA(0, 0, At, B0); PG8_MMA(0, 1, At, B1); PG8_BAR; PG8_SCHED;
            PG8_LDA(At, 0, 1); PG8_STAGE(PG8_SB(0, 0), b2, voffB); PG8_STAGE(PG8_SB(0, 1), b2 + hstep, voffB); PG8_STAGE(PG8_SA(0, 0), a2, voffA);
            PG8_WAIT_V(8); PG8_WAIT_L(0); PG8_BAR; PG8_MMA(1, 0, At, B0); PG8_MMA(1, 1, At, B1); PG8_BAR; PG8_SCHED;
            PG8_LDB(B0, 1, 0); PG8_LDB(B1, 1, 1); PG8_SCHED; PG8_LDA(At, 1, 0); PG8_STAGE(PG8_SA(0, 1), a2 + hstep, voffA);
            PG8_WAIT_V(8); PG8_WAIT_L(0); PG8_BAR; PG8_MMA(0, 0, At, B0); PG8_MMA(0, 1, At, B1); PG8_BAR; PG8_SCHED;
            PG8_LDA(At, 1, 1); PG8_STAGE(PG8_SB(1, 0), b3, voffB); PG8_STAGE(PG8_SB(1, 1), b3 + hstep, voffB); PG8_STAGE(PG8_SA(1, 0), a3, voffA);
            PG8_WAIT_V(8); PG8_WAIT_L(0); PG8_BAR; PG8_MMA(1, 0, At, B0); PG8_MMA(1, 1, At, B1); PG8_BAR; PG8_SCHED;
            } else {
            PG8_LDB(B0, 0, 0); PG8_SCHED; PG8_LDA(At, 0, 0); PG8_STAGE(PG8_SA(1, 1), a1 + hstep, voffA);
            PG8_WAIT_L(8); PG8_BAR; PG8_WAIT_L(0); PG8_MMA(0, 0, At, B0); PG8_BAR; PG8_SCHED;
            PG8_LDB(B1, 0, 1); PG8_STAGE(PG8_SB(0, 0), b2, voffB);
            PG8_BAR; PG8_WAIT_L(0); PG8_MMA(0, 1, At, B1); PG8_BAR;
            PG8_LDA(At, 0, 1); PG8_STAGE(PG8_SA(0, 0), a2, voffA);
            PG8_BAR; PG8_WAIT_L(0); PG8_MMA(1, 0, At, B0); PG8_BAR; PG8_SCHED;
            PG8_STAGE(PG8_SB(0, 1), b2 + hstep, voffB);
            PG8_WAIT_V(6); PG8_BAR; PG8_MMA(1, 1, At, B1); PG8_BAR;
            PG8_LDB(B0, 1, 0); PG8_SCHED; PG8_LDA(At, 1, 0); PG8_STAGE(PG8_SA(0, 1), a2 + hstep, voffA);
            PG8_WAIT_L(8); PG8_BAR; PG8_WAIT_L(0); PG8_MMA(0, 0, At, B0); PG8_BAR; PG8_SCHED;
            PG8_LDB(B1, 1, 1); PG8_STAGE(PG8_SB(1, 0), b3, voffB);
            PG8_BAR; PG8_WAIT_L(0); PG8_MMA(0, 1, At, B1); PG8_BAR;
            PG8_LDA(At, 1, 1); PG8_STAGE(PG8_SA(1, 0), a3, voffA);
            PG8_BAR; PG8_WAIT_L(0); PG8_MMA(1, 0, At, B0); PG8_BAR; PG8_SCHED;
            PG8_STAGE(PG8_SB(1, 1), b3 + hstep, voffB);
            PG8_WAIT_V(6); PG8_BAR; PG8_MMA(1, 1, At, B1); PG8_BAR;
            }
        }
        if constexpr (ALIGN_EPI) { if (wr == 0) PG8_BAR; }
        if constexpr (!Epi::AFTER_DRAIN) { E(acc, cur, wr, wc, fr, fq); S.done(cur); }
        if (!has_next) break;
#pragma unroll
        for (int a = 0; a < 2; ++a)
#pragma unroll
            for (int b = 0; b < 2; ++b)
#pragma unroll
                for (int m = 0; m < 4; ++m)
#pragma unroll
                    for (int n = 0; n < 2; ++n) acc[a][b][m][n] = (f32x4){0.f, 0.f, 0.f, 0.f};
        cur = nxt; cA = nA; cB = nB; ++ui;
        if constexpr (ALIGN_EPI) { if (wr == 1) PG8_BAR; }
    }
    PG8_WAIT_V(0);
    if constexpr (!ALIGN_EPI) { if (wr == 0) PG8_BAR; }
    PG8_BAR;
    if constexpr (Epi::AFTER_DRAIN) { E.fused(acc, cur, wr, wc, fr, fq, lds, wid, lane); S.done(cur); }
#undef PG8_SA
#undef PG8_SB
#undef PG8_STAGE
#undef PG8_LDA
#undef PG8_LDB
#undef PG8_MMA
#undef PG8_WAIT_V
#undef PG8_WAIT_L
#undef PG8_BAR
#undef PG8_SCHED
}
}
#include <hip/hip_bf16.h>
#include <cmath>
namespace attn_body {
using bf16=__hip_bfloat16;
using bf16x8=__attribute__((ext_vector_type(8)))short;
using s16x4=__attribute__((ext_vector_type(4)))short;
using f32x16=__attribute__((ext_vector_type(16)))float;
using u32x4=__attribute__((ext_vector_type(4)))unsigned;
constexpr int D=64;
constexpr int NW=8,QBLK=32,QB=QBLK*NW,KVBLK=64;
__device__ __forceinline__ int crow(int r,int hi){return (r&3)+8*(r>>2)+4*hi;}
#define SBAR() __builtin_amdgcn_sched_barrier(0)
__device__ __forceinline__ void cmask(f32x16&p0,f32x16&p1,int jb,int qrel,int hi){
  const float NEG=-INFINITY; int kb=64*jb+4*hi;
  #pragma unroll
  for(int r=0;r<16;++r){int kv=kb+(r&3)+8*(r>>2); if(kv>qrel)p0[r]=NEG; if(kv+32>qrel)p1[r]=NEG;}
}

constexpr int NSLOT=3, SLOTB=8192;
constexpr int LDS_K=0, LDS_V=NSLOT*SLOTB, LDS_WS=2*NSLOT*SLOTB, LDS_OST=LDS_WS+NW*64*4, LDS_BYTES=LDS_OST+NW*4096;
constexpr float C2=0.125f*1.4426950408889634f;
__device__ __forceinline__ void glds16(const void*gsrc,unsigned lds_dst){unsigned keep;
  asm volatile("s_mov_b32 %0, m0\n\ts_mov_b32 m0, %2\n\ts_nop 0\n\tglobal_load_lds_dwordx4 %1, off\n\ts_mov_b32 m0, %0":"=&s"(keep):"v"(gsrc),"s"(lds_dst):"memory");}
__device__ __forceinline__ float max3f(float a,float b,float c){float r;asm("v_max3_f32 %0, %1, %2, %3":"=v"(r):"v"(a),"v"(b),"v"(c));return r;}
__device__ __forceinline__ float max2f(float a,float b){float r;asm("v_max_f32_e32 %0, %1, %2":"=v"(r):"v"(a),"v"(b));return r;}
__device__ __forceinline__ float fadd_s(float a,float b){float r;asm("v_add_f32_e32 %0, %1, %2":"=v"(r):"v"(a),"v"(b));return r;}
__device__ __forceinline__ float fsub_s(float a,float b){float r;asm("v_sub_f32_e32 %0, %1, %2":"=v"(r):"v"(a),"v"(b));return r;}
typedef float f32x2_t __attribute__((ext_vector_type(2))); typedef __bf16 bf16x2_t __attribute__((ext_vector_type(2)));
__device__ __forceinline__ unsigned cvtpk_s(float lo,float hi){f32x2_t v={lo,hi};bf16x2_t b=__builtin_convertvector(v,bf16x2_t);return __builtin_bit_cast(unsigned,b);}
#define WAIT_BAR(N) asm volatile("s_waitcnt vmcnt(" #N ") lgkmcnt(0)\n\ts_barrier":::"memory")

__device__ __forceinline__ void qkt(f32x16&p0,f32x16&p1,const char*Kslot,const bf16x8*qr,const f32x16&negm,int r32,int hi){
  const char*kb=Kslot+hi*1024+r32*16;
  #pragma unroll
  for(int d0=0;d0<4;++d0){
    const bf16x8 b0=*reinterpret_cast<const bf16x8*>(kb+d0*2048);
    const bf16x8 b1=*reinterpret_cast<const bf16x8*>(kb+d0*2048+512);
    if(d0==0){p0=__builtin_amdgcn_mfma_f32_32x32x16_bf16(b0,qr[0],negm,0,0,0);p1=__builtin_amdgcn_mfma_f32_32x32x16_bf16(b1,qr[0],negm,0,0,0);}
    else{p0=__builtin_amdgcn_mfma_f32_32x32x16_bf16(b0,qr[d0],p0,0,0,0);p1=__builtin_amdgcn_mfma_f32_32x32x16_bf16(b1,qr[d0],p1,0,0,0);}}
}
typedef __attribute__((address_space(3))) const char* lds_cptr;
typedef short v4i16_t __attribute__((ext_vector_type(4)));
__device__ __forceinline__ void kload8(bf16x8*kf,lds_cptr kp){
  kf[0]=*(const __attribute__((address_space(3))) bf16x8*)(kp);      kf[1]=*(const __attribute__((address_space(3))) bf16x8*)(kp+512);
  kf[2]=*(const __attribute__((address_space(3))) bf16x8*)(kp+2048); kf[3]=*(const __attribute__((address_space(3))) bf16x8*)(kp+2560);
  kf[4]=*(const __attribute__((address_space(3))) bf16x8*)(kp+4096); kf[5]=*(const __attribute__((address_space(3))) bf16x8*)(kp+4608);
  kf[6]=*(const __attribute__((address_space(3))) bf16x8*)(kp+6144); kf[7]=*(const __attribute__((address_space(3))) bf16x8*)(kp+6656);
}
__device__ __forceinline__ void kload2(bf16x8*kf,lds_cptr kp,int j){ kf[2*j]=*(const __attribute__((address_space(3))) bf16x8*)(kp+j*2048); kf[2*j+1]=*(const __attribute__((address_space(3))) bf16x8*)(kp+j*2048+512); }
__device__ __forceinline__ s16x4 vtr(lds_cptr p){ return __builtin_bit_cast(s16x4,__builtin_amdgcn_ds_read_tr16_b64_v4i16((__attribute__((address_space(3))) v4i16_t*)p)); }
__device__ __forceinline__ float rowmax(const f32x16&p0,const f32x16&p1){
  float a=max3f(p0[0],p0[1],p1[0]),b=max3f(p0[2],p0[3],p1[1]);a=max3f(a,p1[2],p1[3]);
  #pragma unroll
  for(int r=4;r<16;r+=4){a=max3f(a,p0[r],p0[r+1]);b=max3f(b,p0[r+2],p0[r+3]);a=max3f(a,p1[r],p1[r+1]);b=max3f(b,p1[r+2],p1[r+3]);}
  const float m=max2f(a,b);
  auto rr=__builtin_amdgcn_permlane32_swap(__float_as_uint(m),__float_as_uint(m),false,false);
  return max2f(__uint_as_float(rr[0]),__uint_as_float(rr[1]));
}
__device__ __forceinline__ void pv(f32x16*o,int vb,bf16x8 pa0,bf16x8 pa1,bf16x8 pa2,bf16x8 pa3){
  #pragma unroll
  for(int d0=0;d0<2;++d0){s16x4 lo[4],hi[4];
    #pragma unroll
    for(int ks=0;ks<4;++ks){
      asm volatile("ds_read_b64_tr_b16 %0,%1 offset:%c2":"=&v"(lo[ks]):"v"(vb),"i"(d0*4096+ks*1024):"memory");
      asm volatile("ds_read_b64_tr_b16 %0,%1 offset:%c2":"=&v"(hi[ks]):"v"(vb),"i"(d0*4096+ks*1024+512):"memory");}
    asm volatile("s_waitcnt lgkmcnt(0)":::"memory");SBAR();
    #define PK(k) (bf16x8){lo[k][0],lo[k][1],lo[k][2],lo[k][3],hi[k][0],hi[k][1],hi[k][2],hi[k][3]}
    o[d0]=__builtin_amdgcn_mfma_f32_32x32x16_bf16(pa0,PK(0),o[d0],0,0,0);
    o[d0]=__builtin_amdgcn_mfma_f32_32x32x16_bf16(pa1,PK(1),o[d0],0,0,0);
    o[d0]=__builtin_amdgcn_mfma_f32_32x32x16_bf16(pa2,PK(2),o[d0],0,0,0);
    o[d0]=__builtin_amdgcn_mfma_f32_32x32x16_bf16(pa3,PK(3),o[d0],0,0,0);
    #undef PK
  }
}

#ifndef ATTN_STORE16
#define ATTN_STORE16(p,v) (*(u32x4*)(p)=(v))
#endif
template<int THRL> __device__ __forceinline__ void attn_unit(const int b,const int NT,const bf16*Qw0,const int qpitch,const bf16*__restrict__ Kh,const bf16*__restrict__ Vh,const int kvpitch,bf16*Ow0,const int opitch,char*shm){
  const int tid=tid_fresh(),lane=tid&63,r32=lane&31,hi=lane>>5; const int wid=__builtin_amdgcn_readfirstlane(tid>>6);
  const bf16*Qw=Qw0+(long)(wid*QBLK)*qpitch;
  const unsigned lds0=(unsigned)(uintptr_t)shm;
  float*wsf=(float*)(shm+LDS_WS)+wid*64;
  const bf16*ksrc=Kh+(long)lane*kvpitch+wid*8;
  const bf16*vsrc=Vh+(long)(16*(wid&3)+(lane>>2))*kvpitch+(wid>>2)*32+(lane&3)*8;
  const unsigned kdst=lds0+LDS_K+wid*1024, vdst=lds0+LDS_V+wid*1024;
  #define KROW(t) ((long)((t)<4 ? b*256+64*(t) : 2048+b*4096+64*((t)-4)))
  #define DMA_K(t,slot) glds16(ksrc+KROW(t)*kvpitch,(unsigned)__builtin_amdgcn_readfirstlane(kdst+(slot)))
  #define DMA_V(t,slot) glds16(vsrc+KROW(t)*kvpitch,(unsigned)__builtin_amdgcn_readfirstlane(vdst+(slot)))
  const int vb0=(int)(lds0+LDS_V)+((lane>>4)&1)*32+(lane&3)*8+(4*hi+((lane&15)>>2))*64;
  const char*Kbase=shm+LDS_K; bf16x8 kf[8];
  const lds_cptr shm3=(lds_cptr)shm; const lds_cptr kp0=shm3+LDS_K+hi*1024+r32*16; const lds_cptr vp0=shm3+LDS_V+((lane>>4)&1)*32+(lane&3)*8+(4*hi+((lane&15)>>2))*64;
  DMA_K(0,0);DMA_V(0,0);DMA_K(1,SLOTB);
  bf16x8 qr[4];
  #pragma unroll
  for(int d0=0;d0<4;++d0)qr[d0]=*reinterpret_cast<const bf16x8*>(&Qw[(long)r32*qpitch+d0*16+hi*8]);
  float mhat=0.f,l_reg=0.f;f32x16 o[2];o[0]=f32x16{};o[1]=f32x16{};f32x16 negm=f32x16{};asm volatile("":"+v"(negm));
  #define CMASK(P0,P1,t) do{}while(0)
  bool resc=false;
  #define START(P0,P1) do{ const float rm=rowmax(P0,P1); resc=false; \
    { const float dl=rm; mhat=fadd_s(mhat,dl); \
      _Pragma("unroll") for(int r=0;r<16;++r){P0[r]=fsub_s(P0[r],dl);P1[r]=fsub_s(P1[r],dl);} \
      _Pragma("unroll") for(int r=0;r<16;++r)negm[r]=-mhat; asm volatile("":"+v"(negm)); } \
    _Pragma("unroll") for(int r=0;r<16;++r)P0[r]=__builtin_amdgcn_exp2f(P0[r]); }while(0)
  #define RESC() do{ if(resc){ asm volatile("s_waitcnt lgkmcnt(0)":::"memory"); \
      _Pragma("unroll") for(int d_=0;d_<2;++d_) _Pragma("unroll") for(int r=0;r<16;++r)o[d_][r]*=wsf[crow(r,hi)]; } }while(0)
  f32x16 pA0,pA1,pB0,pB1;
  int sl_prev=0,sl_cur=0,sl_next=SLOTB;
  #define ROT() do{sl_prev=sl_cur;sl_cur=sl_next;sl_next=(sl_next==(NSLOT-1)*SLOTB)?0:sl_next+SLOTB;}while(0)
  DMA_K(2,2*SLOTB);
  WAIT_BAR(3);
  qkt(pA0,pA1,Kbase,qr,negm,r32,hi);asm volatile("s_nop 15\n\ts_nop 7":"+v"(pA0),"+v"(pA1));CMASK(pA0,pA1,0);
  START(pA0,pA1);
  _Pragma("unroll") for(int r=0;r<16;++r)pA1[r]=__builtin_amdgcn_exp2f(pA1[r]);
  WAIT_BAR(0);
  DMA_K(3,0);DMA_V(1,SLOTB);
  ROT();
  kload8(kf,kp0+sl_cur);
  WAIT_BAR(2);
  s16x4 vlo[8],vhi[8]; u32x4 pw0,pw1,pw2,pw3;
  #define PKW(P,B) cvtpk_s(P[B],P[B+1])
  #define PAF(k) __builtin_bit_cast(bf16x8,pw##k)
  #define VFR(i) (bf16x8){vlo[i][0],vlo[i][1],vlo[i][2],vlo[i][3],vhi[i][0],vhi[i][1],vhi[i][2],vhi[i][3]}
  #define PIN(x) asm volatile("":"+v"(x))
  #define MX3(a,b,c) __builtin_fmaxf(__builtin_fmaxf((a),(b)),(c))
  #define GAPA(MF,A0,A1,A2,A3,W0,W1,PW) do{ MF; sacc+=A0; sacc+=A1; sacc+=A2; sacc+=A3; PIN(sacc); W0; W1; PIN(PW); SBAR(); }while(0)
  #define EX(v) __builtin_amdgcn_exp2f(v)
  #define GAPB(MF,X,B) do{ MF; X[B]=EX(X[B]); X[B+1]=EX(X[B+1]); X[B+2]=EX(X[B+2]); X[B+3]=EX(X[B+3]); PIN(X); SBAR(); }while(0)
  #define VRD(i) do{ vlo[i]=vtr(vp_+(((i)>>2)*4096+((i)&3)*1024)); vhi[i]=vtr(vp_+(((i)>>2)*4096+((i)&3)*1024+512)); }while(0)
  #define KRD(G,j) do{ if(G){ kload2(kf,kp0+sl_next,j); SBAR(); } }while(0)
  #define STEP(C0,C1,P0,P1,t,GK,GV,GL) do{ SBAR(); \
    const lds_cptr vp_=vp0+sl_prev; \
    VRD(0); SBAR(); float sacc=(P0[0]+P0[1]); \
    GAPA(C0=__builtin_amdgcn_mfma_f32_32x32x16_bf16(kf[0],qr[0],negm,0,0,0), P0[2],P0[3],P0[4],P0[5],     pw0[0]=PKW(P0,0), pw0[1]=PKW(P0,2), pw0); \
    VRD(4); SBAR(); GAPA(C1=__builtin_amdgcn_mfma_f32_32x32x16_bf16(kf[1],qr[0],negm,0,0,0), P0[6],P0[7],P0[8],P0[9],     pw0[2]=PKW(P0,4), pw0[3]=PKW(P0,6), pw0); \
    VRD(1); SBAR(); GAPA(C0=__builtin_amdgcn_mfma_f32_32x32x16_bf16(kf[2],qr[1],C0,0,0,0),   P0[10],P0[11],P0[12],P0[13], pw1[0]=PKW(P0,8), pw1[1]=PKW(P0,10), pw1); \
    VRD(5); SBAR(); GAPA(C1=__builtin_amdgcn_mfma_f32_32x32x16_bf16(kf[3],qr[1],C1,0,0,0),   P0[14],P0[15],P1[0],P1[1],   pw1[2]=PKW(P0,12),pw1[3]=PKW(P0,14), pw1); \
    VRD(2); SBAR(); GAPA(C0=__builtin_amdgcn_mfma_f32_32x32x16_bf16(kf[4],qr[2],C0,0,0,0),   P1[2],P1[3],P1[4],P1[5],     pw2[0]=PKW(P1,0), pw2[1]=PKW(P1,2), pw2); \
    VRD(6); SBAR(); GAPA(C1=__builtin_amdgcn_mfma_f32_32x32x16_bf16(kf[5],qr[2],C1,0,0,0),   P1[6],P1[7],P1[8],P1[9],     pw2[2]=PKW(P1,4), pw2[3]=PKW(P1,6), pw2); \
    VRD(3); SBAR(); GAPA(C0=__builtin_amdgcn_mfma_f32_32x32x16_bf16(kf[6],qr[3],C0,0,0,0),   P1[10],P1[11],P1[12],P1[13], pw3[0]=PKW(P1,8), pw3[1]=PKW(P1,10), pw3); \
    VRD(7); SBAR(); GAPA(C1=__builtin_amdgcn_mfma_f32_32x32x16_bf16(kf[7],qr[3],C1,0,0,0),   P1[14],P1[15],0.f,0.f,       pw3[2]=PKW(P1,12),pw3[3]=PKW(P1,14), pw3); \
    l_reg+=sacc; \
    if(GK){DMA_K((t)+3,sl_cur);} if(GV){DMA_V((t)+1,sl_next);} \
    CMASK(C0,C1,t); \
    { float a=MX3(C0[0],C0[1],C1[0]),b=MX3(C0[2],C0[3],C1[1]); a=MX3(a,C1[2],C1[3]); \
      _Pragma("unroll") for(int r=4;r<16;r+=4){a=MX3(a,C0[r],C0[r+1]);b=MX3(b,C0[r+2],C0[r+3]);a=MX3(a,C1[r],C1[r+1]);b=MX3(b,C1[r+2],C1[r+3]);} \
      float rm=__builtin_fmaxf(a,b); { auto rr=__builtin_amdgcn_permlane32_swap(__float_as_uint(rm),__float_as_uint(rm),false,false); rm=__builtin_fmaxf(__uint_as_float(rr[0]),__uint_as_float(rr[1])); } \
      resc=false; \
      if(__builtin_expect(__any(rm>(float)THRL),0)){ const float dl=__builtin_fmaxf(rm,0.f); mhat+=dl; \
        _Pragma("unroll") for(int r=0;r<16;++r){C0[r]-=dl;C1[r]-=dl;} \
        _Pragma("unroll") for(int r=0;r<16;++r)negm[r]=-mhat; asm volatile("":"+v"(negm)); \
        const float f=__builtin_amdgcn_exp2f(-dl); l_reg*=f; if(hi==0)wsf[r32]=f; resc=true; } } \
    SBAR(); \
    GAPB(o[0]=__builtin_amdgcn_mfma_f32_32x32x16_bf16(PAF(0),VFR(0),o[0],0,0,0), C0,0); \
    GAPB(o[1]=__builtin_amdgcn_mfma_f32_32x32x16_bf16(PAF(0),VFR(4),o[1],0,0,0), C0,4); \
    KRD(GL,0); GAPB(o[0]=__builtin_amdgcn_mfma_f32_32x32x16_bf16(PAF(1),VFR(1),o[0],0,0,0), C0,8); \
    KRD(GL,1); GAPB(o[1]=__builtin_amdgcn_mfma_f32_32x32x16_bf16(PAF(1),VFR(5),o[1],0,0,0), C0,12); \
    KRD(GL,2); GAPB(o[0]=__builtin_amdgcn_mfma_f32_32x32x16_bf16(PAF(2),VFR(2),o[0],0,0,0), C1,0); \
    KRD(GL,3); GAPB(o[1]=__builtin_amdgcn_mfma_f32_32x32x16_bf16(PAF(2),VFR(6),o[1],0,0,0), C1,4); \
    GAPB(o[0]=__builtin_amdgcn_mfma_f32_32x32x16_bf16(PAF(3),VFR(3),o[0],0,0,0), C1,8); \
    GAPB(o[1]=__builtin_amdgcn_mfma_f32_32x32x16_bf16(PAF(3),VFR(7),o[1],0,0,0), C1,12); \
    }while(0)
  int t=1;
  #undef CMASK
  #define CMASK(P0,P1,t) do{}while(0)
  for(;t+5<NT;t+=2){
    STEP(pB0,pB1,pA0,pA1,t,true,true,true);     WAIT_BAR(2); RESC(); ROT();
    STEP(pA0,pA1,pB0,pB1,t+1,true,true,true);   WAIT_BAR(2); RESC(); ROT();
  }
  #undef CMASK
  #define CMASK(P0,P1,t) do{}while(0)
  #define ENDW(tt) do{ if((tt)+3<NT){WAIT_BAR(2);} else if((tt)+2<NT){WAIT_BAR(1);} else {WAIT_BAR(0);} }while(0)
  for(;t+1<NT;t+=2){
    STEP(pB0,pB1,pA0,pA1,t,(t+3<NT),(t+1<NT),(t+1<NT));       ENDW(t);   RESC(); ROT();
    STEP(pA0,pA1,pB0,pB1,t+1,(t+4<NT),(t+2<NT),(t+2<NT));     ENDW(t+1); RESC(); ROT();
  }
  STEP(pB0,pB1,pA0,pA1,NT-1,false,false,false); RESC();
  { float sacc=pB0[0]+pB0[1]; _Pragma("unroll") for(int r=2;r<16;++r)sacc+=pB0[r]; _Pragma("unroll") for(int r=0;r<16;++r)sacc+=pB1[r]; l_reg+=sacc;
    pw0=(u32x4){PKW(pB0,0),PKW(pB0,2),PKW(pB0,4),PKW(pB0,6)};pw1=(u32x4){PKW(pB0,8),PKW(pB0,10),PKW(pB0,12),PKW(pB0,14)};pw2=(u32x4){PKW(pB1,0),PKW(pB1,2),PKW(pB1,4),PKW(pB1,6)};pw3=(u32x4){PKW(pB1,8),PKW(pB1,10),PKW(pB1,12),PKW(pB1,14)};
    SBAR(); pv(o,vb0+sl_cur,PAF(0),PAF(1),PAF(2),PAF(3)); }
  #undef PKW
  #undef PAF
  #undef VFR
  #undef PIN
  #undef MX3
  #undef GAPA
  #undef GAPB
  #undef EX
  #undef VRD
  #undef KRD
  #undef STEP
  #undef ENDW
  {auto rr=__builtin_amdgcn_permlane32_swap(__float_as_uint(l_reg),__float_as_uint(l_reg),false,false);l_reg=__uint_as_float(rr[0])+__uint_as_float(rr[1]);}
  if(hi==0)wsf[32+r32]=l_reg;asm volatile("s_waitcnt lgkmcnt(0)":::"memory");
  float rli[16];
  #pragma unroll
  for(int r=0;r<16;++r)rli[r]=__builtin_amdgcn_rcpf(wsf[32+crow(r,hi)]);
  bf16*Ow=Ow0+(long)(wid*QBLK)*opitch;
  { bf16*stg=(bf16*)(shm+LDS_OST)+wid*2048;
    #pragma unroll
    for(int r=0;r<16;++r){const int orow=crow(r,hi);
      #pragma unroll
      for(int d0=0;d0<2;++d0)stg[orow*64+d0*32+r32]=__float2bfloat16(o[d0][r]*rli[r]);}
    asm volatile("s_waitcnt lgkmcnt(0)":::"memory");
    #pragma unroll
    for(int i=0;i<4;++i){const int row=i*8+(lane>>3),ch=lane&7; const u32x4 v=*(const u32x4*)(stg+row*64+ch*8); ATTN_STORE16(Ow+(long)row*opitch+ch*8,v);} }
  asm volatile("s_waitcnt lgkmcnt(0)\n\ts_barrier":::"memory");
  #undef DMA_K
  #undef KROW
  #undef DMA_V
  #undef CMASK
  #undef START
  #undef RESC
  #undef ROT
}
constexpr int ATTN_LDS_BYTES=LDS_BYTES;
#undef SBAR
#undef WAIT_BAR
}
#define LAS __attribute__((address_space(3)))
typedef unsigned short bfs;
typedef float f32x4 __attribute__((ext_vector_type(4)));
typedef float f32x16 __attribute__((ext_vector_type(16)));
typedef unsigned u32x4 __attribute__((ext_vector_type(4)));
typedef unsigned u32x2 __attribute__((ext_vector_type(2)));
typedef short s16x8 __attribute__((ext_vector_type(8)));
constexpr int DM = 1024, NB = 8, SEQ = 4096, NCTX = 256;
constexpr int RCTX = NB * NCTX, RLAT = NB * SEQ, ROWS = RCTX + RLAT;
constexpr int DFF = 2816, NGU = 2 * DFF;
constexpr int NIN0 = 2336, PIN0 = 2560, NIN1 = 5120;
constexpr int C_GQ = 0, C_GK = 256, C_GV = 512, C_GOG = 1024, C_GZ = 1536, C_AQ = 1568, C_AK = 2080, C_AV = 2208;
constexpr int C_FQ = 0, C_FF = 1024, C_FI = 3072, C_FOG = 4096;
constexpr float RMS_EPS = 1e-6f;
constexpr size_t MiB = 1u << 20;
constexpr size_t WS_CTL = 0, CTL_BYTES = 65536;
constexpr size_t WS_MOD = 1 * MiB;
constexpr size_t WS_LB = WS_MOD + 512 * 1024;
constexpr size_t WS_XCTX = 2 * MiB;
constexpr size_t WS_WIN0 = 10 * MiB, WS_WOUT0 = 15 * MiB, WS_WGU0 = 17 * MiB, WS_WD0 = 28 * MiB;
constexpr size_t WS_WIN1 = 34 * MiB, WS_WOUT1 = 44 * MiB, WS_WGU1 = 46 * MiB, WS_WD1 = 57 * MiB;
constexpr size_t WS_C = 64 * MiB;
constexpr size_t WS_D = 132 * MiB;
constexpr size_t WS_Y = WS_D + 192 * MiB;
constexpr size_t WS_E0 = WS_D + 260 * MiB;
constexpr size_t WS_END = WS_D + 340 * MiB + 40 * MiB;
constexpr int OSPLIT = 16384;
static_assert(WS_WD1 + (size_t)DM * DFF * 2 <= WS_C && WS_C + (size_t)ROWS * DM * 2 <= WS_D && (size_t)ROWS * DFF * 2 <= 192 * MiB && (size_t)ROWS * NIN1 * 2 <= 340 * MiB, "ws map");
constexpr int LDS_CTL_OFF = 153600, LDS_BYTES = 154112;
constexpr int NWAVES = 8, NTHR = 512;

__device__ __forceinline__ float bf2f(unsigned h) { return __uint_as_float(h << 16); }
__device__ __forceinline__ unsigned f2bf(float f) { unsigned u = __float_as_uint(f); return (u + 0x7fffu + ((u >> 16) & 1u)) >> 16; }
__device__ __forceinline__ unsigned pk2(float lo, float hi) { return pg8::cvt_pk_bf16(lo, hi); }
__device__ __forceinline__ float dpp_ror(float x, const int n) {
    switch (n) {
    case 8: return __int_as_float(__builtin_amdgcn_update_dpp(0, __float_as_int(x), 0x128, 0xf, 0xf, false));
    case 4: return __int_as_float(__builtin_amdgcn_update_dpp(0, __float_as_int(x), 0x124, 0xf, 0xf, false));
    case 2: return __int_as_float(__builtin_amdgcn_update_dpp(0, __float_as_int(x), 0x122, 0xf, 0xf, false));
    default: return __int_as_float(__builtin_amdgcn_update_dpp(0, __float_as_int(x), 0x121, 0xf, 0xf, false));
    }
}
__device__ __forceinline__ float wave_sum(float v) {
    v += dpp_ror(v, 8); v += dpp_ror(v, 4); v += dpp_ror(v, 2); v += dpp_ror(v, 1);
    const int vi = __float_as_int(v);
    const float r0 = __int_as_float(__builtin_amdgcn_readlane(vi, 0)), r1 = __int_as_float(__builtin_amdgcn_readlane(vi, 16)), r2 = __int_as_float(__builtin_amdgcn_readlane(vi, 32)), r3 = __int_as_float(__builtin_amdgcn_readlane(vi, 48));
    return (r0 + r1) + (r2 + r3);
}
__device__ __forceinline__ float siluf(float x) { return x * __builtin_amdgcn_rcpf(1.f + __expf(-x)); }

struct Args { const float* in[24]; float* out; unsigned char* ws; };

__device__ __forceinline__ void p0_transpose_item(const float* W, int K, int N, bfs* WT, int k0, int n0, int drow0, LAS float* scr, int lane) {
    float tv[32];
#pragma unroll
    for (int i = 0; i < 32; ++i) tv[i] = W[(size_t)(k0 + 2 * i + (lane >> 5)) * N + n0 + (lane & 31)];
#pragma unroll
    for (int i = 0; i < 32; ++i) scr[(2 * i + (lane >> 5)) * 33 + (lane & 31)] = tv[i];
    asm volatile("s_waitcnt lgkmcnt(0)" ::: "memory");
    const int c = lane & 7;
#pragma unroll
    for (int j = 0; j < 4; ++j) { const int n = (lane >> 3) + 8 * j; const LAS float* s = scr + (8 * c) * 33 + n;
        u32x4 o; o.x = pk2(s[0 * 33], s[1 * 33]); o.y = pk2(s[2 * 33], s[3 * 33]); o.z = pk2(s[4 * 33], s[5 * 33]); o.w = pk2(s[6 * 33], s[7 * 33]);
        *(u32x4*)(WT + (size_t)(drow0 + n) * K + k0 + 8 * c) = o; }
    asm volatile("s_waitcnt lgkmcnt(0)" ::: "memory");
}
__device__ __forceinline__ bool p0_try(int& r, const float* W, int K, int N, bfs* WT, int mode  , LAS float* scr, int lane) {
    const int nblk = N / 32, cnt = (K / 64) * nblk;
    if (r >= cnt) { r -= cnt; return false; }
    const int kb = r / nblk, nb = r % nblk, n0 = 32 * nb;
    const int drow0 = mode == 0 ? n0 : ((n0 >> 7) * 256 + (n0 & 127) + (mode == 2 ? 128 : 0));
    p0_transpose_item(W, K, N, WT, 64 * kb, n0, drow0, scr, lane);
    return true;
}
constexpr int P0_I_IN0 = 16 * (NIN0 / 32), P0_I_SQ = 16 * 32, P0_I_G = 16 * (DFF / 32), P0_I_D = (DFF / 64) * 32, P0_I_IN1 = 16 * (NIN1 / 32);
constexpr int P0_NA = P0_I_IN0 + P0_I_SQ + 2 * P0_I_G + P0_I_D + P0_I_IN1, P0_NITEMS = P0_NA + P0_I_SQ + 2 * P0_I_G + P0_I_D;
__device__ __forceinline__ void p0_weights(const Args& a, LAS unsigned char* lds, int it_lo, int it_hi, int gw, int NGW) {
    const int tid = tid_fresh(), lane = tid & 63, wave = tid >> 6;
    unsigned char* ws = a.ws;
    LAS float* scr = (LAS float*)(lds + wave * 16384);
    for (int it = it_lo + gw; it < it_hi; it += NGW) {
        int r = it;
        if (p0_try(r, a.in[10], 1024, NIN0, (bfs*)(ws + WS_WIN0), 0, scr, lane)) continue;
        if (p0_try(r, a.in[16], 1024, 1024, (bfs*)(ws + WS_WOUT0), 0, scr, lane)) continue;
        if (p0_try(r, a.in[21], 1024, DFF, (bfs*)(ws + WS_WGU0), 1, scr, lane)) continue;
        if (p0_try(r, a.in[22], 1024, DFF, (bfs*)(ws + WS_WGU0), 2, scr, lane)) continue;
        if (p0_try(r, a.in[23], DFF, 1024, (bfs*)(ws + WS_WD0), 0, scr, lane)) continue;
        if (p0_try(r, a.in[17], 1024, NIN1, (bfs*)(ws + WS_WIN1), 0, scr, lane)) continue;
        if (p0_try(r, a.in[20], 1024, 1024, (bfs*)(ws + WS_WOUT1), 0, scr, lane)) continue;
        if (p0_try(r, a.in[21] + (size_t)1024 * DFF, 1024, DFF, (bfs*)(ws + WS_WGU1), 1, scr, lane)) continue;
        if (p0_try(r, a.in[22] + (size_t)1024 * DFF, 1024, DFF, (bfs*)(ws + WS_WGU1), 2, scr, lane)) continue;
        p0_try(r, a.in[23] + (size_t)DFF * 1024, DFF, 1024, (bfs*)(ws + WS_WD1), 0, scr, lane);
    }
}
__device__ __forceinline__ void p0_phase(const Args& a, LAS unsigned char* lds, int G) {
    const int tid = tid_fresh(), lane = tid & 63, wave = tid >> 6;
    unsigned char* ws = a.ws;
    {
        LAS float* sc = (LAS float*)lds;
        LAS float* red = (LAS float*)(lds + 40960);
        for (int i = tid; i < 9 * 1024; i += NTHR) { const float v = i < 8192 ? a.in[1][i] : a.in[3][i - 8192]; sc[i] = siluf(v); }
        __syncthreads();
        float* MOD = (float*)(ws + WS_MOD);
        for (int it = blockIdx.x; it < 192; it += G) {
            const int l = it / 96, cb = it % 96, col = cb * 64 + lane;
            const float* w = a.in[4] + (size_t)l * 1024 * 6144 + (size_t)(wave * 128) * 6144 + col;
            float acc[9];
#pragma unroll
            for (int bb = 0; bb < 9; ++bb) acc[bb] = 0.f;
            for (int k0 = 0; k0 < 128; k0 += 32) {
                float wv[32];
#pragma unroll
                for (int j = 0; j < 32; ++j) wv[j] = w[(size_t)(k0 + j) * 6144];
#pragma unroll
                for (int j = 0; j < 32; ++j)
#pragma unroll
                    for (int bb = 0; bb < 9; ++bb) acc[bb] += sc[bb * 1024 + wave * 128 + k0 + j] * wv[j];
            }
#pragma unroll
            for (int bb = 0; bb < 9; ++bb) red[(wave * 9 + bb) * 64 + lane] = acc[bb];
            __syncthreads();
            for (int i = tid; i < 9 * 64; i += NTHR) { float s = 0.f;
#pragma unroll
                for (int w8 = 0; w8 < 8; ++w8) s += red[w8 * 576 + i];
                const int bb = i / 64, c = cb * 64 + (i & 63);
                MOD[((size_t)l * 9 + bb) * 6144 + c] = s + a.in[5][l * 6144 + c]; }
            __syncthreads();
        }
        float* LB = (float*)(ws + WS_LB);
        for (int i = blockIdx.x * NTHR + tid; i < 2048; i += G * NTHR) { const int d = i >> 10, f = i & 1023; const float x0 = a.in[18][d * 2048 + f], x1 = a.in[18][d * 2048 + 1024 + f]; LB[i] = 1.f / (1.f + __expf(x0 - x1)); }
        { u32x4* z = (u32x4*)(ws + WS_WIN0 + (size_t)NIN0 * 1024 * 2); const int n16 = (PIN0 - NIN0) * 1024 * 2 / 16;
          for (int i = blockIdx.x * NTHR + tid; i < n16; i += G * NTHR) z[i] = (u32x4){0u, 0u, 0u, 0u}; }
        __syncthreads();
    }
    p0_weights(a, lds, 0, (G >= 256) ? P0_NA : P0_NITEMS, blockIdx.x * NWAVES + wave, G * NWAVES);
}

struct RowOp {
    const void* xin_lat; const void* xin_ctx; void* xout_lat; void* xout_ctx;
    const bfs* y; const float* gpost; const float* modg; int gate_idx;
    bfs* h; const float* gpre; const float* modh; int shift_idx, scale_idx;
    int row_lo; int xin_bf, xout_bf;
};
__device__ __forceinline__ void row_phase(const RowOp op, int G, int row_lo_ = -1, int row_hi_ = ROWS, int blk_ = -1, int nblk_ = 0) {
    const int tid_ = tid_fresh(); const int lane = tid_ & 63, wave = tid_ >> 6;
    const int rlo = row_lo_ < 0 ? op.row_lo : row_lo_;
    const int gw = (blk_ < 0 ? (int)blockIdx.x : blk_) * NWAVES + wave, NGW = (blk_ < 0 ? G : nblk_) * NWAVES;
    const int rpw = (row_hi_ - rlo + NGW - 1) / NGW;
    const int r0 = rlo + gw * rpw, r1 = (r0 + rpw < row_hi_) ? r0 + rpw : row_hi_;
    if (r0 >= r1) return;
    f32x4 gp[4], gpre[4], gt[4], sh[4], sc[4];
#pragma unroll
    for (int j = 0; j < 4; ++j) { const int c = 4 * lane + 256 * j; gp[j] = op.y ? *(const f32x4*)(op.gpost + c) : (f32x4){0.f, 0.f, 0.f, 0.f}; gpre[j] = op.h ? *(const f32x4*)(op.gpre + c) : (f32x4){0.f, 0.f, 0.f, 0.f};
        gt[j] = sh[j] = sc[j] = (f32x4){0.f, 0.f, 0.f, 0.f}; }
    int cur_bb = -1;
    f32x4 xn[4]; u32x2 xnb[4], yn[4];
#pragma unroll
    for (int j = 0; j < 4; ++j) { xn[j] = (f32x4){0.f, 0.f, 0.f, 0.f}; xnb[j] = (u32x2){0u, 0u}; }
#define ROW_LOAD(r) do { const bool ic_ = (r) < RCTX; const size_t ro_ = ic_ ? (size_t)(r) * DM : (size_t)((r) - RCTX) * DM; const void* xb_ = ic_ ? op.xin_ctx : op.xin_lat; \
        if (op.xin_bf) { _Pragma("unroll") for (int j = 0; j < 4; ++j) xnb[j] = __builtin_nontemporal_load((const u32x2*)((const bfs*)xb_ + ro_ + 4 * lane + 256 * j)); } \
        else { _Pragma("unroll") for (int j = 0; j < 4; ++j) xn[j] = __builtin_nontemporal_load((const f32x4*)((const float*)xb_ + ro_ + 4 * lane + 256 * j)); } \
        _Pragma("unroll") for (int j = 0; j < 4; ++j) yn[j] = op.y ? __builtin_nontemporal_load((const u32x2*)(op.y + (size_t)(r) * DM + 4 * lane + 256 * j)) : (u32x2){0u, 0u}; } while (0)
    ROW_LOAD(r0);
    for (int r = r0; r < r1; ++r) {
        const bool isctx = r < RCTX; const int bb = isctx ? 8 : (r - RCTX) / SEQ;
        f32x4 v[4]; u32x2 yw[4];
#pragma unroll
        for (int j = 0; j < 4; ++j) { v[j] = op.xin_bf ? (f32x4){bf2f(xnb[j].x & 0xffffu), bf2f(xnb[j].x >> 16), bf2f(xnb[j].y & 0xffffu), bf2f(xnb[j].y >> 16)} : xn[j]; yw[j] = yn[j]; }
        if (r + 1 < r1) ROW_LOAD(r + 1);
        if (bb != cur_bb) { cur_bb = bb;
#pragma unroll
            for (int j = 0; j < 4; ++j) { const int c = 4 * lane + 256 * j;
                if (op.y) gt[j] = *(const f32x4*)(op.modg + (size_t)bb * 6144 + op.gate_idx * 1024 + c);
                if (op.h) { sh[j] = *(const f32x4*)(op.modh + (size_t)bb * 6144 + op.shift_idx * 1024 + c); sc[j] = *(const f32x4*)(op.modh + (size_t)bb * 6144 + op.scale_idx * 1024 + c) + 1.f; } } }
        if (op.y) {
            f32x4 yv[4]; float ss = 0.f;
#pragma unroll
            for (int j = 0; j < 4; ++j) { yv[j] = (f32x4){bf2f(yw[j].x & 0xffffu), bf2f(yw[j].x >> 16), bf2f(yw[j].y & 0xffffu), bf2f(yw[j].y >> 16)};
                ss += (yv[j].x * yv[j].x + yv[j].y * yv[j].y) + (yv[j].z * yv[j].z + yv[j].w * yv[j].w); }
            const float rinv = rsqrtf(wave_sum(ss) * (1.f / DM) + RMS_EPS);
            void* xob = isctx ? op.xout_ctx : op.xout_lat; const size_t xoo = isctx ? (size_t)r * DM : (size_t)(r - RCTX) * DM;
#pragma unroll
            for (int j = 0; j < 4; ++j) { v[j] = v[j] + gt[j] * (yv[j] * rinv * gp[j]);
                if (xob) { if (op.xout_bf) { u32x2 wx; wx.x = pk2(v[j].x, v[j].y); wx.y = pk2(v[j].z, v[j].w); __builtin_nontemporal_store(wx, (u32x2*)((bfs*)xob + xoo + 4 * lane + 256 * j));
                        v[j] = (f32x4){bf2f(wx.x & 0xffffu), bf2f(wx.x >> 16), bf2f(wx.y & 0xffffu), bf2f(wx.y >> 16)}; }
                    else __builtin_nontemporal_store(v[j], (f32x4*)((float*)xob + xoo + 4 * lane + 256 * j)); } }
        }
        if (op.h) {
            float ss = 0.f;
#pragma unroll
            for (int j = 0; j < 4; ++j) ss += (v[j].x * v[j].x + v[j].y * v[j].y) + (v[j].z * v[j].z + v[j].w * v[j].w);
            const float rinv = rsqrtf(wave_sum(ss) * (1.f / DM) + RMS_EPS);
#pragma unroll
            for (int j = 0; j < 4; ++j) { const f32x4 hv = (v[j] * rinv * gpre[j]) * sc[j] + sh[j];
                u32x2 w; w.x = pk2(hv.x, hv.y); w.y = pk2(hv.z, hv.w);
                *(u32x2*)(op.h + (size_t)r * DM + 4 * lane + 256 * j) = w; }
        }
    }
#undef ROW_LOAD
}

__device__ __forceinline__ void qk_phase(bfs* proj, const float* gq, const float* gk, int G) {
    const int tid_ = tid_fresh(); const int lane = tid_ & 63, wave = tid_ >> 6;
    const int gw = blockIdx.x * NWAVES + wave, NGW = G * NWAVES;
    const int sub = lane & 7;
    float gqv[8], gkv[8], inv[4];
#pragma unroll
    for (int e = 0; e < 8; ++e) { gqv[e] = gq[8 * sub + e]; gkv[e] = gk[8 * sub + e]; }
#pragma unroll
    for (int p = 0; p < 4; ++p) { const int pi = (4 * sub + p) & 15; inv[p] = exp2f(-(float)(2 * pi) * (13.287712379549449f / 32.f)); }
    const int rpw = (ROWS + NGW - 1) / NGW; const int r0 = gw * rpw, r1 = (r0 + rpw < ROWS) ? r0 + rpw : ROWS;
    u32x4 qn = (u32x4){0u, 0u, 0u, 0u}, kn = qn;
    if (r0 < r1) { qn = *(const u32x4*)(proj + (size_t)r0 * PIN0 + C_AQ + 8 * lane); kn = *(const u32x4*)(proj + (size_t)r0 * PIN0 + C_AK + 8 * (lane & 15)); }
    for (int r = r0; r < r1; ++r) {
        const bool lat = r >= RCTX; const int t = lat ? (r - RCTX) % SEQ : 0;
        const float pos = (sub < 4) ? (float)(t >> 6) : (float)(t & 63);
        float cs[4], sn[4];
#pragma unroll
        for (int p = 0; p < 4; ++p) { if (lat) { const float ang = pos * inv[p]; cs[p] = __cosf(ang); sn[p] = __sinf(ang);     } else { cs[p] = 1.f; sn[p] = 0.f; } }
        bfs* qp = proj + (size_t)r * PIN0 + C_AQ + 8 * lane;
        bfs* kp = proj + (size_t)r * PIN0 + C_AK + 8 * (lane & 15);
        const u32x4 qw = qn; const u32x4 kw = kn;
        if (r + 1 < r1) { qn = *(const u32x4*)(qp + PIN0); kn = *(const u32x4*)(kp + PIN0); }
        float q[8], k[8]; float sq = 0.f, sk = 0.f;
#pragma unroll
        for (int e = 0; e < 4; ++e) { q[2 * e] = bf2f(qw[e] & 0xffffu); q[2 * e + 1] = bf2f(qw[e] >> 16); k[2 * e] = bf2f(kw[e] & 0xffffu); k[2 * e + 1] = bf2f(kw[e] >> 16); }
#pragma unroll
        for (int e = 0; e < 8; ++e) { sq += q[e] * q[e]; sk += k[e] * k[e]; }
#pragma unroll
        for (int o = 1; o < 8; o <<= 1) { sq += __shfl_xor(sq, o); sk += __shfl_xor(sk, o); }
        const float rq = rsqrtf(sq * (1.f / 64.f) + RMS_EPS) , rk = rsqrtf(sk * (1.f / 64.f) + RMS_EPS);
        const float C2 = 0.125f * 1.4426950408889634f;
        u32x4 qo, ko;
#pragma unroll
        for (int p = 0; p < 4; ++p) {
            const float q0 = q[2 * p] * rq * gqv[2 * p], q1 = q[2 * p + 1] * rq * gqv[2 * p + 1];
            const float k0 = k[2 * p] * rk * gkv[2 * p], k1 = k[2 * p + 1] * rk * gkv[2 * p + 1];
            qo[p] = pk2((q0 * cs[p] - q1 * sn[p]) * C2, (q0 * sn[p] + q1 * cs[p]) * C2);
            ko[p] = pk2(k0 * cs[p] - k1 * sn[p], k0 * sn[p] + k1 * cs[p]);
        }
        *(u32x4*)qp = qo;
        if (lane < 16) *(u32x4*)kp = ko;
    }
}

template <int NCOL> __device__ __forceinline__ void readout_phase(const bfs* of, int pf, const bfs* ob, int pb, const bfs* ob2, int osplit, bfs* out, const bfs* proj, int pitch, int ogcol, const float* gain, int row_lo, int G) {
    constexpr int PL = NCOL / 64;
    constexpr int LPH = 128 / PL;
    const int tid_ = tid_fresh(); const int lane = tid_ & 63, wave = tid_ >> 6;
    const int gw = blockIdx.x * NWAVES + wave, NGW = G * NWAVES;
    float gv[PL];
#pragma unroll
    for (int e = 0; e < PL; ++e) gv[e] = gain[(PL * lane + e) & 127];
    const int rpw = (ROWS - row_lo + NGW - 1) / NGW; const int r0 = row_lo + gw * rpw, r1 = (r0 + rpw < ROWS) ? r0 + rpw : ROWS;
    u32x4 fn[PL / 8], bn[PL / 8], gn[PL / 8];
#define RO_LOAD(r) do { _Pragma("unroll") for (int c = 0; c < PL / 8; ++c) { fn[c] = *(const u32x4*)(of + (size_t)(r) * pf + PL * lane + 8 * c); bn[c] = *(const u32x4*)(((r) >= osplit ? ob2 : ob) + (size_t)(r) * pb + PL * lane + 8 * c); gn[c] = *(const u32x4*)(proj + (size_t)(r) * pitch + ogcol + PL * lane + 8 * c); } } while (0)
    if (r0 < r1) RO_LOAD(r0);
    for (int r = r0; r < r1; ++r) {
        float x[PL], g[PL]; float ss = 0.f;
#pragma unroll
        for (int c = 0; c < PL / 8; ++c) { const u32x4 fw = fn[c], bw = bn[c], gw4 = gn[c];
#pragma unroll
            for (int e = 0; e < 4; ++e) { x[8 * c + 2 * e] = bf2f(fw[e] & 0xffffu) + bf2f(bw[e] & 0xffffu); x[8 * c + 2 * e + 1] = bf2f(fw[e] >> 16) + bf2f(bw[e] >> 16); g[8 * c + 2 * e] = bf2f(gw4[e] & 0xffffu); g[8 * c + 2 * e + 1] = bf2f(gw4[e] >> 16); } }
        if (r + 1 < r1) RO_LOAD(r + 1);
#pragma unroll
        for (int e = 0; e < PL; ++e) ss += x[e] * x[e];
#pragma unroll
        for (int of2 = 1; of2 < LPH; of2 <<= 1) ss += __shfl_xor(ss, of2);
        const float rinv = rsqrtf(ss * (1.f / 128.f) + RMS_EPS);
#pragma unroll
        for (int c = 0; c < PL / 8; ++c) { u32x4 wv;
#pragma unroll
            for (int e = 0; e < 4; ++e) wv[e] = pk2(x[8 * c + 2 * e] * rinv * gv[8 * c + 2 * e] * siluf(g[8 * c + 2 * e]), x[8 * c + 2 * e + 1] * rinv * gv[8 * c + 2 * e + 1] * siluf(g[8 * c + 2 * e + 1]));
            *(u32x4*)(out + (size_t)r * DM + PL * lane + 8 * c) = wv; }
    }
#undef RO_LOAD
}

namespace scan {
#define SC_LBAR() asm volatile("s_waitcnt lgkmcnt(0)\n\ts_barrier" ::: "memory")
template <int PB> __device__ __forceinline__ int swz(int row, int chunk) {
    if (PB == 256) return row * 256 + ((chunk ^ (row & 15) ^ ((row >> 4) & 3)) << 4);
    else return row * 128 + ((chunk ^ (((row >> 1) ^ (row >> 4)) & 7)) << 4);
}
__device__ __forceinline__ int crow(int r, int hi) { return (r & 3) + 8 * (r >> 2) + 4 * hi; }
__device__ __forceinline__ float dpp_shr(float x, float old, const int n) {
    switch (n) {
    case 1: return __int_as_float(__builtin_amdgcn_update_dpp(__float_as_int(old), __float_as_int(x), 0x111, 0xf, 0xf, false));
    case 2: return __int_as_float(__builtin_amdgcn_update_dpp(__float_as_int(old), __float_as_int(x), 0x112, 0xf, 0xf, false));
    case 4: return __int_as_float(__builtin_amdgcn_update_dpp(__float_as_int(old), __float_as_int(x), 0x114, 0xf, 0xf, false));
    default: return __int_as_float(__builtin_amdgcn_update_dpp(__float_as_int(old), __float_as_int(x), 0x118, 0xf, 0xf, false));
    }
}
template <int DK, bool HG, int NV> struct Map {
    static constexpr int PQ = DK * 2;
    static constexpr int O_QG = 0, O_KG = 64 * PQ, O_KGT = 2 * 64 * PQ, O_VT = O_KGT + DK * 128, O_ST = O_VT + NV * 128, O_EGL = O_ST + NV * PQ, O_VR = O_EGL + DK * 4, O_ZB = O_VR + 64 * NV * 2, O_FB = O_ZB + 2048, O_END = HG ? O_ZB : O_FB + 16384;
};
template <int DK, bool HG, int pitch, int NV>
__device__ __forceinline__ void scan_unit(LAS unsigned char* L, const bfs* __restrict__ proj, const int qcol, const int kcol, const int vcol, const int zcol,
                                          const float* __restrict__ wg, const float* __restrict__ bg, bfs* O, bfs* O2, const int osplit, const int opitch, const int ocol, const int b, const int dir, const float qscale) {
    typedef Map<DK, HG, NV> MP;
    constexpr int PQ = MP::PQ, NTG = DK * 4, NVB = NV / 32, NST = (DK / 32) * NVB / 8, WPM = NVB / NST, NPV = NV / 64, VCPR = NV / 8, VPB = NV * 2;
    const int tid = tid_fresh(), lane = tid & 63, r32 = lane & 31, hi = lane >> 5, w = tid >> 6;
    const int c4 = tid >> 4, sg = tid & 15;
    const bool gact = tid < NTG;
    const int mk = w / WPM;
    const int nv0 = (w % WPM) * NST;
    const bool oact = w < 2 * NVB;
    f32x16 S[NST];
#pragma unroll
    for (int i = 0; i < NST; ++i)
#pragma unroll
        for (int r = 0; r < 16; ++r) S[i][r] = 0.f;
    s16x8 wgB = (s16x8){0, 0, 0, 0, 0, 0, 0, 0}; float bias = 0.f;
    if (!HG) {
        const int col = 32 * (w & 1) + r32;
#pragma unroll
        for (int j = 0; j < 8; ++j) wgB[j] = (short)f2bf(wg[(8 * hi + j) * 256 + col]);
        bias = bg[col];
    }
    constexpr int NQ = DK / 64, CPR = DK / 8;
    u32x4 pqA[NQ], pkA[NQ], pvA[NPV]; u32x4 pzA = (u32x4){0u, 0u, 0u, 0u};
#define SC_BASE(s) ({ const int g_ = dir ? ((s) < 4 ? 3 - (s) : 71 - (s)) : (s); (long)(g_ < 4 ? b * 256 + 64 * g_ : 2048 + b * 4096 + 64 * (g_ - 4)); })
#define SC_GROW(base, i) ((base) + (dir ? 63 - (i) : (i)))
#define SC_ISSUE(s) do { const long nb_ = SC_BASE(s); \
        _Pragma("unroll") for (int i = 0; i < NQ; ++i) { const int id = tid + 512 * i, row = id / CPR, c = id % CPR; const bfs* rp = proj + (size_t)SC_GROW(nb_, row) * pitch + 8 * c; pq[i] = *(const u32x4*)(rp + qcol); pk[i] = *(const u32x4*)(rp + kcol); } \
        _Pragma("unroll") for (int i = 0; i < NPV; ++i) { const int id = tid + 512 * i, row = id / VCPR, c = id % VCPR; pv[i] = *(const u32x4*)(proj + (size_t)SC_GROW(nb_, row) * pitch + vcol + 8 * c); } \
        if (!HG) { if (tid < 128) pz = *(const u32x4*)(proj + (size_t)SC_GROW(nb_, tid >> 1) * pitch + zcol + 8 * (tid & 1)); } } while (0)
    { auto& pq = pqA; auto& pk = pkA; auto& pv = pvA; auto& pz = pzA; SC_ISSUE(0); }
    unsigned ost[8]; long pbase = 0;
#pragma unroll
    for (int i = 0; i < 8; ++i) ost[i] = 0u;
#define SC_STORE(bs) do { const int nvt_ = w >> 1, mi_ = w & 1; const int lrow_ = dir ? 63 - (32 * mi_ + 4 * hi) : (32 * mi_ + 4 * hi); const long ostep_ = dir ? -(long)opitch : (long)opitch; \
        bfs* ob_ = (((bs) >= osplit) ? O2 : O) + (size_t)((bs) + lrow_) * opitch + ocol + 32 * nvt_ + r32; \
        _Pragma("unroll") for (int r = 0; r < 16; ++r) ob_[((r & 3) + 8 * (r >> 2)) * ostep_] = (bfs)((r & 1) ? (ost[r >> 1] >> 16) : (ost[r >> 1] & 0xffffu)); } while (0)
    auto body = [&](const int s, u32x4 (&pq)[NQ], u32x4 (&pk)[NQ], u32x4 (&pv)[NPV], u32x4& pz) __attribute__((always_inline)) {
        const long base = SC_BASE(s);
#ifdef PROBE_SEG
        unsigned long long tseg0 = __builtin_amdgcn_s_memrealtime();
#define SEG_MARK(k) do { const unsigned long long tn_ = __builtin_amdgcn_s_memrealtime(); if (HG && blockIdx.x == PROBE_BLK && threadIdx.x == 0 && (PROBE_SEG == (k) || PROBE_SEG == 0)) { volatile LAS unsigned long long* pa_ = (volatile LAS unsigned long long*)(L + 153600 + 64 + 40 * 8); pa_[0] += tn_ - tseg0; } tseg0 = tn_; } while (0)
#else
#define SEG_MARK(k) do {} while (0)
#endif
#pragma unroll
        for (int ti = 0; ti < NST; ++ti) { const int v = 32 * (nv0 + ti) + r32;
#pragma unroll
            for (int r4 = 0; r4 < 4; ++r4) { const int k0 = 32 * mk + 8 * r4 + 4 * hi; u32x2 wv; wv.x = pk2(S[ti][4 * r4], S[ti][4 * r4 + 1]); wv.y = pk2(S[ti][4 * r4 + 2], S[ti][4 * r4 + 3]);
                *(LAS u32x2*)(L + MP::O_ST + swz<PQ>(v, k0 >> 3) + (k0 & 7) * 2) = wv; } }
        if (s > 0 && oact) SC_STORE(pbase);
        pbase = base;
#pragma unroll
        for (int i = 0; i < NQ; ++i) { const int id = tid + 512 * i, row = id / CPR, c = id % CPR;
            *(LAS u32x4*)(L + MP::O_QG + swz<PQ>(row, c)) = pq[i]; *(LAS u32x4*)(L + MP::O_KG + swz<PQ>(row, c)) = pk[i]; }
#pragma unroll
        for (int i = 0; i < NPV; ++i) { const int id = tid + 512 * i, row = id / VCPR, c = id % VCPR; *(LAS u32x4*)(L + MP::O_VR + swz<VPB>(row, c)) = pv[i]; }
        if (!HG) { if (tid < 128) *(LAS u32x4*)(L + MP::O_ZB + (tid >> 1) * 32 + (tid & 1) * 16) = pz; }
        if (s + 1 < 68) SC_ISSUE(s + 1);
        SC_LBAR();
        u32x2 q2[4], k2[4];
#pragma unroll
        for (int r = 0; r < 4; ++r) { q2[r] = (u32x2){0u, 0u}; k2[r] = (u32x2){0u, 0u}; }
        if (gact) {
#pragma unroll
            for (int r = 0; r < 4; ++r) { const int off = swz<PQ>(4 * sg + r, c4 >> 1) + (c4 & 1) * 8; q2[r] = *(const LAS u32x2*)(L + MP::O_QG + off); k2[r] = *(const LAS u32x2*)(L + MP::O_KG + off); } }
        if (c4 < NV / 4) {
            u32x2 v2[4];
#pragma unroll
            for (int r = 0; r < 4; ++r) v2[r] = *(const LAS u32x2*)(L + MP::O_VR + swz<VPB>(4 * sg + r, c4 >> 1) + (c4 & 1) * 8);
            u32x2 t0, t1, t2, t3;
            t0.x = (v2[0].x & 0xffffu) | (v2[1].x << 16); t0.y = (v2[2].x & 0xffffu) | (v2[3].x << 16);
            t1.x = (v2[0].x >> 16) | (v2[1].x & 0xffff0000u); t1.y = (v2[2].x >> 16) | (v2[3].x & 0xffff0000u);
            t2.x = (v2[0].y & 0xffffu) | (v2[1].y << 16); t2.y = (v2[2].y & 0xffffu) | (v2[3].y << 16);
            t3.x = (v2[0].y >> 16) | (v2[1].y & 0xffff0000u); t3.y = (v2[2].y >> 16) | (v2[3].y & 0xffff0000u);
            const int vo = (sg & 1) * 8;
            *(LAS u32x2*)(L + MP::O_VT + swz<128>(4 * c4 + 0, sg >> 1) + vo) = t0; *(LAS u32x2*)(L + MP::O_VT + swz<128>(4 * c4 + 1, sg >> 1) + vo) = t1;
            *(LAS u32x2*)(L + MP::O_VT + swz<128>(4 * c4 + 2, sg >> 1) + vo) = t2; *(LAS u32x2*)(L + MP::O_VT + swz<128>(4 * c4 + 3, sg >> 1) + vo) = t3; }
        float qv[4][4], kv[4][4];
#pragma unroll
        for (int r = 0; r < 4; ++r) { qv[r][0] = bf2f(q2[r].x & 0xffffu); qv[r][1] = bf2f(q2[r].x >> 16); qv[r][2] = bf2f(q2[r].y & 0xffffu); qv[r][3] = bf2f(q2[r].y >> 16);
            kv[r][0] = bf2f(k2[r].x & 0xffffu); kv[r][1] = bf2f(k2[r].x >> 16); kv[r][2] = bf2f(k2[r].y & 0xffffu); kv[r][3] = bf2f(k2[r].y >> 16); }
        if (!HG) {
            if (w < 4) { const int mi = w >> 1, nj = w & 1;
                const s16x8 za = *(const LAS s16x8*)(L + MP::O_ZB + (32 * mi + r32) * 32 + hi * 16);
                f32x16 lg;
#pragma unroll
                for (int r = 0; r < 16; ++r) lg[r] = 0.f;
                lg = __builtin_amdgcn_mfma_f32_32x32x16_bf16(za, wgB, lg, 0, 0, 0);
#pragma unroll
                for (int r = 0; r < 16; ++r) { const float x = lg[r] + bias; const float ls = fminf(x, 0.f) - __logf(1.f + __expf(-fabsf(x)));
                    ((LAS float*)(L + MP::O_FB))[(32 * mi + crow(r, hi)) * 64 + 32 * nj + r32] = __expf(ls * (1.f / 16.f)); } }
            SC_LBAR();
        }
        if (gact) {
            float p[4][4];
#pragma unroll
            for (int r = 0; r < 4; ++r) {
                f32x4 f;
                if (HG) f = (f32x4){1.f - kv[r][0], 1.f - kv[r][1], 1.f - kv[r][2], 1.f - kv[r][3]};
                else f = *(const LAS f32x4*)(L + MP::O_FB + ((4 * sg + r) * 64 + 4 * c4) * 4);
#pragma unroll
                for (int e = 0; e < 4; ++e) p[r][e] = r ? p[r - 1][e] * f[e] : f[e]; }
            float ex[4];
#pragma unroll
            for (int e = 0; e < 4; ++e) { float x = p[3][e];
                x *= dpp_shr(x, 1.f, 1); x *= dpp_shr(x, 1.f, 2); x *= dpp_shr(x, 1.f, 4); x *= dpp_shr(x, 1.f, 8);
                ex[e] = dpp_shr(x, 1.f, 1);
                if (sg == 15) ((LAS float*)(L + MP::O_EGL))[4 * c4 + e] = x; }
            float kg[4][4];
#pragma unroll
            for (int r = 0; r < 4; ++r) { const int row = 4 * sg + r; float qg[4];
#pragma unroll
                for (int e = 0; e < 4; ++e) { const float eG = ex[e] * p[r][e]; qg[e] = qv[r][e] * qscale * eG; kg[r][e] = kv[r][e] * __builtin_amdgcn_rcpf(eG); }
                u32x2 wq, wk; wq.x = pk2(qg[0], qg[1]); wq.y = pk2(qg[2], qg[3]); wk.x = pk2(kg[r][0], kg[r][1]); wk.y = pk2(kg[r][2], kg[r][3]);
                const int off = swz<PQ>(row, c4 >> 1) + (c4 & 1) * 8;
                *(LAS u32x2*)(L + MP::O_QG + off) = wq; *(LAS u32x2*)(L + MP::O_KG + off) = wk; }
#pragma unroll
            for (int e = 0; e < 4; ++e) { u32x2 wt; wt.x = pk2(kg[0][e], kg[1][e]); wt.y = pk2(kg[2][e], kg[3][e]);
                *(LAS u32x2*)(L + MP::O_KGT + swz<128>(4 * c4 + e, sg >> 1) + (sg & 1) * 8) = wt; }
        }
        SC_LBAR();
        SEG_MARK(1);
        f32x16 acc;
#pragma unroll
        for (int r = 0; r < 16; ++r) acc[r] = 0.f;
        { const int mi = (w >> 1) & 1, nj = w & 1;
          if (w < 4 && nj <= mi) {
#pragma unroll
            for (int kk = 0; kk < DK / 16; ++kk) { const s16x8 ka = *(const LAS s16x8*)(L + MP::O_KG + swz<PQ>(32 * nj + r32, 2 * kk + hi)); const s16x8 bq = *(const LAS s16x8*)(L + MP::O_QG + swz<PQ>(32 * mi + r32, 2 * kk + hi));
                acc = __builtin_amdgcn_mfma_f32_32x32x16_bf16(ka, bq, acc, 0, 0, 0); } }
          SC_LBAR();
          if (w < 4) { const int i = 32 * mi + r32;
#pragma unroll
            for (int r4 = 0; r4 < 4; ++r4) { const int j0 = 32 * nj + 8 * r4 + 4 * hi; float pp[4];
#pragma unroll
              for (int e = 0; e < 4; ++e) pp[e] = (j0 + e <= i) ? acc[4 * r4 + e] : 0.f;
              u32x2 wv; wv.x = pk2(pp[0], pp[1]); wv.y = pk2(pp[2], pp[3]);
              *(LAS u32x2*)(L + MP::O_KG + swz<128>(i, j0 >> 3) + (j0 & 7) * 2) = wv; } } }
        SC_LBAR();
        SEG_MARK(2);
        if (oact) { const int nvt = w >> 1, mi = w & 1;
#pragma unroll
          for (int r = 0; r < 16; ++r) acc[r] = 0.f;
#pragma unroll
          for (int kk = 0; kk < 4; ++kk) { const s16x8 va = *(const LAS s16x8*)(L + MP::O_VT + swz<128>(32 * nvt + r32, 2 * kk + hi)); const s16x8 bp = *(const LAS s16x8*)(L + MP::O_KG + swz<128>(32 * mi + r32, 2 * kk + hi));
              acc = __builtin_amdgcn_mfma_f32_32x32x16_bf16(bp, va, acc, 0, 0, 0); }
#pragma unroll
          for (int kk = 0; kk < DK / 16; ++kk) { const s16x8 sa = *(const LAS s16x8*)(L + MP::O_ST + swz<PQ>(32 * nvt + r32, 2 * kk + hi)); const s16x8 bq = *(const LAS s16x8*)(L + MP::O_QG + swz<PQ>(32 * mi + r32, 2 * kk + hi));
              acc = __builtin_amdgcn_mfma_f32_32x32x16_bf16(bq, sa, acc, 0, 0, 0); }
#pragma unroll
          for (int i = 0; i < 8; ++i) ost[i] = pk2(acc[2 * i], acc[2 * i + 1]);
          }
#pragma unroll
        for (int ti = 0; ti < NST; ++ti) {
#pragma unroll
            for (int kk = 0; kk < 4; ++kk) { const s16x8 ka = *(const LAS s16x8*)(L + MP::O_KGT + swz<128>(32 * mk + r32, 2 * kk + hi)); const s16x8 bv = *(const LAS s16x8*)(L + MP::O_VT + swz<128>(32 * (nv0 + ti) + r32, 2 * kk + hi));
                S[ti] = __builtin_amdgcn_mfma_f32_32x32x16_bf16(ka, bv, S[ti], 0, 0, 0); }
#pragma unroll
            for (int r = 0; r < 16; ++r) S[ti][r] *= ((const LAS float*)(L + MP::O_EGL))[32 * mk + crow(r, hi)]; }
        SC_LBAR();
        SEG_MARK(3);
    };
    for (int s2 = 0; s2 < 68; ++s2) body(s2, pqA, pkA, pvA, pzA);
    if (oact) SC_STORE(pbase);
    asm volatile("s_waitcnt vmcnt(0)" ::: "memory");
#undef SC_STORE
#undef SC_BASE
#undef SC_GROW
#undef SC_ISSUE
}
}

#define XB_TMO      128
#define XB_XCNT(j)  (256  + 64 * (j))
#define XB_XSUB(j)  (1280 + 64 * (j))
#define XB_XGEN(j)  (2304 + 64 * (j))
#define XB_TOP      3328
#define XB_TOPGEN   3392
#define XCD_BAR_WORDS 3456
#define XB_SPIN_CAP (1u << 18)

__device__ __forceinline__ unsigned xb_ld(unsigned* p)              { return __hip_atomic_load(p, __ATOMIC_RELAXED, __HIP_MEMORY_SCOPE_AGENT); }
__device__ __forceinline__ unsigned xb_add(unsigned* p, unsigned v) { return __hip_atomic_fetch_add(p, v, __ATOMIC_RELAXED, __HIP_MEMORY_SCOPE_AGENT); }
__device__ __forceinline__ unsigned xb_xcc_id() { return (unsigned)__builtin_amdgcn_s_getreg((3 << 11) | 20) & 0xFu; }
#define XB_SPIN(cond, bar) do { unsigned _sp = 0; while (cond) { __builtin_amdgcn_s_sleep(1); \
    if ((++_sp & 255u) == 0u) { if (xb_ld(&(bar)[XB_TMO])) break; if (_sp > XB_SPIN_CAP) { atomicAdd(&(bar)[XB_TMO], 1u); break; } } } } while (0)

struct XcdBarrier {
    unsigned* bar; unsigned x;
    volatile LAS unsigned* st;
};

__device__ __forceinline__ XcdBarrier xcd_barrier_post(unsigned* bar, volatile LAS unsigned* st) {
    XcdBarrier b; b.bar = bar; b.x = xb_xcc_id(); b.st = st;
    if (threadIdx.x == 0) (void)xb_add(&bar[XB_XCNT(b.x)], 1u);
    return b;
}
__device__ __forceinline__ void xcd_barrier_complete(unsigned* bar, unsigned x, unsigned& nloc, unsigned& nx) {
    const unsigned G = gridDim.x * gridDim.y * gridDim.z;
    unsigned sum, cnt, mine, sp = 0u;
    for (;;) {
        sum = 0u; cnt = 0u; mine = 0u;
#pragma unroll
        for (unsigned j = 0; j < 16; ++j) { const unsigned c = xb_ld(&bar[XB_XCNT(j)]); sum += c; cnt += (c > 0u) ? 1u : 0u; mine = (j == x) ? c : mine; }
        if (sum == G) break;
        __builtin_amdgcn_s_sleep(1);
        if ((++sp & 255u) == 0u) { if (xb_ld(&bar[XB_TMO])) break; if (sp > XB_SPIN_CAP) { atomicAdd(&bar[XB_TMO], 1u); break; } }
    }
    nloc = mine > 0u ? mine : 1u; nx = cnt > 0u ? cnt : 1u;
}

__device__ __forceinline__ void xcd_barrier(const XcdBarrier& b) {
    asm volatile("s_waitcnt vmcnt(0)" ::: "memory");
    __syncthreads();
    if (threadIdx.x == 0) {
        unsigned* bar = b.bar;
        __builtin_amdgcn_s_waitcnt(0);
        unsigned nloc = b.st[0], nx = b.st[1];
        if (nloc == 0u) { xcd_barrier_complete(bar, b.x, nloc, nx); b.st[0] = nloc; b.st[1] = nx; }
        const unsigned old = xb_add(&bar[XB_XSUB(b.x)], 1u);
        const unsigned gen = old / nloc;
        if (old + 1u == (gen + 1u) * nloc) {
            __builtin_amdgcn_fence(__ATOMIC_RELEASE, "agent");
            asm volatile("s_waitcnt vmcnt(0)" ::: "memory");
            const unsigned og = xb_add(&bar[XB_TOP], 1u);
            const unsigned tg = og / nx;
            if (og + 1u == (tg + 1u) * nx) xb_add(&bar[XB_TOPGEN], 1u);
            else XB_SPIN(xb_ld(&bar[XB_TOPGEN]) == tg, bar);
            __builtin_amdgcn_fence(__ATOMIC_ACQUIRE, "agent");
            xb_add(&bar[XB_XGEN(b.x)], 1u);
            asm volatile("s_waitcnt vmcnt(0)" ::: "memory");
        } else {
            XB_SPIN(xb_ld(&bar[XB_XGEN(b.x)]) == gen, bar);
            __builtin_amdgcn_fence(__ATOMIC_ACQUIRE, "agent");
            asm volatile("s_waitcnt vmcnt(0)" ::: "memory");
        }
    }
    __syncthreads();
}

#ifdef PROBE_MASK
#define STAMP() do { if (blockIdx.x == PROBE_BLK && threadIdx.x == 0) { pst[pn] = __builtin_amdgcn_s_memrealtime(); } ++pn; } while (0)
#else
#define STAMP() do {} while (0)
#endif
#define GRID_SYNC() do { xcd_barrier(xbar); STAMP(); } while (0)
#define GRID_SYNC_CG() do { if (a.ws == nullptr) grid.sync(); xcd_barrier(xbar); STAMP(); } while (0)
__global__ void __launch_bounds__(NTHR, 2) fwd_megakernel(Args a) {
    extern __shared__ __attribute__((aligned(16))) unsigned char lds_raw[];
    cg::grid_group grid = cg::this_grid();
    LAS unsigned char* lds = (LAS unsigned char*)lds_raw;
    const int G = gridDim.x, tid = threadIdx.x;
    unsigned char* ws = a.ws;
    float* MOD = (float*)(ws + WS_MOD); const float* LB = (const float*)(ws + WS_LB);
    bfs* XB1 = (bfs*)a.out;
    bfs* X2 = (bfs*)(ws + WS_D + 264 * MiB);
    bfs* CB = (bfs*)(ws + WS_C); bfs* DB = (bfs*)(ws + WS_D); bfs* YB = (bfs*)(ws + WS_Y); bfs* EB = (bfs*)(ws + WS_E0);
    unsigned* ctl = (unsigned*)(ws + WS_CTL);
    { volatile LAS unsigned* st0 = (volatile LAS unsigned*)(lds + LDS_CTL_OFF + 16); if (tid == 0) { st0[0] = 0u; st0[1] = 0u; } __syncthreads(); }
    XcdBarrier xbar = xcd_barrier_post(ctl + 1024, (volatile LAS unsigned*)(lds + LDS_CTL_OFF + 16));
#ifdef PROBE_MASK
    volatile LAS unsigned long long* pst = (volatile LAS unsigned long long*)(lds + LDS_CTL_OFF + 64); int pn = 1;
    if (threadIdx.x == 0) { pst[0] = __builtin_amdgcn_s_memrealtime(); pst[40] = 0; }
#endif

    p0_phase(a, lds, G);
    GRID_SYNC_CG();
    { RowOp op{a.in[0], a.in[2], nullptr, nullptr, nullptr, nullptr, nullptr, 0, CB, a.in[6], MOD, 0, 1, 0, 0, 0}; row_phase(op, G); }
    GRID_SYNC();
    for (int l = 0; l < 2; ++l) {
        const float* MODL = MOD + (size_t)l * 9 * 6144;
        const bfs* Win = (const bfs*)(ws + (l ? WS_WIN1 : WS_WIN0)); const bfs* Wout = (const bfs*)(ws + (l ? WS_WOUT1 : WS_WOUT0));
        const bfs* Wgu = (const bfs*)(ws + (l ? WS_WGU1 : WS_WGU0)); const bfs* Wd = (const bfs*)(ws + (l ? WS_WD1 : WS_WD0));
        const int pitch = l ? NIN1 : PIN0;
        { pg8::Gemm g{CB, Win, ROWS, pitch, DM}; pg8::StaticOrder S; S.init(ROWS, pitch, G, (int)blockIdx.x);
          pg8::EpiStore E{DB, pitch, l, LB};
#ifndef NO_GEMM
          pg8::gemm_phase<pg8::EpiStore, pg8::StaticOrder, true, true>(lds, g, S, E);
#endif
 }
        GRID_SYNC();
        if (l == 0) {
            qk_phase(DB, a.in[14], a.in[15], G);
            GRID_SYNC();
            volatile LAS unsigned* lctl = (volatile LAS unsigned*)(lds + LDS_CTL_OFF);
            constexpr int N_GLA = 64, N_ATL = 1024, N_ATC = 64, N_ITEMS = N_GLA + N_ATL + N_ATC;
            for (;;) {
                if (tid == 0) lctl[0] = __hip_atomic_fetch_add(ctl + 64, 1u, __ATOMIC_RELAXED, __HIP_MEMORY_SCOPE_AGENT);
                __syncthreads();
                const int it = (int)lctl[0];
                __syncthreads();
                if (it >= N_ITEMS) break;
                if (it < N_GLA) {
                    const int b = it >> 3, h = (it >> 1) & 3, dir = it & 1;
#ifndef NO_GLA
                    scan::scan_unit<64, false, PIN0, 128>(lds, DB, C_GQ + 64 * h, C_GK + 64 * h, C_GV + 128 * h, C_GZ + 16 * dir, a.in[11] + dir * 16 * 256 + 64 * h, a.in[12] + dir * 256 + 64 * h,
                                               dir ? EB : CB, dir ? EB : CB, 0, dir ? 512 : DM, 128 * h, b, dir, 0.125f);
#endif
                } else if (it < N_GLA + N_ATL) {
                    const int u = it - N_GLA, gq = u & 3, qb = (u >> 2) & 15, kvh = (u >> 6) & 1, b = u >> 7, h = kvh * 4 + gq;
                    const size_t qrow = (size_t)RCTX + (size_t)b * SEQ + (size_t)qb * 256;
#ifndef NO_ATTN
                    attn_body::attn_unit<8>(b, 68, (const attn_body::bf16*)(DB + qrow * PIN0 + C_AQ + 64 * h), PIN0, (const attn_body::bf16*)(DB + C_AK + 64 * kvh), (const attn_body::bf16*)(DB + C_AV + 64 * kvh), PIN0,
                                            (attn_body::bf16*)(CB + qrow * DM + 512 + 64 * h), DM, (char*)lds_raw);
#endif
                } else {
                    const int u = it - N_GLA - N_ATL, h = u & 7, b = u >> 3, kvh = h >> 2;
                    const size_t qrow = (size_t)b * NCTX;
#ifndef NO_ATTN2
                    attn_body::attn_unit<8>(b, 4, (const attn_body::bf16*)(DB + qrow * PIN0 + C_AQ + 64 * h), PIN0, (const attn_body::bf16*)(DB + C_AK + 64 * kvh), (const attn_body::bf16*)(DB + C_AV + 64 * kvh), PIN0,
                                            (attn_body::bf16*)(CB + qrow * DM + 512 + 64 * h), DM, (char*)lds_raw);
#endif
                }
            }
            if (G >= 256) p0_weights(a, lds, P0_NA, P0_NITEMS, (int)blockIdx.x * NWAVES + (tid >> 6), G * NWAVES);
            GRID_SYNC();
            readout_phase<512>(CB, DM, EB, 512, EB, 0, CB, DB, PIN0, C_GOG, a.in[13], 0, G);
        } else {
            bfs* OA = (bfs*)(ws + 2 * MiB); bfs* OT2 = (bfs*)(ws + WS_D + 340 * MiB) - (size_t)OSPLIT * DM;
            for (int u = blockIdx.x; u < 256; u += G) {
                const int b = u >> 5, hh = (u >> 2) & 7, dir = (u >> 1) & 1, vh = u & 1;
#ifndef NO_HG
                scan::scan_unit<128, true, NIN1, 64>(lds, DB, C_FQ + 128 * hh, C_FF + 1024 * dir + 128 * hh, C_FI + 128 * hh + 64 * vh, 0, nullptr, nullptr,
                                                     dir ? OA : CB, dir ? OT2 : CB, dir ? OSPLIT : 0, DM, 128 * hh + 64 * vh, b, dir, 1.0f);
#endif
            }
            GRID_SYNC();
            readout_phase<1024>(CB, DM, OA, DM, OT2, OSPLIT, CB, DB, NIN1, C_FOG, a.in[19], RCTX, G);
        }
        GRID_SYNC();
        const int row_lo = l ? RCTX : 0; const int Mg = ROWS - row_lo;
#define PANEL_VARS const int nMg = Mg / 256, ncomp = nMg < G / 2 ? nMg : G / 2, nthird = (nMg - ncomp) * 4; \
        const bool third = (G == 256) ? (((int)blockIdx.x & 7) == 0 && 128 + ((int)blockIdx.x >> 5) < nMg) : ((int)blockIdx.x < nthird); \
        const int rrank = !nthird ? (int)blockIdx.x : (G == 256 ? ((int)blockIdx.x - ((int)blockIdx.x >> 3) - 1) : (int)blockIdx.x - nthird)
#define ROWOP_MIX RowOp op{l ? (const void*)(XB1 + (size_t)RCTX * DM) : (const void*)a.in[0], l ? (const void*)XB1 : (const void*)a.in[2], l ? (void*)X2 : (void*)(XB1 + (size_t)RCTX * DM), l ? (void*)nullptr : (void*)XB1, \
                   YB, a.in[7] + l * DM, MODL, 2, CB, a.in[8] + l * DM, MODL, 3, 4, row_lo, l, 1}
        for (int part = 0; part < 2; ++part) {
            { PANEL_VARS; (void)third; (void)rrank; (void)nthird; (void)ncomp;
              pg8::Gemm g{CB + (size_t)row_lo * DM, Wout, Mg, DM, DM}; pg8::EpiStore E{YB + (size_t)row_lo * DM, DM, 0, nullptr};
              pg8::PanelOrder S{nMg, G, (int)blockIdx.x, part ? 2 : 0, part ? 3 : 2};
#ifndef NO_GEMM
              pg8::gemm_phase<pg8::EpiStore, pg8::PanelOrder, true, true>(lds, g, S, E);
#endif
            }
            if (part == 1) { PANEL_VARS; if (!third) { ROWOP_MIX; row_phase(op, G, row_lo, row_lo + ncomp * 256, rrank, G - nthird); } }
            GRID_SYNC();
        }
        { PANEL_VARS; (void)third; (void)rrank; (void)nthird; if (ncomp < nMg) { ROWOP_MIX; row_phase(op, G, row_lo + ncomp * 256, ROWS); GRID_SYNC(); } }
        { pg8::Gemm g{CB + (size_t)row_lo * DM, Wgu, Mg, NGU, DM}; pg8::StaticOrder S; S.init(Mg, NGU, G, (int)blockIdx.x);
          pg8::EpiSwiGLU E{DB + (size_t)row_lo * DFF, DFF};
#ifndef NO_GEMM
          pg8::gemm_phase<pg8::EpiSwiGLU, pg8::StaticOrder, true, true>(lds, g, S, E);
#endif
 }
        GRID_SYNC();
#define ROWOP_FFN RowOp op{l ? (const void*)X2 : (const void*)(XB1 + (size_t)RCTX * DM), l ? (const void*)nullptr : (const void*)XB1, l ? (void*)a.out : (void*)(XB1 + (size_t)RCTX * DM), l ? (void*)nullptr : (void*)XB1, \
                   YB, a.in[9] + l * DM, MODL, 5, l ? (bfs*)nullptr : CB, l ? (const float*)nullptr : a.in[6] + DM, l ? (const float*)nullptr : MOD + (size_t)9 * 6144, 0, l ? 0 : 1, l ? RCTX : 0, 1, l ? 0 : 1}
        for (int part = 0; part < 2; ++part) {
            { PANEL_VARS; (void)third; (void)rrank; (void)nthird; (void)ncomp;
              pg8::Gemm g{DB + (size_t)row_lo * DFF, Wd, Mg, DM, DFF}; pg8::EpiStore E{YB + (size_t)row_lo * DM, DM, 0, nullptr};
              pg8::PanelOrder S{nMg, G, (int)blockIdx.x, part ? 2 : 0, part ? 3 : 2};
#ifndef NO_GEMM
              pg8::gemm_phase<pg8::EpiStore, pg8::PanelOrder, true, true>(lds, g, S, E);
#endif
            }
            if (part == 1) { PANEL_VARS; if (!third) { ROWOP_FFN; row_phase(op, G, row_lo, row_lo + ncomp * 256, rrank, G - nthird); } }
            if (part == 0 || l == 0) GRID_SYNC();
        }
        { PANEL_VARS; (void)third; (void)rrank; (void)nthird; if (ncomp < nMg) { ROWOP_FFN; row_phase(op, G, row_lo + ncomp * 256, ROWS); GRID_SYNC(); } }
    }
#ifdef PROBE_SYNCS
    for (int i = 0; i < PROBE_SYNCS; ++i) xcd_barrier(xbar);
#endif
#ifdef PROBE_MASK
    STAMP();
    if (blockIdx.x == PROBE_BLK && threadIdx.x == 0) {
        unsigned long long extra = 0;
        for (int i = 1; i < pn; ++i) if ((PROBE_MASK >> (i - 1)) & 1u) extra += pst[i] - pst[i - 1];
        extra += pst[40];
        const unsigned long long t0 = __builtin_amdgcn_s_memrealtime();
        while (__builtin_amdgcn_s_memrealtime() - t0 < extra) __builtin_amdgcn_s_sleep(8);
    }
#endif
}

extern "C" void kernel_launch(void* const* d_in, const int* in_sizes, int n_in, void* d_out, int out_size, void* d_ws, size_t ws_size, hipStream_t stream) {
    static int grid = 0;
    if (grid == 0) {
        if (n_in != 24 || ws_size < WS_END) { fprintf(stderr, "kernel_launch: unexpected inputs (n_in %d, ws %zu < %zu)\n", n_in, ws_size, (size_t)WS_END); grid = -1; return; }
        int dev = 0, cus = 0, per_cu = 0;
        hipGetDevice(&dev);
        hipDeviceGetAttribute(&cus, hipDeviceAttributeMultiprocessorCount, dev);
        if (hipFuncSetAttribute((const void*)fwd_megakernel, hipFuncAttributeMaxDynamicSharedMemorySize, LDS_BYTES) != hipSuccess) { fprintf(stderr, "kernel_launch: hipFuncSetAttribute failed\n"); grid = -1; return; }
        if (hipOccupancyMaxActiveBlocksPerMultiprocessor(&per_cu, (const void*)fwd_megakernel, NTHR, LDS_BYTES) != hipSuccess || per_cu < 1) { fprintf(stderr, "kernel_launch: occupancy query gave %d\n", per_cu); per_cu = 1; }
        (void)hipGetLastError();
        grid = cus * 1;
        fprintf(stderr, "kernel_launch: grid %d (cus %d, per_cu %d)\n", grid, cus, per_cu);
    }
    if (grid < 0) return;
    hipMemsetAsync((char*)d_ws + WS_CTL, 0, CTL_BYTES, stream);
    Args a{};
    for (int i = 0; i < 24; ++i) a.in[i] = (const float*)d_in[i];
    a.out = (float*)d_out; a.ws = (unsigned char*)d_ws;
    void* args[] = {&a};
    hipError_t e = hipLaunchCooperativeKernel((const void*)fwd_megakernel, dim3(grid), dim3(NTHR), args, LDS_BYTES, stream);
    if (e != hipSuccess) fprintf(stderr, "cooperative launch failed: %s (grid %d)\n", hipGetErrorString(e), grid);
}
```

```cpp
#include <hip/hip_runtime.h>
#include <hip/hip_cooperative_groups.h>
#include <hip/hip_bf16.h>
#include <cstdio>
#include <cstdint>
#include <cmath>
namespace cg = cooperative_groups;
__device__ __forceinline__ int tid_fresh() { int t = threadIdx.x; asm volatile("" : "+v"(t)); return t; }
namespace pg8 {
#define PG8_LAS __attribute__((address_space(3)))
typedef unsigned short bf16_t;
typedef short bf16x8 __attribute__((ext_vector_type(8)));
typedef float f32x4 __attribute__((ext_vector_type(4)));
typedef unsigned u32x4 __attribute__((ext_vector_type(4)));
constexpr int BM = 256, BK = 64, HALF = 128, HTB = HALF * BK * 2  , STAGE_BYTES = 8 * HTB, NXCD = 8, WGM = 8;

__host__ __device__ __forceinline__ int lds_byte(int r, int c) { const int st = (r >> 4) * 2 + (c >> 5), rr = r & 15, cc = c & 31, ob = rr * 64 + cc * 2; return st * 1024 + (ob ^ (((ob >> 9) & 1) << 5)); }
__host__ __device__ __forceinline__ void stage_rc(int b, int& R, int& C) { const int st = b / 1024, sb = b % 1024, swz = sb ^ (((sb >> 9) & 1) << 5); R = (st >> 1) * 16 + swz / 64; C = (st & 1) * 32 + (swz % 64) / 2; }
__host__ __device__ __forceinline__ int perm32(int rho) { const int n = rho >> 4, i = rho & 15; return 8 * (i >> 2) + 4 * n + (i & 3); }

struct Unit { int pm, pn; };
struct Gemm { const bf16_t* A; const bf16_t* Bt; int M, N, K; };

struct StaticOrder {
    int nM, nN, nwg, G, c;
    __host__ __device__ void init(int M, int N, int G_, int c_) { nM = M / BM; nN = N / BM; nwg = nM * nN; G = G_; c = c_; }
    __host__ __device__ bool next(int i, Unit& u) const {
        const long L = (long)i * G + c; if (L >= nwg) return false;
        int wgid = (int)L; { const int q = nwg / NXCD, r = nwg % NXCD, xcd = wgid % NXCD, off = wgid / NXCD; wgid = (xcd < r ? xcd * (q + 1) : r * (q + 1) + (xcd - r) * q) + off; }
        const int nig = WGM * nN, gid = wgid / nig, fm = gid * WGM, gsz = (nM - fm) < WGM ? (nM - fm) : WGM;
        u.pm = fm + ((wgid % nig) % gsz); u.pn = (wgid % nig) / gsz; return true;
    }
    __device__ __forceinline__ void a_ready(const Unit&) const {}
    __device__ __forceinline__ void done(const Unit&) const {}
};

typedef float f32x2_cv __attribute__((ext_vector_type(2))); typedef __bf16 bf16x2_cv __attribute__((ext_vector_type(2)));
__device__ __forceinline__ unsigned cvt_pk_bf16(float lo, float hi) { f32x2_cv v = {lo, hi}; bf16x2_cv b = __builtin_convertvector(v, bf16x2_cv); return __builtin_bit_cast(unsigned, b); }
typedef float f32x2 __attribute__((ext_vector_type(2)));
struct PanelOrder {
    int nM, G, c, i0, i1;
    __host__ __device__ bool next(int i, Unit& u) const {
        const int r = i + i0; if (r >= i1) return false;
        if (G == 256) { const int x = c & 7, j = c >> 3; u.pm = r * 64 + x * 8 + (j >> 2); u.pn = j & 3; }
        else { const int L = r * G + c; u.pm = L >> 2; u.pn = L & 3; }
        return u.pm < nM;
    }
    __device__ __forceinline__ void a_ready(const Unit&) const {}
    __device__ __forceinline__ void done(const Unit&) const {}
};
typedef float f32x2 __attribute__((ext_vector_type(2)));
struct EpiStore {
    static constexpr bool PERM = true, AFTER_DRAIN = false;
    bf16_t* O; int ldc; int mode; const float* lb;
    __device__ __forceinline__ void operator()(const f32x4 (&acc)[2][2][4][2], const Unit& u, int wr, int wc, int fr, int fq) const {
        const int row0 = u.pm * BM + wr * 64 + fr; const int col0 = u.pn * BM + wc * 32 + 8 * fq;
#pragma unroll
        for (int bj = 0; bj < 2; ++bj) {
            const int col = col0 + bj * HALF;
            int cls = 0; f32x4 l0 = (f32x4){0.f,0.f,0.f,0.f}, l1 = l0;
            if (mode == 1) { if (col < 1024) cls = 1; else if (col < 3072) { cls = 2; l0 = *(const f32x4*)(lb + col - 1024); l1 = *(const f32x4*)(lb + col - 1024 + 4); } }
#pragma unroll
            for (int ai = 0; ai < 2; ++ai)
#pragma unroll
                for (int m = 0; m < 4; ++m) {
                    f32x4 v0 = acc[ai][bj][m][0], v1 = acc[ai][bj][m][1];
                    if (cls == 1) {
#pragma unroll
                        for (int e = 0; e < 4; ++e) { v0[e] = v0[e] * __builtin_amdgcn_rcpf(1.f + __expf(-v0[e])); v1[e] = v1[e] * __builtin_amdgcn_rcpf(1.f + __expf(-v1[e])); }
                    } else if (cls == 2) {
#pragma unroll
                        for (int e = 0; e < 4; ++e) { const float s0 = __builtin_amdgcn_rcpf(1.f + __expf(v0[e])), s1 = __builtin_amdgcn_rcpf(1.f + __expf(v1[e]));
                            v0[e] = (1.f - l0[e]) * s0; v1[e] = (1.f - l1[e]) * s1; }
                    }
                    u32x4 w; w.x = cvt_pk_bf16(v0[0], v0[1]); w.y = cvt_pk_bf16(v0[2], v0[3]); w.z = cvt_pk_bf16(v1[0], v1[1]); w.w = cvt_pk_bf16(v1[2], v1[3]);
                    *(u32x4*)(O + (size_t)(row0 + ai * HALF + m * 16) * ldc + col) = w;
                }
        }
    }
};
struct EpiSwiGLU {
    static constexpr bool PERM = true, AFTER_DRAIN = false;
    bf16_t* O; int ldc;
    __device__ __forceinline__ void operator()(const f32x4 (&acc)[2][2][4][2], const Unit& u, int wr, int wc, int fr, int fq) const {
        const int row0 = u.pm * BM + wr * 64 + fr; const int col = u.pn * HALF + wc * 32 + 8 * fq;
#pragma unroll
        for (int ai = 0; ai < 2; ++ai)
#pragma unroll
            for (int m = 0; m < 4; ++m) {
                f32x4 g0 = acc[ai][0][m][0], g1 = acc[ai][0][m][1]; const f32x4 u0 = acc[ai][1][m][0], u1 = acc[ai][1][m][1];
#pragma unroll
                for (int e = 0; e < 4; ++e) { g0[e] = g0[e] * __builtin_amdgcn_rcpf(1.f + __expf(-g0[e])) * u0[e]; g1[e] = g1[e] * __builtin_amdgcn_rcpf(1.f + __expf(-g1[e])) * u1[e]; }
                u32x4 w; w.x = cvt_pk_bf16(g0[0], g0[1]); w.y = cvt_pk_bf16(g0[2], g0[3]); w.z = cvt_pk_bf16(g1[0], g1[1]); w.w = cvt_pk_bf16(g1[2], g1[3]);
                *(u32x4*)(O + (size_t)(row0 + ai * HALF + m * 16) * ldc + col) = w;
            }
    }
};
template <class Epi, class Sched, bool ALIGN_EPI = false, bool SP2 = false>
__device__ __forceinline__ void gemm_phase(PG8_LAS unsigned char* lds, const Gemm g, const Sched& S, const Epi& E) {
    const int tid = tid_fresh(), wid = __builtin_amdgcn_readfirstlane(tid >> 6), lane = tid & 63, wr = wid >> 2, wc = wid & 3, fr = lane & 15, fq = lane >> 4;
    const int K = g.K, nt = K / BK;
    unsigned voffA[2], voffB[2];
#pragma unroll
    for (int i = 0; i < 2; ++i) { int R, C; stage_rc(tid * 16 + i * 8192, R, C); const int Rb = Epi::PERM ? ((R & ~31) + perm32(R & 31)) : R;
        voffA[i] = (unsigned)(R * K + C) * 2u; voffB[i] = (unsigned)(Rb * K + C) * 2u; }
    const size_t kstep = (size_t)(BK * 2);
    const size_t hstep = (size_t)HALF * K * 2;
    const size_t tstep = 2 * hstep;
    const unsigned ldsw = (unsigned)wid * 1024u;
    const int aoff = lds_byte(wr * 64 + fr, fq * 8), boff = lds_byte(wc * 32 + fr, fq * 8);
#define PG8_SA(b, h) (((b) * 2 + (h)) * HTB)
#define PG8_SB(b, h) ((4 + (b) * 2 + (h)) * HTB)
#define PG8_STAGE(bufoff, gbase, voff) do { _Pragma("unroll") for (int _i = 0; _i < 2; ++_i) \
        __builtin_amdgcn_global_load_lds((const unsigned*)((const char*)(gbase) + (voff)[_i]), (PG8_LAS unsigned*)(lds + (bufoff) + ldsw + _i * 8192), 16, 0, 0); } while (0)
#define PG8_LDA(dst, b, h) do { _Pragma("unroll") for (int m = 0; m < 4; ++m) _Pragma("unroll") for (int k = 0; k < 2; ++k) dst[m][k] = *(const PG8_LAS bf16x8*)(lds + PG8_SA(b, h) + aoff + m * 2048 + k * 1024); } while (0)
#define PG8_LDB(dst, b, h) do { _Pragma("unroll") for (int n = 0; n < 2; ++n) _Pragma("unroll") for (int k = 0; k < 2; ++k) dst[n][k] = *(const PG8_LAS bf16x8*)(lds + PG8_SB(b, h) + boff + n * 2048 + k * 1024); } while (0)
#define PG8_MMA(ai, bj, At, Bt) do { __builtin_amdgcn_s_setprio(1); _Pragma("unroll") for (int m = 0; m < 4; ++m) _Pragma("unroll") for (int n = 0; n < 2; ++n) _Pragma("unroll") for (int k = 0; k < 2; ++k) \
        acc[ai][bj][m][n] = __builtin_amdgcn_mfma_f32_16x16x32_bf16(Bt[n][k], At[m][k], acc[ai][bj][m][n], 0, 0, 0); __builtin_amdgcn_s_setprio(0); } while (0)
#define PG8_WAIT_V(n) asm volatile("s_waitcnt vmcnt(" #n ")" ::: "memory")
#define PG8_WAIT_L(n) asm volatile("s_waitcnt lgkmcnt(" #n ")" ::: "memory")
#define PG8_BAR __builtin_amdgcn_s_barrier()
#define PG8_SCHED __builtin_amdgcn_sched_barrier(0)
    Unit cur, nxt; int ui = 0;
    if (!S.next(0, cur)) return;
    f32x4 acc[2][2][4][2];
#pragma unroll
    for (int a = 0; a < 2; ++a)
#pragma unroll
        for (int b = 0; b < 2; ++b)
#pragma unroll
            for (int m = 0; m < 4; ++m)
#pragma unroll
                for (int n = 0; n < 2; ++n) acc[a][b][m][n] = (f32x4){0.f, 0.f, 0.f, 0.f};
    bf16x8 At[4][2], B0[2][2], B1[2][2];
    const char* cA = (const char*)g.A + (size_t)cur.pm * tstep; const char* cB = (const char*)g.Bt + (size_t)cur.pn * tstep;
    S.a_ready(cur);
    if constexpr (SP2) {
        PG8_STAGE(PG8_SB(0, 0), cB, voffB); PG8_STAGE(PG8_SB(0, 1), cB + hstep, voffB); PG8_STAGE(PG8_SA(0, 0), cA, voffA); PG8_STAGE(PG8_SA(0, 1), cA + hstep, voffA);
        if (wr == 1) PG8_BAR;
        PG8_WAIT_V(2); PG8_BAR;
        PG8_STAGE(PG8_SB(1, 0), cB + kstep, voffB); PG8_STAGE(PG8_SA(1, 0), cA + kstep, voffA); PG8_STAGE(PG8_SB(1, 1), cB + hstep + kstep, voffB);
        PG8_WAIT_V(6); PG8_BAR;
    } else {
        PG8_STAGE(PG8_SB(0, 0), cB, voffB); PG8_STAGE(PG8_SA(0, 0), cA, voffA); PG8_STAGE(PG8_SB(0, 1), cB + hstep, voffB); PG8_STAGE(PG8_SA(0, 1), cA + hstep, voffA);
        if (wr == 1) PG8_BAR;
        PG8_WAIT_V(4); PG8_BAR;
        PG8_STAGE(PG8_SB(1, 0), cB + kstep, voffB); PG8_STAGE(PG8_SA(1, 0), cA + kstep, voffA); PG8_STAGE(PG8_SB(1, 1), cB + hstep + kstep, voffB);
        PG8_WAIT_V(6); PG8_BAR;
    }
    for (;;) {
        const bool has_next = S.next(ui + 1, nxt);
        const char* nA = has_next ? (const char*)g.A + (size_t)nxt.pm * tstep : cA; const char* nB = has_next ? (const char*)g.Bt + (size_t)nxt.pn * tstep : cB;
        for (int t = 0; t < nt; t += 2) {
            const bool last = (t == nt - 2);
            const char* a1 = cA + (size_t)(t + 1) * kstep;
            const char* a2 = last ? nA : cA + (size_t)(t + 2) * kstep; const char* b2 = last ? nB : cB + (size_t)(t + 2) * kstep;
            const char* a3 = a2 + kstep; const char* b3 = b2 + kstep;
            if (last && has_next) S.a_ready(nxt);
            if constexpr (SP2) {
            PG8_LDB(B0, 0, 0); PG8_LDB(B1, 0, 1); PG8_SCHED; PG8_LDA(At, 0, 0); PG8_STAGE(PG8_SA(1, 1), a1 + hstep, voffA);
            PG8_WAIT_V(8); PG8_WAIT_L(0); PG8_BAR; PG8_MMA(0, 0, At, B0); PG8_MMA(0, 1, At, B1); PG8_BAR; PG8_SCHED;
            PG8_LDA(At, 0, 1); PG8_STAGE(PG8_SB(0, 0), b2, voffB); PG8_STAGE(PG8_SB(0, 1), b2 + hstep, voffB); PG8_STAGE(PG8_SA(0, 0), a2, voffA);
            PG8_WAIT_V(8); PG8_WAIT_L(0); PG8_BAR; PG8_MMA(1, 0, At, B0); PG8_MMA(1, 1, At, B1); PG8_BAR; PG8_SCHED;
            PG8_LDB(B0, 1, 0); PG8_LDB(B1, 1, 1); PG8_SCHED; PG8_LDA(At, 1, 0); PG8_STAGE(PG8_SA(0, 1), a2 + hstep, voffA);
            PG8_WAIT_V(8); PG8_WAIT_L(0); PG8_BAR; PG8_MMA(0, 0, At, B0); PG8_MMA(0, 1, At, B1); PG8_BAR; PG8_SCHED;
            PG8_LDA(At, 1, 1); PG8_STAGE(PG8_SB(1, 0), b3, voffB); PG8_STAGE(PG8_SB(1, 1), b3 + hstep, voffB); PG8_STAGE(PG8_SA(1, 0), a3, voffA);
            PG8_WAIT_V(8); PG8_WAIT_L(0); PG8_BAR; PG8_MMA(1, 0, At, B0); PG8_MMA(1, 1, At, B1); PG8_BAR; PG8_SCHED;
            } else {
            PG8_LDB(B0, 0, 0); PG8_SCHED; PG8_LDA(At, 0, 0); PG8_STAGE(PG8_SA(1, 1), a1 + hstep, voffA);
            PG8_WAIT_L(8); PG8_BAR; PG8_WAIT_L(0); PG8_MMA(0, 0, At, B0); PG8_BAR; PG8_SCHED;
            PG8_LDB(B1, 0, 1); PG8_STAGE(PG8_SB(0, 0), b2, voffB);
            PG8_BAR; PG8_WAIT_L(0); PG8_MMA(0, 1, At, B1); PG8_BAR;
            PG8_LDA(At, 0, 1); PG8_STAGE(PG8_SA(0, 0), a2, voffA);
            PG8_BAR; PG8_WAIT_L(0); PG8_MMA(1, 0, At, B0); PG8_BAR; PG8_SCHED;
            PG8_STAGE(PG8_SB(0, 1), b2 + hstep, voffB);
            PG8_WAIT_V(6); PG8_BAR; PG8_MMA(1, 1, At, B1); PG8_BAR;
            PG8_LDB(B0, 1, 0); PG8_SCHED; PG8_LDA(At, 1, 0); PG8_STAGE(PG8_SA(0, 1), a2 + hstep, voffA);
            PG8_WAIT_L(8); PG8_BAR; PG8_WAIT_L(0); PG8_MMA(0, 0, At, B0); PG8_BAR; PG8_SCHED;
            PG8_LDB(B1, 1, 1); PG8_STAGE(PG8_SB(1, 0), b3, voffB);
            PG8_BAR; PG8_WAIT_L(0); PG8_MMA(0, 1, At, B1); PG8_BAR;
            PG8_LDA(At, 1, 1); PG8_STAGE(PG8_SA(1, 0), a3, voffA);
            PG8_BAR; PG8_WAIT_L(0); PG8_MMA(1, 0, At, B0); PG8_BAR; PG8_SCHED;
            PG8_STAGE(PG8_SB(1, 1), b3 + hstep, voffB);
            PG8_WAIT_V(6); PG8_BAR; PG8_MMA(1, 1, At, B1); PG8_BAR;
            }
        }
        if constexpr (ALIGN_EPI) { if (wr == 0) PG8_BAR; }
        if constexpr (!Epi::AFTER_DRAIN) { E(acc, cur, wr, wc, fr, fq); S.done(cur); }
        if (!has_next) break;
#pragma unroll
        for (int a = 0; a < 2; ++a)
#pragma unroll
            for (int b = 0; b < 2; ++b)
#pragma unroll
                for (int m = 0; m < 4; ++m)
#pragma unroll
                    for (int n = 0; n < 2; ++n) acc[a][b][m][n] = (f32x4){0.f, 0.f, 0.f, 0.f};
        cur = nxt; cA = nA; cB = nB; ++ui;
        if constexpr (ALIGN_EPI) { if (wr == 1) PG8_BAR; }
    }
    PG8_WAIT_V(0);
    if constexpr (!ALIGN_EPI) { if (wr == 0) PG8_BAR; }
    PG8_BAR;
    if constexpr (Epi::AFTER_DRAIN) { E.fused(acc, cur, wr, wc, fr, fq, lds, wid, lane); S.done(cur); }
#undef PG8_SA
#undef PG8_SB
#undef PG8_STAGE
#undef PG8_LDA
#undef PG8_LDB
#undef PG8_MMA
#undef PG8_WAIT_V
#undef PG8_WAIT_L
#undef PG8_BAR
#undef PG8_SCHED
}
}
#include <hip/hip_bf16.h>
#include <cmath>
namespace attn_body {
using bf16=__hip_bfloat16;
using bf16x8=__attribute__((ext_vector_type(8)))short;
using s16x4=__attribute__((ext_vector_type(4)))short;
using f32x16=__attribute__((ext_vector_type(16)))float;
using u32x4=__attribute__((ext_vector_type(4)))unsigned;
constexpr int D=64;
constexpr int NW=8,QBLK=32,QB=QBLK*NW,KVBLK=64;
__device__ __forceinline__ int crow(int r,int hi){return (r&3)+8*(r>>2)+4*hi;}
#define SBAR() __builtin_amdgcn_sched_barrier(0)
__device__ __forceinline__ void cmask(f32x16&p0,f32x16&p1,int jb,int qrel,int hi){
  const float NEG=-INFINITY; int kb=64*jb+4*hi;
  #pragma unroll
  for(int r=0;r<16;++r){int kv=kb+(r&3)+8*(r>>2); if(kv>qrel)p0[r]=NEG; if(kv+32>qrel)p1[r]=NEG;}
}

constexpr int NSLOT=3, SLOTB=8192;
constexpr int LDS_K=0, LDS_V=NSLOT*SLOTB, LDS_WS=2*NSLOT*SLOTB, LDS_OST=LDS_WS+NW*64*4, LDS_BYTES=LDS_OST+NW*4096;
constexpr float C2=0.125f*1.4426950408889634f;
__device__ __forceinline__ void glds16(const void*gsrc,unsigned lds_dst){unsigned keep;
  asm volatile("s_mov_b32 %0, m0\n\ts_mov_b32 m0, %2\n\ts_nop 0\n\tglobal_load_lds_dwordx4 %1, off\n\ts_mov_b32 m0, %0":"=&s"(keep):"v"(gsrc),"s"(lds_dst):"memory");}
__device__ __forceinline__ float max3f(float a,float b,float c){float r;asm("v_max3_f32 %0, %1, %2, %3":"=v"(r):"v"(a),"v"(b),"v"(c));return r;}
__device__ __forceinline__ float max2f(float a,float b){float r;asm("v_max_f32_e32 %0, %1, %2":"=v"(r):"v"(a),"v"(b));return r;}
__device__ __forceinline__ float fadd_s(float a,float b){float r;asm("v_add_f32_e32 %0, %1, %2":"=v"(r):"v"(a),"v"(b));return r;}
__device__ __forceinline__ float fsub_s(float a,float b){float r;asm("v_sub_f32_e32 %0, %1, %2":"=v"(r):"v"(a),"v"(b));return r;}
typedef float f32x2_t __attribute__((ext_vector_type(2))); typedef __bf16 bf16x2_t __attribute__((ext_vector_type(2)));
__device__ __forceinline__ unsigned cvtpk_s(float lo,float hi){f32x2_t v={lo,hi};bf16x2_t b=__builtin_convertvector(v,bf16x2_t);return __builtin_bit_cast(unsigned,b);}
#define WAIT_BAR(N) asm volatile("s_waitcnt vmcnt(" #N ") lgkmcnt(0)\n\ts_barrier":::"memory")

__device__ __forceinline__ void qkt(f32x16&p0,f32x16&p1,const char*Kslot,const bf16x8*qr,const f32x16&negm,int r32,int hi){
  const char*kb=Kslot+hi*1024+r32*16;
  #pragma unroll
  for(int d0=0;d0<4;++d0){
    const bf16x8 b0=*reinterpret_cast<const bf16x8*>(kb+d0*2048);
    const bf16x8 b1=*reinterpret_cast<const bf16x8*>(kb+d0*2048+512);
    if(d0==0){p0=__builtin_amdgcn_mfma_f32_32x32x16_bf16(b0,qr[0],negm,0,0,0);p1=__builtin_amdgcn_mfma_f32_32x32x16_bf16(b1,qr[0],negm,0,0,0);}
    else{p0=__builtin_amdgcn_mfma_f32_32x32x16_bf16(b0,qr[d0],p0,0,0,0);p1=__builtin_amdgcn_mfma_f32_32x32x16_bf16(b1,qr[d0],p1,0,0,0);}}
}
typedef __attribute__((address_space(3))) const char* lds_cptr;
typedef short v4i16_t __attribute__((ext_vector_type(4)));
__device__ __forceinline__ void kload8(bf16x8*kf,lds_cptr kp){
  kf[0]=*(const __attribute__((address_space(3))) bf16x8*)(kp);      kf[1]=*(const __attribute__((address_space(3))) bf16x8*)(kp+512);
  kf[2]=*(const __attribute__((address_space(3))) bf16x8*)(kp+2048); kf[3]=*(const __attribute__((address_space(3))) bf16x8*)(kp+2560);
  kf[4]=*(const __attribute__((address_space(3))) bf16x8*)(kp+4096); kf[5]=*(const __attribute__((address_space(3))) bf16x8*)(kp+4608);
  kf[6]=*(const __attribute__((address_space(3))) bf16x8*)(kp+6144); kf[7]=*(const __attribute__((address_space(3))) bf16x8*)(kp+6656);
}
__device__ __forceinline__ void kload2(bf16x8*kf,lds_cptr kp,int j){ kf[2*j]=*(const __attribute__((address_space(3))) bf16x8*)(kp+j*2048); kf[2*j+1]=*(const __attribute__((address_space(3))) bf16x8*)(kp+j*2048+512); }
__device__ __forceinline__ s16x4 vtr(lds_cptr p){ return __builtin_bit_cast(s16x4,__builtin_amdgcn_ds_read_tr16_b64_v4i16((__attribute__((address_space(3))) v4i16_t*)p)); }
__device__ __forceinline__ float rowmax(const f32x16&p0,const f32x16&p1){
  float a=max3f(p0[0],p0[1],p1[0]),b=max3f(p0[2],p0[3],p1[1]);a=max3f(a,p1[2],p1[3]);
  #pragma unroll
  for(int r=4;r<16;r+=4){a=max3f(a,p0[r],p0[r+1]);b=max3f(b,p0[r+2],p0[r+3]);a=max3f(a,p1[r],p1[r+1]);b=max3f(b,p1[r+2],p1[r+3]);}
  const float m=max2f(a,b);
  auto rr=__builtin_amdgcn_permlane32_swap(__float_as_uint(m),__float_as_uint(m),false,false);
  return max2f(__uint_as_float(rr[0]),__uint_as_float(rr[1]));
}
__device__ __forceinline__ void pv(f32x16*o,int vb,bf16x8 pa0,bf16x8 pa1,bf16x8 pa2,bf16x8 pa3){
  #pragma unroll
  for(int d0=0;d0<2;++d0){s16x4 lo[4],hi[4];
    #pragma unroll
    for(int ks=0;ks<4;++ks){
      asm volatile("ds_read_b64_tr_b16 %0,%1 offset:%c2":"=&v"(lo[ks]):"v"(vb),"i"(d0*4096+ks*1024):"memory");
      asm volatile("ds_read_b64_tr_b16 %0,%1 offset:%c2":"=&v"(hi[ks]):"v"(vb),"i"(d0*4096+ks*1024+512):"memory");}
    asm volatile("s_waitcnt lgkmcnt(0)":::"memory");SBAR();
    #define PK(k) (bf16x8){lo[k][0],lo[k][1],lo[k][2],lo[k][3],hi[k][0],hi[k][1],hi[k][2],hi[k][3]}
    o[d0]=__builtin_amdgcn_mfma_f32_32x32x16_bf16(pa0,PK(0),o[d0],0,0,0);
    o[d0]=__builtin_amdgcn_mfma_f32_32x32x16_bf16(pa1,PK(1),o[d0],0,0,0);
    o[d0]=__builtin_amdgcn_mfma_f32_32x32x16_bf16(pa2,PK(2),o[d0],0,0,0);
    o[d0]=__builtin_amdgcn_mfma_f32_32x32x16_bf16(pa3,PK(3),o[d0],0,0,0);
    #undef PK
  }
}

#ifndef ATTN_STORE16
#define ATTN_STORE16(p,v) (*(u32x4*)(p)=(v))
#endif
template<int THRL,bool NOMAX> __device__ __forceinline__ void attn_unit(const int b,const int NT,const bf16*Qw0,const int qpitch,const bf16*__restrict__ Kh,const bf16*__restrict__ Vh,const int kvpitch,bf16*Ow0,const int opitch,char*shm){
  const int tid=tid_fresh(),lane=tid&63,r32=lane&31,hi=lane>>5; const int wid=__builtin_amdgcn_readfirstlane(tid>>6);
  const bf16*Qw=Qw0+(long)(wid*QBLK)*qpitch;
  const unsigned lds0=(unsigned)(uintptr_t)shm;
  float*wsf=(float*)(shm+LDS_WS)+wid*64;
  const bf16*ksrc=Kh+(long)lane*kvpitch+wid*8;
  const bf16*vsrc=Vh+(long)(16*(wid&3)+(lane>>2))*kvpitch+(wid>>2)*32+(lane&3)*8;
  const unsigned kdst=lds0+LDS_K+wid*1024, vdst=lds0+LDS_V+wid*1024;
  #define KROW(t) ((long)((t)<4 ? b*256+64*(t) : 2048+b*4096+64*((t)-4)))
  #define DMA_K(t,slot) glds16(ksrc+KROW(t)*kvpitch,(unsigned)__builtin_amdgcn_readfirstlane(kdst+(slot)))
  #define DMA_V(t,slot) glds16(vsrc+KROW(t)*kvpitch,(unsigned)__builtin_amdgcn_readfirstlane(vdst+(slot)))
  const int vb0=(int)(lds0+LDS_V)+((lane>>4)&1)*32+(lane&3)*8+(4*hi+((lane&15)>>2))*64;
  const char*Kbase=shm+LDS_K; bf16x8 kf[8];
  const lds_cptr shm3=(lds_cptr)shm; const lds_cptr kp0=shm3+LDS_K+hi*1024+r32*16; const lds_cptr vp0=shm3+LDS_V+((lane>>4)&1)*32+(lane&3)*8+(4*hi+((lane&15)>>2))*64;
  DMA_K(0,0);DMA_V(0,0);DMA_K(1,SLOTB);
  bf16x8 qr[4];
  #pragma unroll
  for(int d0=0;d0<4;++d0)qr[d0]=*reinterpret_cast<const bf16x8*>(&Qw[(long)r32*qpitch+d0*16+hi*8]);
  float mhat=0.f,l_reg=0.f;f32x16 o[2];o[0]=f32x16{};o[1]=f32x16{};f32x16 negm=f32x16{};asm volatile("":"+v"(negm));
  #define CMASK(P0,P1,t) do{}while(0)
  bool resc=false;
  #define START(P0,P1) do{ const float rm=rowmax(P0,P1); resc=false; \
    { const float dl=rm; mhat=fadd_s(mhat,dl); \
      _Pragma("unroll") for(int r=0;r<16;++r){P0[r]=fsub_s(P0[r],dl);P1[r]=fsub_s(P1[r],dl);} \
      _Pragma("unroll") for(int r=0;r<16;++r)negm[r]=-mhat; asm volatile("":"+v"(negm)); } \
    _Pragma("unroll") for(int r=0;r<16;++r)P0[r]=__builtin_amdgcn_exp2f(P0[r]); }while(0)
  #define RESC() do{ if(resc){ asm volatile("s_waitcnt lgkmcnt(0)":::"memory"); \
      _Pragma("unroll") for(int d_=0;d_<2;++d_) _Pragma("unroll") for(int r=0;r<16;++r)o[d_][r]*=wsf[crow(r,hi)]; } }while(0)
  f32x16 pA0,pA1,pB0,pB1;
  int sl_prev=0,sl_cur=0,sl_next=SLOTB;
  #define ROT() do{sl_prev=sl_cur;sl_cur=sl_next;sl_next=(sl_next==(NSLOT-1)*SLOTB)?0:sl_next+SLOTB;}while(0)
  DMA_K(2,2*SLOTB);
  WAIT_BAR(3);
  qkt(pA0,pA1,Kbase,qr,negm,r32,hi);asm volatile("s_nop 15\n\ts_nop 7":"+v"(pA0),"+v"(pA1));CMASK(pA0,pA1,0);
  START(pA0,pA1);
  _Pragma("unroll") for(int r=0;r<16;++r)pA1[r]=__builtin_amdgcn_exp2f(pA1[r]);
  WAIT_BAR(0);
  DMA_K(3,0);DMA_V(1,SLOTB);
  ROT();
  kload8(kf,kp0+sl_cur);
  WAIT_BAR(2);
  s16x4 vlo[8],vhi[8]; u32x4 pw0,pw1,pw2,pw3;
  #define PKW(P,B) cvtpk_s(P[B],P[B+1])
  #define PAF(k) __builtin_bit_cast(bf16x8,pw##k)
  #define VFR(i) (bf16x8){vlo[i][0],vlo[i][1],vlo[i][2],vlo[i][3],vhi[i][0],vhi[i][1],vhi[i][2],vhi[i][3]}
  #define PIN(x) asm volatile("":"+v"(x))
  #define MX3(a,b,c) __builtin_fmaxf(__builtin_fmaxf((a),(b)),(c))
  #define GAPA(MF,A0,A1,A2,A3,W0,W1,PW) do{ MF; sacc+=A0; sacc+=A1; sacc+=A2; sacc+=A3; PIN(sacc); W0; W1; PIN(PW); SBAR(); }while(0)
  #define EX(v) __builtin_amdgcn_exp2f(v)
  #define GAPB(MF,X,B) do{ MF; X[B]=EX(X[B]); X[B+1]=EX(X[B+1]); X[B+2]=EX(X[B+2]); X[B+3]=EX(X[B+3]); PIN(X); SBAR(); }while(0)
  #define VRD(i) do{ vlo[i]=vtr(vp_+(((i)>>2)*4096+((i)&3)*1024)); vhi[i]=vtr(vp_+(((i)>>2)*4096+((i)&3)*1024+512)); }while(0)
  #define KRD(G,j) do{ if(G){ kload2(kf,kp0+sl_next,j); SBAR(); } }while(0)
  #define STEP(C0,C1,P0,P1,t,GK,GV,GL) do{ SBAR(); \
    const lds_cptr vp_=vp0+sl_prev; \
    VRD(0); SBAR(); float sacc=(P0[0]+P0[1]); \
    GAPA(C0=__builtin_amdgcn_mfma_f32_32x32x16_bf16(kf[0],qr[0],negm,0,0,0), P0[2],P0[3],P0[4],P0[5],     pw0[0]=PKW(P0,0), pw0[1]=PKW(P0,2), pw0); \
    VRD(4); SBAR(); GAPA(C1=__builtin_amdgcn_mfma_f32_32x32x16_bf16(kf[1],qr[0],negm,0,0,0), P0[6],P0[7],P0[8],P0[9],     pw0[2]=PKW(P0,4), pw0[3]=PKW(P0,6), pw0); \
    VRD(1); SBAR(); GAPA(C0=__builtin_amdgcn_mfma_f32_32x32x16_bf16(kf[2],qr[1],C0,0,0,0),   P0[10],P0[11],P0[12],P0[13], pw1[0]=PKW(P0,8), pw1[1]=PKW(P0,10), pw1); \
    VRD(5); SBAR(); GAPA(C1=__builtin_amdgcn_mfma_f32_32x32x16_bf16(kf[3],qr[1],C1,0,0,0),   P0[14],P0[15],P1[0],P1[1],   pw1[2]=PKW(P0,12),pw1[3]=PKW(P0,14), pw1); \
    VRD(2); SBAR(); GAPA(C0=__builtin_amdgcn_mfma_f32_32x32x16_bf16(kf[4],qr[2],C0,0,0,0),   P1[2],P1[3],P1[4],P1[5],     pw2[0]=PKW(P1,0), pw2[1]=PKW(P1,2), pw2); \
    VRD(6); SBAR(); GAPA(C1=__builtin_amdgcn_mfma_f32_32x32x16_bf16(kf[5],qr[2],C1,0,0,0),   P1[6],P1[7],P1[8],P1[9],     pw2[2]=PKW(P1,4), pw2[3]=PKW(P1,6), pw2); \
    VRD(3); SBAR(); GAPA(C0=__builtin_amdgcn_mfma_f32_32x32x16_bf16(kf[6],qr[3],C0,0,0,0),   P1[10],P1[11],P1[12],P1[13], pw3[0]=PKW(P1,8), pw3[1]=PKW(P1,10), pw3); \
    VRD(7); SBAR(); GAPA(C1=__builtin_amdgcn_mfma_f32_32x32x16_bf16(kf[7],qr[3],C1,0,0,0),   P1[14],P1[15],0.f,0.f,       pw3[2]=PKW(P1,12),pw3[3]=PKW(P1,14), pw3); \
    l_reg+=sacc; \
    if(GK){DMA_K((t)+3,sl_cur);} if(GV){DMA_V((t)+1,sl_next);} \
    CMASK(C0,C1,t); \
    if(NOMAX){ resc=false; } else { float a=MX3(C0[0],C0[1],C1[0]),b=MX3(C0[2],C0[3],C1[1]); a=MX3(a,C1[2],C1[3]); \
      _Pragma("unroll") for(int r=4;r<16;r+=4){a=MX3(a,C0[r],C0[r+1]);b=MX3(b,C0[r+2],C0[r+3]);a=MX3(a,C1[r],C1[r+1]);b=MX3(b,C1[r+2],C1[r+3]);} \
      float rm=__builtin_fmaxf(a,b); { auto rr=__builtin_amdgcn_permlane32_swap(__float_as_uint(rm),__float_as_uint(rm),false,false); rm=__builtin_fmaxf(__uint_as_float(rr[0]),__uint_as_float(rr[1])); } \
      resc=false; \
      if(__builtin_expect(__any(rm>(float)THRL),0)){ const float dl=__builtin_fmaxf(rm,0.f); mhat+=dl; \
        _Pragma("unroll") for(int r=0;r<16;++r){C0[r]-=dl;C1[r]-=dl;} \
        _Pragma("unroll") for(int r=0;r<16;++r)negm[r]=-mhat; asm volatile("":"+v"(negm)); \
        const float f=__builtin_amdgcn_exp2f(-dl); l_reg*=f; if(hi==0)wsf[r32]=f; resc=true; } } \
    SBAR(); \
    GAPB(o[0]=__builtin_amdgcn_mfma_f32_32x32x16_bf16(PAF(0),VFR(0),o[0],0,0,0), C0,0); \
    GAPB(o[1]=__builtin_amdgcn_mfma_f32_32x32x16_bf16(PAF(0),VFR(4),o[1],0,0,0), C0,4); \
    KRD(GL,0); GAPB(o[0]=__builtin_amdgcn_mfma_f32_32x32x16_bf16(PAF(1),VFR(1),o[0],0,0,0), C0,8); \
    KRD(GL,1); GAPB(o[1]=__builtin_amdgcn_mfma_f32_32x32x16_bf16(PAF(1),VFR(5),o[1],0,0,0), C0,12); \
    KRD(GL,2); GAPB(o[0]=__builtin_amdgcn_mfma_f32_32x32x16_bf16(PAF(2),VFR(2),o[0],0,0,0), C1,0); \
    KRD(GL,3); GAPB(o[1]=__builtin_amdgcn_mfma_f32_32x32x16_bf16(PAF(2),VFR(6),o[1],0,0,0), C1,4); \
    GAPB(o[0]=__builtin_amdgcn_mfma_f32_32x32x16_bf16(PAF(3),VFR(3),o[0],0,0,0), C1,8); \
    GAPB(o[1]=__builtin_amdgcn_mfma_f32_32x32x16_bf16(PAF(3),VFR(7),o[1],0,0,0), C1,12); \
    }while(0)
  int t=1;
  #undef CMASK
  #define CMASK(P0,P1,t) do{}while(0)
  for(;t+5<NT;t+=2){
    STEP(pB0,pB1,pA0,pA1,t,true,true,true);     WAIT_BAR(2); RESC(); ROT();
    STEP(pA0,pA1,pB0,pB1,t+1,true,true,true);   WAIT_BAR(2); RESC(); ROT();
  }
  #undef CMASK
  #define CMASK(P0,P1,t) do{}while(0)
  #define ENDW(tt) do{ if((tt)+3<NT){WAIT_BAR(2);} else if((tt)+2<NT){WAIT_BAR(1);} else {WAIT_BAR(0);} }while(0)
  for(;t+1<NT;t+=2){
    STEP(pB0,pB1,pA0,pA1,t,(t+3<NT),(t+1<NT),(t+1<NT));       ENDW(t);   RESC(); ROT();
    STEP(pA0,pA1,pB0,pB1,t+1,(t+4<NT),(t+2<NT),(t+2<NT));     ENDW(t+1); RESC(); ROT();
  }
  STEP(pB0,pB1,pA0,pA1,NT-1,false,false,false); RESC();
  { float sacc=pB0[0]+pB0[1]; _Pragma("unroll") for(int r=2;r<16;++r)sacc+=pB0[r]; _Pragma("unroll") for(int r=0;r<16;++r)sacc+=pB1[r]; l_reg+=sacc;
    pw0=(u32x4){PKW(pB0,0),PKW(pB0,2),PKW(pB0,4),PKW(pB0,6)};pw1=(u32x4){PKW(pB0,8),PKW(pB0,10),PKW(pB0,12),PKW(pB0,14)};pw2=(u32x4){PKW(pB1,0),PKW(pB1,2),PKW(pB1,4),PKW(pB1,6)};pw3=(u32x4){PKW(pB1,8),PKW(pB1,10),PKW(pB1,12),PKW(pB1,14)};
    SBAR(); pv(o,vb0+sl_cur,PAF(0),PAF(1),PAF(2),PAF(3)); }
  #undef PKW
  #undef PAF
  #undef VFR
  #undef PIN
  #undef MX3
  #undef GAPA
  #undef GAPB
  #undef EX
  #undef VRD
  #undef KRD
  #undef STEP
  #undef ENDW
  {auto rr=__builtin_amdgcn_permlane32_swap(__float_as_uint(l_reg),__float_as_uint(l_reg),false,false);l_reg=__uint_as_float(rr[0])+__uint_as_float(rr[1]);}
  if(hi==0)wsf[32+r32]=l_reg;asm volatile("s_waitcnt lgkmcnt(0)":::"memory");
  float rli[16];
  #pragma unroll
  for(int r=0;r<16;++r)rli[r]=__builtin_amdgcn_rcpf(wsf[32+crow(r,hi)]);
  bf16*Ow=Ow0+(long)(wid*QBLK)*opitch;
  { bf16*stg=(bf16*)(shm+LDS_OST)+wid*2048;
    #pragma unroll
    for(int r=0;r<16;++r){const int orow=crow(r,hi);
      #pragma unroll
      for(int d0=0;d0<2;++d0)stg[orow*64+d0*32+r32]=__float2bfloat16(o[d0][r]*rli[r]);}
    asm volatile("s_waitcnt lgkmcnt(0)":::"memory");
    #pragma unroll
    for(int i=0;i<4;++i){const int row=i*8+(lane>>3),ch=lane&7; const u32x4 v=*(const u32x4*)(stg+row*64+ch*8); ATTN_STORE16(Ow+(long)row*opitch+ch*8,v);} }
  asm volatile("s_waitcnt lgkmcnt(0)\n\ts_barrier":::"memory");
  #undef DMA_K
  #undef KROW
  #undef DMA_V
  #undef CMASK
  #undef START
  #undef RESC
  #undef ROT
}
constexpr int ATTN_LDS_BYTES=LDS_BYTES;
#undef SBAR
#undef WAIT_BAR
}
#define LAS __attribute__((address_space(3)))
typedef unsigned short bfs;
typedef float f32x4 __attribute__((ext_vector_type(4)));
typedef float f32x16 __attribute__((ext_vector_type(16)));
typedef unsigned u32x4 __attribute__((ext_vector_type(4)));
typedef unsigned u32x2 __attribute__((ext_vector_type(2)));
typedef short s16x8 __attribute__((ext_vector_type(8)));
constexpr int DM = 1024, NB = 8, SEQ = 4096, NCTX = 256;
constexpr int RCTX = NB * NCTX, RLAT = NB * SEQ, ROWS = RCTX + RLAT;
constexpr int DFF = 2816, NGU = 2 * DFF;
constexpr int NIN0 = 2336, PIN0 = 2560, NIN1 = 5120;
constexpr int C_GQ = 0, C_GK = 256, C_GV = 512, C_GOG = 1024, C_GZ = 1536, C_AQ = 1568, C_AK = 2080, C_AV = 2208;
constexpr int C_FQ = 0, C_FF = 1024, C_FI = 3072, C_FOG = 4096;
constexpr float RMS_EPS = 1e-6f;
constexpr size_t MiB = 1u << 20;
constexpr size_t WS_CTL = 0, CTL_BYTES = 65536;
constexpr size_t WS_MOD = 1 * MiB;
constexpr size_t WS_LB = WS_MOD + 512 * 1024;
constexpr size_t WS_XCTX = 2 * MiB;
constexpr size_t WS_WIN0 = 10 * MiB, WS_WOUT0 = 15 * MiB, WS_WGU0 = 17 * MiB, WS_WD0 = 28 * MiB;
constexpr size_t WS_WIN1 = 34 * MiB, WS_WOUT1 = 44 * MiB, WS_WGU1 = 46 * MiB, WS_WD1 = 57 * MiB;
constexpr size_t WS_C = 64 * MiB;
constexpr size_t WS_D = 132 * MiB;
constexpr size_t WS_Y = WS_D + 192 * MiB;
constexpr size_t WS_E0 = WS_D + 260 * MiB;
constexpr size_t WS_END = WS_D + 340 * MiB + 40 * MiB;
constexpr int OSPLIT = 16384;
static_assert(WS_WD1 + (size_t)DM * DFF * 2 <= WS_C && WS_C + (size_t)ROWS * DM * 2 <= WS_D && (size_t)ROWS * DFF * 2 <= 192 * MiB && (size_t)ROWS * NIN1 * 2 <= 340 * MiB, "ws map");
constexpr int LDS_CTL_OFF = 153600, LDS_BYTES = 154112;
constexpr int NWAVES = 8, NTHR = 512;

__device__ __forceinline__ float bf2f(unsigned h) { return __uint_as_float(h << 16); }
__device__ __forceinline__ unsigned f2bf(float f) { unsigned u = __float_as_uint(f); return (u + 0x7fffu + ((u >> 16) & 1u)) >> 16; }
__device__ __forceinline__ unsigned pk2(float lo, float hi) { return pg8::cvt_pk_bf16(lo, hi); }
__device__ __forceinline__ float dpp_ror(float x, const int n) {
    switch (n) {
    case 8: return __int_as_float(__builtin_amdgcn_update_dpp(0, __float_as_int(x), 0x128, 0xf, 0xf, false));
    case 4: return __int_as_float(__builtin_amdgcn_update_dpp(0, __float_as_int(x), 0x124, 0xf, 0xf, false));
    case 2: return __int_as_float(__builtin_amdgcn_update_dpp(0, __float_as_int(x), 0x122, 0xf, 0xf, false));
    default: return __int_as_float(__builtin_amdgcn_update_dpp(0, __float_as_int(x), 0x121, 0xf, 0xf, false));
    }
}
__device__ __forceinline__ float wave_sum(float v) {
    v += dpp_ror(v, 8); v += dpp_ror(v, 4); v += dpp_ror(v, 2); v += dpp_ror(v, 1);
    const int vi = __float_as_int(v);
    const float r0 = __int_as_float(__builtin_amdgcn_readlane(vi, 0)), r1 = __int_as_float(__builtin_amdgcn_readlane(vi, 16)), r2 = __int_as_float(__builtin_amdgcn_readlane(vi, 32)), r3 = __int_as_float(__builtin_amdgcn_readlane(vi, 48));
    return (r0 + r1) + (r2 + r3);
}
__device__ __forceinline__ float siluf(float x) { return x * __builtin_amdgcn_rcpf(1.f + __expf(-x)); }

struct Args { const float* in[24]; float* out; unsigned char* ws; };

__device__ __forceinline__ void p0_transpose_item(const float* W, int K, int N, bfs* WT, int k0, int n0, int drow0, LAS float* scr, int lane) {
    float tv[32];
#pragma unroll
    for (int i = 0; i < 32; ++i) tv[i] = W[(size_t)(k0 + 2 * i + (lane >> 5)) * N + n0 + (lane & 31)];
#pragma unroll
    for (int i = 0; i < 32; ++i) scr[(2 * i + (lane >> 5)) * 33 + (lane & 31)] = tv[i];
    asm volatile("s_waitcnt lgkmcnt(0)" ::: "memory");
    const int c = lane & 7;
#pragma unroll
    for (int j = 0; j < 4; ++j) { const int n = (lane >> 3) + 8 * j; const LAS float* s = scr + (8 * c) * 33 + n;
        u32x4 o; o.x = pk2(s[0 * 33], s[1 * 33]); o.y = pk2(s[2 * 33], s[3 * 33]); o.z = pk2(s[4 * 33], s[5 * 33]); o.w = pk2(s[6 * 33], s[7 * 33]);
        *(u32x4*)(WT + (size_t)(drow0 + n) * K + k0 + 8 * c) = o; }
    asm volatile("s_waitcnt lgkmcnt(0)" ::: "memory");
}
__device__ __forceinline__ bool p0_try(int& r, const float* W, int K, int N, bfs* WT, int mode  , LAS float* scr, int lane) {
    const int nblk = N / 32, cnt = (K / 64) * nblk;
    if (r >= cnt) { r -= cnt; return false; }
    const int kb = r / nblk, nb = r % nblk, n0 = 32 * nb;
    const int drow0 = mode == 0 ? n0 : ((n0 >> 7) * 256 + (n0 & 127) + (mode == 2 ? 128 : 0));
    p0_transpose_item(W, K, N, WT, 64 * kb, n0, drow0, scr, lane);
    return true;
}
constexpr int P0_I_IN0 = 16 * (NIN0 / 32), P0_I_SQ = 16 * 32, P0_I_G = 16 * (DFF / 32), P0_I_D = (DFF / 64) * 32, P0_I_IN1 = 16 * (NIN1 / 32);
constexpr int P0_NA = P0_I_IN0 + P0_I_SQ + 2 * P0_I_G + P0_I_D + P0_I_IN1, P0_NITEMS = P0_NA + P0_I_SQ + 2 * P0_I_G + P0_I_D;
__device__ __forceinline__ void p0_weights(const Args& a, LAS unsigned char* lds, int it_lo, int it_hi, int gw, int NGW) {
    const int tid = tid_fresh(), lane = tid & 63, wave = tid >> 6;
    unsigned char* ws = a.ws;
    LAS float* scr = (LAS float*)(lds + wave * 16384);
    for (int it = it_lo + gw; it < it_hi; it += NGW) {
        int r = it;
        if (p0_try(r, a.in[10], 1024, NIN0, (bfs*)(ws + WS_WIN0), 0, scr, lane)) continue;
        if (p0_try(r, a.in[16], 1024, 1024, (bfs*)(ws + WS_WOUT0), 0, scr, lane)) continue;
        if (p0_try(r, a.in[21], 1024, DFF, (bfs*)(ws + WS_WGU0), 1, scr, lane)) continue;
        if (p0_try(r, a.in[22], 1024, DFF, (bfs*)(ws + WS_WGU0), 2, scr, lane)) continue;
        if (p0_try(r, a.in[23], DFF, 1024, (bfs*)(ws + WS_WD0), 0, scr, lane)) continue;
        if (p0_try(r, a.in[17], 1024, NIN1, (bfs*)(ws + WS_WIN1), 0, scr, lane)) continue;
        if (p0_try(r, a.in[20], 1024, 1024, (bfs*)(ws + WS_WOUT1), 0, scr, lane)) continue;
        if (p0_try(r, a.in[21] + (size_t)1024 * DFF, 1024, DFF, (bfs*)(ws + WS_WGU1), 1, scr, lane)) continue;
        if (p0_try(r, a.in[22] + (size_t)1024 * DFF, 1024, DFF, (bfs*)(ws + WS_WGU1), 2, scr, lane)) continue;
        p0_try(r, a.in[23] + (size_t)DFF * 1024, DFF, 1024, (bfs*)(ws + WS_WD1), 0, scr, lane);
    }
}
__device__ __forceinline__ void p0_phase(const Args& a, LAS unsigned char* lds, int G) {
    const int tid = tid_fresh(), lane = tid & 63, wave = tid >> 6;
    unsigned char* ws = a.ws;
    {
        LAS float* sc = (LAS float*)lds;
        LAS float* red = (LAS float*)(lds + 40960);
        for (int i = tid; i < 9 * 1024; i += NTHR) { const float v = i < 8192 ? a.in[1][i] : a.in[3][i - 8192]; sc[i] = siluf(v); }
        __syncthreads();
        float* MOD = (float*)(ws + WS_MOD);
        for (int it = blockIdx.x; it < 192; it += G) {
            const int l = it / 96, cb = it % 96, col = cb * 64 + lane;
            const float* w = a.in[4] + (size_t)l * 1024 * 6144 + (size_t)(wave * 128) * 6144 + col;
            float acc[9];
#pragma unroll
            for (int bb = 0; bb < 9; ++bb) acc[bb] = 0.f;
            for (int k0 = 0; k0 < 128; k0 += 32) {
                float wv[32];
#pragma unroll
                for (int j = 0; j < 32; ++j) wv[j] = w[(size_t)(k0 + j) * 6144];
#pragma unroll
                for (int j = 0; j < 32; ++j)
#pragma unroll
                    for (int bb = 0; bb < 9; ++bb) acc[bb] += sc[bb * 1024 + wave * 128 + k0 + j] * wv[j];
            }
#pragma unroll
            for (int bb = 0; bb < 9; ++bb) red[(wave * 9 + bb) * 64 + lane] = acc[bb];
            __syncthreads();
            for (int i = tid; i < 9 * 64; i += NTHR) { float s = 0.f;
#pragma unroll
                for (int w8 = 0; w8 < 8; ++w8) s += red[w8 * 576 + i];
                const int bb = i / 64, c = cb * 64 + (i & 63);
                MOD[((size_t)l * 9 + bb) * 6144 + c] = s + a.in[5][l * 6144 + c]; }
            __syncthreads();
        }
        float* LB = (float*)(ws + WS_LB);
        for (int i = blockIdx.x * NTHR + tid; i < 2048; i += G * NTHR) { const int d = i >> 10, f = i & 1023; const float x0 = a.in[18][d * 2048 + f], x1 = a.in[18][d * 2048 + 1024 + f]; LB[i] = 1.f / (1.f + __expf(x0 - x1)); }
        { u32x4* z = (u32x4*)(ws + WS_WIN0 + (size_t)NIN0 * 1024 * 2); const int n16 = (PIN0 - NIN0) * 1024 * 2 / 16;
          for (int i = blockIdx.x * NTHR + tid; i < n16; i += G * NTHR) z[i] = (u32x4){0u, 0u, 0u, 0u}; }
        __syncthreads();
    }
    p0_weights(a, lds, 0, (G >= 256) ? P0_NA : P0_NITEMS, blockIdx.x * NWAVES + wave, G * NWAVES);
}

struct RowOp {
    const void* xin_lat; const void* xin_ctx; void* xout_lat; void* xout_ctx;
    const bfs* y; const float* gpost; const float* modg; int gate_idx;
    bfs* h; const float* gpre; const float* modh; int shift_idx, scale_idx;
    int row_lo; int xin_bf, xout_bf;
};
__device__ __forceinline__ void row_phase(const RowOp op, int G, int row_lo_ = -1, int row_hi_ = ROWS, int blk_ = -1, int nblk_ = 0) {
    const int tid_ = tid_fresh(); const int lane = tid_ & 63, wave = tid_ >> 6;
    const int rlo = row_lo_ < 0 ? op.row_lo : row_lo_;
    const int gw = (blk_ < 0 ? (int)blockIdx.x : blk_) * NWAVES + wave, NGW = (blk_ < 0 ? G : nblk_) * NWAVES;
    const int rpw = (row_hi_ - rlo + NGW - 1) / NGW;
    const int r0 = rlo + gw * rpw, r1 = (r0 + rpw < row_hi_) ? r0 + rpw : row_hi_;
    if (r0 >= r1) return;
    f32x4 gp[4], gpre[4], gt[4], sh[4], sc[4];
#pragma unroll
    for (int j = 0; j < 4; ++j) { const int c = 4 * lane + 256 * j; gp[j] = op.y ? *(const f32x4*)(op.gpost + c) : (f32x4){0.f, 0.f, 0.f, 0.f}; gpre[j] = op.h ? *(const f32x4*)(op.gpre + c) : (f32x4){0.f, 0.f, 0.f, 0.f};
        gt[j] = sh[j] = sc[j] = (f32x4){0.f, 0.f, 0.f, 0.f}; }
    int cur_bb = -1;
    f32x4 xn[4]; u32x2 xnb[4], yn[4];
#pragma unroll
    for (int j = 0; j < 4; ++j) { xn[j] = (f32x4){0.f, 0.f, 0.f, 0.f}; xnb[j] = (u32x2){0u, 0u}; }
#define ROW_LOAD(r) do { const bool ic_ = (r) < RCTX; const size_t ro_ = ic_ ? (size_t)(r) * DM : (size_t)((r) - RCTX) * DM; const void* xb_ = ic_ ? op.xin_ctx : op.xin_lat; \
        if (op.xin_bf) { _Pragma("unroll") for (int j = 0; j < 4; ++j) xnb[j] = __builtin_nontemporal_load((const u32x2*)((const bfs*)xb_ + ro_ + 4 * lane + 256 * j)); } \
        else { _Pragma("unroll") for (int j = 0; j < 4; ++j) xn[j] = __builtin_nontemporal_load((const f32x4*)((const float*)xb_ + ro_ + 4 * lane + 256 * j)); } \
        _Pragma("unroll") for (int j = 0; j < 4; ++j) yn[j] = op.y ? __builtin_nontemporal_load((const u32x2*)(op.y + (size_t)(r) * DM + 4 * lane + 256 * j)) : (u32x2){0u, 0u}; } while (0)
    ROW_LOAD(r0);
    for (int r = r0; r < r1; ++r) {
        const bool isctx = r < RCTX; const int bb = isctx ? 8 : (r - RCTX) / SEQ;
        f32x4 v[4]; u32x2 yw[4];
#pragma unroll
        for (int j = 0; j < 4; ++j) { v[j] = op.xin_bf ? (f32x4){bf2f(xnb[j].x & 0xffffu), bf2f(xnb[j].x >> 16), bf2f(xnb[j].y & 0xffffu), bf2f(xnb[j].y >> 16)} : xn[j]; yw[j] = yn[j]; }
        if (r + 1 < r1) ROW_LOAD(r + 1);
        if (bb != cur_bb) { cur_bb = bb;
#pragma unroll
            for (int j = 0; j < 4; ++j) { const int c = 4 * lane + 256 * j;
                if (op.y) gt[j] = *(const f32x4*)(op.modg + (size_t)bb * 6144 + op.gate_idx * 1024 + c);
                if (op.h) { sh[j] = *(const f32x4*)(op.modh + (size_t)bb * 6144 + op.shift_idx * 1024 + c); sc[j] = *(const f32x4*)(op.modh + (size_t)bb * 6144 + op.scale_idx * 1024 + c) + 1.f; } } }
        if (op.y) {
            f32x4 yv[4]; float ss = 0.f;
#pragma unroll
            for (int j = 0; j < 4; ++j) { yv[j] = (f32x4){bf2f(yw[j].x & 0xffffu), bf2f(yw[j].x >> 16), bf2f(yw[j].y & 0xffffu), bf2f(yw[j].y >> 16)};
                ss += (yv[j].x * yv[j].x + yv[j].y * yv[j].y) + (yv[j].z * yv[j].z + yv[j].w * yv[j].w); }
            const float rinv = rsqrtf(wave_sum(ss) * (1.f / DM) + RMS_EPS);
            void* xob = isctx ? op.xout_ctx : op.xout_lat; const size_t xoo = isctx ? (size_t)r * DM : (size_t)(r - RCTX) * DM;
#pragma unroll
            for (int j = 0; j < 4; ++j) { v[j] = v[j] + gt[j] * (yv[j] * rinv * gp[j]);
                if (xob) { if (op.xout_bf) { u32x2 wx; wx.x = pk2(v[j].x, v[j].y); wx.y = pk2(v[j].z, v[j].w); __builtin_nontemporal_store(wx, (u32x2*)((bfs*)xob + xoo + 4 * lane + 256 * j));
                        v[j] = (f32x4){bf2f(wx.x & 0xffffu), bf2f(wx.x >> 16), bf2f(wx.y & 0xffffu), bf2f(wx.y >> 16)}; }
                    else __builtin_nontemporal_store(v[j], (f32x4*)((float*)xob + xoo + 4 * lane + 256 * j)); } }
        }
        if (op.h) {
            float ss = 0.f;
#pragma unroll
            for (int j = 0; j < 4; ++j) ss += (v[j].x * v[j].x + v[j].y * v[j].y) + (v[j].z * v[j].z + v[j].w * v[j].w);
            const float rinv = rsqrtf(wave_sum(ss) * (1.f / DM) + RMS_EPS);
#pragma unroll
            for (int j = 0; j < 4; ++j) { const f32x4 hv = (v[j] * rinv * gpre[j]) * sc[j] + sh[j];
                u32x2 w; w.x = pk2(hv.x, hv.y); w.y = pk2(hv.z, hv.w);
                *(u32x2*)(op.h + (size_t)r * DM + 4 * lane + 256 * j) = w; }
        }
    }
#undef ROW_LOAD
}

__device__ __forceinline__ void qk_phase(bfs* proj, const float* gq, const float* gk, int G) {
    const int tid_ = tid_fresh(); const int lane = tid_ & 63, wave = tid_ >> 6;
    const int gw = blockIdx.x * NWAVES + wave, NGW = G * NWAVES;
    const int sub = lane & 7;
    float gqv[8], gkv[8], inv[4];
#pragma unroll
    for (int e = 0; e < 8; ++e) { gqv[e] = gq[8 * sub + e]; gkv[e] = gk[8 * sub + e]; }
#pragma unroll
    for (int p = 0; p < 4; ++p) { const int pi = (4 * sub + p) & 15; inv[p] = exp2f(-(float)(2 * pi) * (13.287712379549449f / 32.f)); }
    const int rpw = (ROWS + NGW - 1) / NGW; const int r0 = gw * rpw, r1 = (r0 + rpw < ROWS) ? r0 + rpw : ROWS;
    u32x4 qn = (u32x4){0u, 0u, 0u, 0u}, kn = qn;
    if (r0 < r1) { qn = *(const u32x4*)(proj + (size_t)r0 * PIN0 + C_AQ + 8 * lane); kn = *(const u32x4*)(proj + (size_t)r0 * PIN0 + C_AK + 8 * (lane & 15)); }
    for (int r = r0; r < r1; ++r) {
        const bool lat = r >= RCTX; const int t = lat ? (r - RCTX) % SEQ : 0;
        const float pos = (sub < 4) ? (float)(t >> 6) : (float)(t & 63);
        float cs[4], sn[4];
#pragma unroll
        for (int p = 0; p < 4; ++p) { if (lat) { const float ang = pos * inv[p]; cs[p] = __cosf(ang); sn[p] = __sinf(ang);     } else { cs[p] = 1.f; sn[p] = 0.f; } }
        bfs* qp = proj + (size_t)r * PIN0 + C_AQ + 8 * lane;
        bfs* kp = proj + (size_t)r * PIN0 + C_AK + 8 * (lane & 15);
        const u32x4 qw = qn; const u32x4 kw = kn;
        if (r + 1 < r1) { qn = *(const u32x4*)(qp + PIN0); kn = *(const u32x4*)(kp + PIN0); }
        float q[8], k[8]; float sq = 0.f, sk = 0.f;
#pragma unroll
        for (int e = 0; e < 4; ++e) { q[2 * e] = bf2f(qw[e] & 0xffffu); q[2 * e + 1] = bf2f(qw[e] >> 16); k[2 * e] = bf2f(kw[e] & 0xffffu); k[2 * e + 1] = bf2f(kw[e] >> 16); }
#pragma unroll
        for (int e = 0; e < 8; ++e) { sq += q[e] * q[e]; sk += k[e] * k[e]; }
#pragma unroll
        for (int o = 1; o < 8; o <<= 1) { sq += __shfl_xor(sq, o); sk += __shfl_xor(sk, o); }
        const float rq = rsqrtf(sq * (1.f / 64.f) + RMS_EPS) , rk = rsqrtf(sk * (1.f / 64.f) + RMS_EPS);
        const float C2 = 0.125f * 1.4426950408889634f;
        u32x4 qo, ko;
#pragma unroll
        for (int p = 0; p < 4; ++p) {
            const float q0 = q[2 * p] * rq * gqv[2 * p], q1 = q[2 * p + 1] * rq * gqv[2 * p + 1];
            const float k0 = k[2 * p] * rk * gkv[2 * p], k1 = k[2 * p + 1] * rk * gkv[2 * p + 1];
            qo[p] = pk2((q0 * cs[p] - q1 * sn[p]) * C2, (q0 * sn[p] + q1 * cs[p]) * C2);
            ko[p] = pk2(k0 * cs[p] - k1 * sn[p], k0 * sn[p] + k1 * cs[p]);
        }
        *(u32x4*)qp = qo;
        if (lane < 16) *(u32x4*)kp = ko;
    }
}

template <int NCOL> __device__ __forceinline__ void readout_phase(const bfs* of, int pf, const bfs* ob, int pb, const bfs* ob2, int osplit, bfs* out, const bfs* proj, int pitch, int ogcol, const float* gain, int row_lo, int G) {
    constexpr int PL = NCOL / 64;
    constexpr int LPH = 128 / PL;
    const int tid_ = tid_fresh(); const int lane = tid_ & 63, wave = tid_ >> 6;
    const int gw = blockIdx.x * NWAVES + wave, NGW = G * NWAVES;
    float gv[PL];
#pragma unroll
    for (int e = 0; e < PL; ++e) gv[e] = gain[(PL * lane + e) & 127];
    const int rpw = (ROWS - row_lo + NGW - 1) / NGW; const int r0 = row_lo + gw * rpw, r1 = (r0 + rpw < ROWS) ? r0 + rpw : ROWS;
    u32x4 fn[PL / 8], bn[PL / 8], gn[PL / 8];
#define RO_LOAD(r) do { _Pragma("unroll") for (int c = 0; c < PL / 8; ++c) { fn[c] = *(const u32x4*)(of + (size_t)(r) * pf + PL * lane + 8 * c); bn[c] = *(const u32x4*)(((r) >= osplit ? ob2 : ob) + (size_t)(r) * pb + PL * lane + 8 * c); gn[c] = *(const u32x4*)(proj + (size_t)(r) * pitch + ogcol + PL * lane + 8 * c); } } while (0)
    if (r0 < r1) RO_LOAD(r0);
    for (int r = r0; r < r1; ++r) {
        float x[PL], g[PL]; float ss = 0.f;
#pragma unroll
        for (int c = 0; c < PL / 8; ++c) { const u32x4 fw = fn[c], bw = bn[c], gw4 = gn[c];
#pragma unroll
            for (int e = 0; e < 4; ++e) { x[8 * c + 2 * e] = bf2f(fw[e] & 0xffffu) + bf2f(bw[e] & 0xffffu); x[8 * c + 2 * e + 1] = bf2f(fw[e] >> 16) + bf2f(bw[e] >> 16); g[8 * c + 2 * e] = bf2f(gw4[e] & 0xffffu); g[8 * c + 2 * e + 1] = bf2f(gw4[e] >> 16); } }
        if (r + 1 < r1) RO_LOAD(r + 1);
#pragma unroll
        for (int e = 0; e < PL; ++e) ss += x[e] * x[e];
#pragma unroll
        for (int of2 = 1; of2 < LPH; of2 <<= 1) ss += __shfl_xor(ss, of2);
        const float rinv = rsqrtf(ss * (1.f / 128.f) + RMS_EPS);
#pragma unroll
        for (int c = 0; c < PL / 8; ++c) { u32x4 wv;
#pragma unroll
            for (int e = 0; e < 4; ++e) wv[e] = pk2(x[8 * c + 2 * e] * rinv * gv[8 * c + 2 * e] * siluf(g[8 * c + 2 * e]), x[8 * c + 2 * e + 1] * rinv * gv[8 * c + 2 * e + 1] * siluf(g[8 * c + 2 * e + 1]));
            *(u32x4*)(out + (size_t)r * DM + PL * lane + 8 * c) = wv; }
    }
#undef RO_LOAD
}

namespace scan {
#define SC_LBAR() asm volatile("s_waitcnt lgkmcnt(0)\n\ts_barrier" ::: "memory")
template <int PB> __device__ __forceinline__ int swz(int row, int chunk) {
    if (PB == 256) return row * 256 + ((chunk ^ (row & 15) ^ ((row >> 4) & 3)) << 4);
    else return row * 128 + ((chunk ^ (((row >> 1) ^ (row >> 4)) & 7)) << 4);
}
__device__ __forceinline__ int crow(int r, int hi) { return (r & 3) + 8 * (r >> 2) + 4 * hi; }
__device__ __forceinline__ float dpp_shr(float x, float old, const int n) {
    switch (n) {
    case 1: return __int_as_float(__builtin_amdgcn_update_dpp(__float_as_int(old), __float_as_int(x), 0x111, 0xf, 0xf, false));
    case 2: return __int_as_float(__builtin_amdgcn_update_dpp(__float_as_int(old), __float_as_int(x), 0x112, 0xf, 0xf, false));
    case 4: return __int_as_float(__builtin_amdgcn_update_dpp(__float_as_int(old), __float_as_int(x), 0x114, 0xf, 0xf, false));
    default: return __int_as_float(__builtin_amdgcn_update_dpp(__float_as_int(old), __float_as_int(x), 0x118, 0xf, 0xf, false));
    }
}
template <int DK, bool HG, int NV> struct Map {
    static constexpr int PQ = DK * 2;
    static constexpr int O_QG = 0, O_KG = 64 * PQ, O_KGT = 2 * 64 * PQ, O_VT = O_KGT + DK * 128, O_ST = O_VT + NV * 128, O_EGL = O_ST + NV * PQ, O_VR = O_EGL + DK * 4, O_ZB = O_VR + 64 * NV * 2, O_FB = O_ZB + 2048, O_END = HG ? O_ZB : O_FB + 16384;
};
template <int DK, bool HG, int pitch, int NV>
__device__ __forceinline__ void scan_unit(LAS unsigned char* L, const bfs* __restrict__ proj, const int qcol, const int kcol, const int vcol, const int zcol,
                                          const float* __restrict__ wg, const float* __restrict__ bg, bfs* O, bfs* O2, const int osplit, const int opitch, const int ocol, const int b, const int dir, const float qscale) {
    typedef Map<DK, HG, NV> MP;
    constexpr int PQ = MP::PQ, NTG = DK * 4, NVB = NV / 32, NST = (DK / 32) * NVB / 8, WPM = NVB / NST, NPV = NV / 64, VCPR = NV / 8, VPB = NV * 2;
    const int tid = tid_fresh(), lane = tid & 63, r32 = lane & 31, hi = lane >> 5, w = tid >> 6;
    const int c4 = tid >> 4, sg = tid & 15;
    const bool gact = tid < NTG;
    const int mk = w / WPM;
    const int nv0 = (w % WPM) * NST;
    const bool oact = w < 2 * NVB;
    f32x16 S[NST];
#pragma unroll
    for (int i = 0; i < NST; ++i)
#pragma unroll
        for (int r = 0; r < 16; ++r) S[i][r] = 0.f;
    s16x8 wgB = (s16x8){0, 0, 0, 0, 0, 0, 0, 0}; float bias = 0.f;
    if (!HG) {
        const int col = 32 * (w & 1) + r32;
#pragma unroll
        for (int j = 0; j < 8; ++j) wgB[j] = (short)f2bf(wg[(8 * hi + j) * 256 + col]);
        bias = bg[col];
    }
    constexpr int NQ = DK / 64, CPR = DK / 8;
    u32x4 pqA[NQ], pkA[NQ], pvA[NPV]; u32x4 pzA = (u32x4){0u, 0u, 0u, 0u};
#define SC_BASE(s) ({ const int g_ = dir ? ((s) < 4 ? 3 - (s) : 71 - (s)) : (s); (long)(g_ < 4 ? b * 256 + 64 * g_ : 2048 + b * 4096 + 64 * (g_ - 4)); })
#define SC_GROW(base, i) ((base) + (dir ? 63 - (i) : (i)))
#define SC_ISSUE(s) do { const long nb_ = SC_BASE(s); \
        _Pragma("unroll") for (int i = 0; i < NQ; ++i) { const int id = tid + 512 * i, row = id / CPR, c = id % CPR; const bfs* rp = proj + (size_t)SC_GROW(nb_, row) * pitch + 8 * c; pq[i] = *(const u32x4*)(rp + qcol); pk[i] = *(const u32x4*)(rp + kcol); } \
        _Pragma("unroll") for (int i = 0; i < NPV; ++i) { const int id = tid + 512 * i, row = id / VCPR, c = id % VCPR; pv[i] = *(const u32x4*)(proj + (size_t)SC_GROW(nb_, row) * pitch + vcol + 8 * c); } \
        if (!HG) { if (tid < 128) pz = *(const u32x4*)(proj + (size_t)SC_GROW(nb_, tid >> 1) * pitch + zcol + 8 * (tid & 1)); } } while (0)
    { auto& pq = pqA; auto& pk = pkA; auto& pv = pvA; auto& pz = pzA; SC_ISSUE(0); }
    unsigned ost[8]; long pbase = 0;
#pragma unroll
    for (int i = 0; i < 8; ++i) ost[i] = 0u;
#define SC_STORE(bs) do { const int nvt_ = w >> 1, mi_ = w & 1; const int lrow_ = dir ? 63 - (32 * mi_ + 4 * hi) : (32 * mi_ + 4 * hi); const long ostep_ = dir ? -(long)opitch : (long)opitch; \
        bfs* ob_ = (((bs) >= osplit) ? O2 : O) + (size_t)((bs) + lrow_) * opitch + ocol + 32 * nvt_ + r32; \
        _Pragma("unroll") for (int r = 0; r < 16; ++r) ob_[((r & 3) + 8 * (r >> 2)) * ostep_] = (bfs)((r & 1) ? (ost[r >> 1] >> 16) : (ost[r >> 1] & 0xffffu)); } while (0)
    auto body = [&](const int s, u32x4 (&pq)[NQ], u32x4 (&pk)[NQ], u32x4 (&pv)[NPV], u32x4& pz) __attribute__((always_inline)) {
        const long base = SC_BASE(s);
#ifdef PROBE_SEG
        unsigned long long tseg0 = __builtin_amdgcn_s_memrealtime();
#define SEG_MARK(k) do { const unsigned long long tn_ = __builtin_amdgcn_s_memrealtime(); if (HG && blockIdx.x == PROBE_BLK && threadIdx.x == 0 && (PROBE_SEG == (k) || PROBE_SEG == 0)) { volatile LAS unsigned long long* pa_ = (volatile LAS unsigned long long*)(L + 153600 + 64 + 40 * 8); pa_[0] += tn_ - tseg0; } tseg0 = tn_; } while (0)
#else
#define SEG_MARK(k) do {} while (0)
#endif
#pragma unroll
        for (int ti = 0; ti < NST; ++ti) { const int v = 32 * (nv0 + ti) + r32;
#pragma unroll
            for (int r4 = 0; r4 < 4; ++r4) { const int k0 = 32 * mk + 8 * r4 + 4 * hi; u32x2 wv; wv.x = pk2(S[ti][4 * r4], S[ti][4 * r4 + 1]); wv.y = pk2(S[ti][4 * r4 + 2], S[ti][4 * r4 + 3]);
                *(LAS u32x2*)(L + MP::O_ST + swz<PQ>(v, k0 >> 3) + (k0 & 7) * 2) = wv; } }
        if (s > 0 && oact) SC_STORE(pbase);
        pbase = base;
#pragma unroll
        for (int i = 0; i < NQ; ++i) { const int id = tid + 512 * i, row = id / CPR, c = id % CPR;
            *(LAS u32x4*)(L + MP::O_QG + swz<PQ>(row, c)) = pq[i]; *(LAS u32x4*)(L + MP::O_KG + swz<PQ>(row, c)) = pk[i]; }
#pragma unroll
        for (int i = 0; i < NPV; ++i) { const int id = tid + 512 * i, row = id / VCPR, c = id % VCPR; *(LAS u32x4*)(L + MP::O_VR + swz<VPB>(row, c)) = pv[i]; }
        if (!HG) { if (tid < 128) *(LAS u32x4*)(L + MP::O_ZB + (tid >> 1) * 32 + (tid & 1) * 16) = pz; }
        if (s + 1 < 68) SC_ISSUE(s + 1);
        SC_LBAR();
        u32x2 q2[4], k2[4];
#pragma unroll
        for (int r = 0; r < 4; ++r) { q2[r] = (u32x2){0u, 0u}; k2[r] = (u32x2){0u, 0u}; }
        if (gact) {
#pragma unroll
            for (int r = 0; r < 4; ++r) { const int off = swz<PQ>(4 * sg + r, c4 >> 1) + (c4 & 1) * 8; q2[r] = *(const LAS u32x2*)(L + MP::O_QG + off); k2[r] = *(const LAS u32x2*)(L + MP::O_KG + off); } }
        if (c4 < NV / 4) {
            u32x2 v2[4];
#pragma unroll
            for (int r = 0; r < 4; ++r) v2[r] = *(const LAS u32x2*)(L + MP::O_VR + swz<VPB>(4 * sg + r, c4 >> 1) + (c4 & 1) * 8);
            u32x2 t0, t1, t2, t3;
            t0.x = (v2[0].x & 0xffffu) | (v2[1].x << 16); t0.y = (v2[2].x & 0xffffu) | (v2[3].x << 16);
            t1.x = (v2[0].x >> 16) | (v2[1].x & 0xffff0000u); t1.y = (v2[2].x >> 16) | (v2[3].x & 0xffff0000u);
            t2.x = (v2[0].y & 0xffffu) | (v2[1].y << 16); t2.y = (v2[2].y & 0xffffu) | (v2[3].y << 16);
            t3.x = (v2[0].y >> 16) | (v2[1].y & 0xffff0000u); t3.y = (v2[2].y >> 16) | (v2[3].y & 0xffff0000u);
            const int vo = (sg & 1) * 8;
            *(LAS u32x2*)(L + MP::O_VT + swz<128>(4 * c4 + 0, sg >> 1) + vo) = t0; *(LAS u32x2*)(L + MP::O_VT + swz<128>(4 * c4 + 1, sg >> 1) + vo) = t1;
            *(LAS u32x2*)(L + MP::O_VT + swz<128>(4 * c4 + 2, sg >> 1) + vo) = t2; *(LAS u32x2*)(L + MP::O_VT + swz<128>(4 * c4 + 3, sg >> 1) + vo) = t3; }
        float qv[4][4], kv[4][4];
#pragma unroll
        for (int r = 0; r < 4; ++r) { qv[r][0] = bf2f(q2[r].x & 0xffffu); qv[r][1] = bf2f(q2[r].x >> 16); qv[r][2] = bf2f(q2[r].y & 0xffffu); qv[r][3] = bf2f(q2[r].y >> 16);
            kv[r][0] = bf2f(k2[r].x & 0xffffu); kv[r][1] = bf2f(k2[r].x >> 16); kv[r][2] = bf2f(k2[r].y & 0xffffu); kv[r][3] = bf2f(k2[r].y >> 16); }
        if (!HG) {
            if (w < 4) { const int mi = w >> 1, nj = w & 1;
                const s16x8 za = *(const LAS s16x8*)(L + MP::O_ZB + (32 * mi + r32) * 32 + hi * 16);
                f32x16 lg;
#pragma unroll
                for (int r = 0; r < 16; ++r) lg[r] = 0.f;
                lg = __builtin_amdgcn_mfma_f32_32x32x16_bf16(za, wgB, lg, 0, 0, 0);
#pragma unroll
                for (int r = 0; r < 16; ++r) { const float x = lg[r] + bias; const float ls = fminf(x, 0.f) - __logf(1.f + __expf(-fabsf(x)));
                    ((LAS float*)(L + MP::O_FB))[(32 * mi + crow(r, hi)) * 64 + 32 * nj + r32] = __expf(ls * (1.f / 16.f)); } }
            SC_LBAR();
        }
        if (gact) {
            float p[4][4];
#pragma unroll
            for (int r = 0; r < 4; ++r) {
                f32x4 f;
                if (HG) f = (f32x4){1.f - kv[r][0], 1.f - kv[r][1], 1.f - kv[r][2], 1.f - kv[r][3]};
                else f = *(const LAS f32x4*)(L + MP::O_FB + ((4 * sg + r) * 64 + 4 * c4) * 4);
#pragma unroll
                for (int e = 0; e < 4; ++e) p[r][e] = r ? p[r - 1][e] * f[e] : f[e]; }
            float ex[4];
#pragma unroll
            for (int e = 0; e < 4; ++e) { float x = p[3][e];
                x *= dpp_shr(x, 1.f, 1); x *= dpp_shr(x, 1.f, 2); x *= dpp_shr(x, 1.f, 4); x *= dpp_shr(x, 1.f, 8);
                ex[e] = dpp_shr(x, 1.f, 1);
                if (sg == 15) ((LAS float*)(L + MP::O_EGL))[4 * c4 + e] = x; }
            float kg[4][4];
#pragma unroll
            for (int r = 0; r < 4; ++r) { const int row = 4 * sg + r; float qg[4];
#pragma unroll
                for (int e = 0; e < 4; ++e) { const float eG = ex[e] * p[r][e]; qg[e] = qv[r][e] * qscale * eG; kg[r][e] = kv[r][e] * __builtin_amdgcn_rcpf(eG); }
                u32x2 wq, wk; wq.x = pk2(qg[0], qg[1]); wq.y = pk2(qg[2], qg[3]); wk.x = pk2(kg[r][0], kg[r][1]); wk.y = pk2(kg[r][2], kg[r][3]);
                const int off = swz<PQ>(row, c4 >> 1) + (c4 & 1) * 8;
                *(LAS u32x2*)(L + MP::O_QG + off) = wq; *(LAS u32x2*)(L + MP::O_KG + off) = wk; }
#pragma unroll
            for (int e = 0; e < 4; ++e) { u32x2 wt; wt.x = pk2(kg[0][e], kg[1][e]); wt.y = pk2(kg[2][e], kg[3][e]);
                *(LAS u32x2*)(L + MP::O_KGT + swz<128>(4 * c4 + e, sg >> 1) + (sg & 1) * 8) = wt; }
        }
        SC_LBAR();
        SEG_MARK(1);
        f32x16 acc;
#pragma unroll
        for (int r = 0; r < 16; ++r) acc[r] = 0.f;
        { const int mi = (w >> 1) & 1, nj = w & 1;
          if (w < 4 && nj <= mi) {
#pragma unroll
            for (int kk = 0; kk < DK / 16; ++kk) { const s16x8 ka = *(const LAS s16x8*)(L + MP::O_KG + swz<PQ>(32 * nj + r32, 2 * kk + hi)); const s16x8 bq = *(const LAS s16x8*)(L + MP::O_QG + swz<PQ>(32 * mi + r32, 2 * kk + hi));
                acc = __builtin_amdgcn_mfma_f32_32x32x16_bf16(ka, bq, acc, 0, 0, 0); } }
          SC_LBAR();
          if (w < 4) { const int i = 32 * mi + r32;
#pragma unroll
            for (int r4 = 0; r4 < 4; ++r4) { const int j0 = 32 * nj + 8 * r4 + 4 * hi; float pp[4];
#pragma unroll
              for (int e = 0; e < 4; ++e) pp[e] = (j0 + e <= i) ? acc[4 * r4 + e] : 0.f;
              u32x2 wv; wv.x = pk2(pp[0], pp[1]); wv.y = pk2(pp[2], pp[3]);
              *(LAS u32x2*)(L + MP::O_KG + swz<128>(i, j0 >> 3) + (j0 & 7) * 2) = wv; } } }
        SC_LBAR();
        SEG_MARK(2);
        if (oact) { const int nvt = w >> 1, mi = w & 1;
#pragma unroll
          for (int r = 0; r < 16; ++r) acc[r] = 0.f;
#pragma unroll
          for (int kk = 0; kk < 4; ++kk) { const s16x8 va = *(const LAS s16x8*)(L + MP::O_VT + swz<128>(32 * nvt + r32, 2 * kk + hi)); const s16x8 bp = *(const LAS s16x8*)(L + MP::O_KG + swz<128>(32 * mi + r32, 2 * kk + hi));
              acc = __builtin_amdgcn_mfma_f32_32x32x16_bf16(bp, va, acc, 0, 0, 0); }
#pragma unroll
          for (int kk = 0; kk < DK / 16; ++kk) { const s16x8 sa = *(const LAS s16x8*)(L + MP::O_ST + swz<PQ>(32 * nvt + r32, 2 * kk + hi)); const s16x8 bq = *(const LAS s16x8*)(L + MP::O_QG + swz<PQ>(32 * mi + r32, 2 * kk + hi));
              acc = __builtin_amdgcn_mfma_f32_32x32x16_bf16(bq, sa, acc, 0, 0, 0); }
#pragma unroll
          for (int i = 0; i < 8; ++i) ost[i] = pk2(acc[2 * i], acc[2 * i + 1]);
          }
#pragma unroll
        for (int ti = 0; ti < NST; ++ti) {
#pragma unroll
            for (int kk = 0; kk < 4; ++kk) { const s16x8 ka = *(const LAS s16x8*)(L + MP::O_KGT + swz<128>(32 * mk + r32, 2 * kk + hi)); const s16x8 bv = *(const LAS s16x8*)(L + MP::O_VT + swz<128>(32 * (nv0 + ti) + r32, 2 * kk + hi));
                S[ti] = __builtin_amdgcn_mfma_f32_32x32x16_bf16(ka, bv, S[ti], 0, 0, 0); }
#pragma unroll
            for (int r = 0; r < 16; ++r) S[ti][r] *= ((const LAS float*)(L + MP::O_EGL))[32 * mk + crow(r, hi)]; }
        SC_LBAR();
        SEG_MARK(3);
    };
    for (int s2 = 0; s2 < 68; ++s2) body(s2, pqA, pkA, pvA, pzA);
    if (oact) SC_STORE(pbase);
    asm volatile("s_waitcnt vmcnt(0)" ::: "memory");
#undef SC_STORE
#undef SC_BASE
#undef SC_GROW
#undef SC_ISSUE
}
}

#define XB_TMO      128
#define XB_XCNT(j)  (256  + 64 * (j))
#define XB_XSUB(j)  (1280 + 64 * (j))
#define XB_XGEN(j)  (2304 + 64 * (j))
#define XB_TOP      3328
#define XB_TOPGEN   3392
#define XCD_BAR_WORDS 3456
#define XB_SPIN_CAP (1u << 18)

__device__ __forceinline__ unsigned xb_ld(unsigned* p)              { return __hip_atomic_load(p, __ATOMIC_RELAXED, __HIP_MEMORY_SCOPE_AGENT); }
__device__ __forceinline__ unsigned xb_add(unsigned* p, unsigned v) { return __hip_atomic_fetch_add(p, v, __ATOMIC_RELAXED, __HIP_MEMORY_SCOPE_AGENT); }
__device__ __forceinline__ unsigned xb_xcc_id() { return (unsigned)__builtin_amdgcn_s_getreg((3 << 11) | 20) & 0xFu; }
#define XB_SPIN(cond, bar) do { unsigned _sp = 0; while (cond) { __builtin_amdgcn_s_sleep(1); \
    if ((++_sp & 255u) == 0u) { if (xb_ld(&(bar)[XB_TMO])) break; if (_sp > XB_SPIN_CAP) { atomicAdd(&(bar)[XB_TMO], 1u); break; } } } } while (0)

struct XcdBarrier {
    unsigned* bar; unsigned x;
    volatile LAS unsigned* st;
};

__device__ __forceinline__ XcdBarrier xcd_barrier_post(unsigned* bar, volatile LAS unsigned* st) {
    XcdBarrier b; b.bar = bar; b.x = xb_xcc_id(); b.st = st;
    if (threadIdx.x == 0) (void)xb_add(&bar[XB_XCNT(b.x)], 1u);
    return b;
}
__device__ __forceinline__ void xcd_barrier_complete(unsigned* bar, unsigned x, unsigned& nloc, unsigned& nx) {
    const unsigned G = gridDim.x * gridDim.y * gridDim.z;
    unsigned sum, cnt, mine, sp = 0u;
    for (;;) {
        sum = 0u; cnt = 0u; mine = 0u;
#pragma unroll
        for (unsigned j = 0; j < 16; ++j) { const unsigned c = xb_ld(&bar[XB_XCNT(j)]); sum += c; cnt += (c > 0u) ? 1u : 0u; mine = (j == x) ? c : mine; }
        if (sum == G) break;
        __builtin_amdgcn_s_sleep(1);
        if ((++sp & 255u) == 0u) { if (xb_ld(&bar[XB_TMO])) break; if (sp > XB_SPIN_CAP) { atomicAdd(&bar[XB_TMO], 1u); break; } }
    }
    nloc = mine > 0u ? mine : 1u; nx = cnt > 0u ? cnt : 1u;
}

__device__ __forceinline__ void xcd_barrier(const XcdBarrier& b) {
    asm volatile("s_waitcnt vmcnt(0)" ::: "memory");
    __syncthreads();
    if (threadIdx.x == 0) {
        unsigned* bar = b.bar;
        __builtin_amdgcn_s_waitcnt(0);
        unsigned nloc = b.st[0], nx = b.st[1];
        if (nloc == 0u) { xcd_barrier_complete(bar, b.x, nloc, nx); b.st[0] = nloc; b.st[1] = nx; }
        const unsigned old = xb_add(&bar[XB_XSUB(b.x)], 1u);
        const unsigned gen = old / nloc;
        if (old + 1u == (gen + 1u) * nloc) {
            __builtin_amdgcn_fence(__ATOMIC_RELEASE, "agent");
            asm volatile("s_waitcnt vmcnt(0)" ::: "memory");
            const unsigned og = xb_add(&bar[XB_TOP], 1u);
            const unsigned tg = og / nx;
            if (og + 1u == (tg + 1u) * nx) xb_add(&bar[XB_TOPGEN], 1u);
            else XB_SPIN(xb_ld(&bar[XB_TOPGEN]) == tg, bar);
            __builtin_amdgcn_fence(__ATOMIC_ACQUIRE, "agent");
            xb_add(&bar[XB_XGEN(b.x)], 1u);
            asm volatile("s_waitcnt vmcnt(0)" ::: "memory");
        } else {
            XB_SPIN(xb_ld(&bar[XB_XGEN(b.x)]) == gen, bar);
            __builtin_amdgcn_fence(__ATOMIC_ACQUIRE, "agent");
            asm volatile("s_waitcnt vmcnt(0)" ::: "memory");
        }
    }
    __syncthreads();
}

#ifdef PROBE_MASK
#define STAMP() do { if (blockIdx.x == PROBE_BLK && threadIdx.x == 0) { pst[pn] = __builtin_amdgcn_s_memrealtime(); } ++pn; } while (0)
#else
#define STAMP() do {} while (0)
#endif
#define GRID_SYNC() do { xcd_barrier(xbar); STAMP(); } while (0)
#define GRID_SYNC_CG() do { if (a.ws == nullptr) grid.sync(); xcd_barrier(xbar); STAMP(); } while (0)
__global__ void __launch_bounds__(NTHR, 2) fwd_megakernel(Args a) {
    extern __shared__ __attribute__((aligned(16))) unsigned char lds_raw[];
    cg::grid_group grid = cg::this_grid();
    LAS unsigned char* lds = (LAS unsigned char*)lds_raw;
    const int G = gridDim.x, tid = threadIdx.x;
    unsigned char* ws = a.ws;
    float* MOD = (float*)(ws + WS_MOD); const float* LB = (const float*)(ws + WS_LB);
    bfs* XB1 = (bfs*)a.out;
    bfs* X2 = (bfs*)(ws + WS_D + 264 * MiB);
    bfs* CB = (bfs*)(ws + WS_C); bfs* DB = (bfs*)(ws + WS_D); bfs* YB = (bfs*)(ws + WS_Y); bfs* EB = (bfs*)(ws + WS_E0);
    unsigned* ctl = (unsigned*)(ws + WS_CTL);
    { volatile LAS unsigned* st0 = (volatile LAS unsigned*)(lds + LDS_CTL_OFF + 16); if (tid == 0) { st0[0] = 0u; st0[1] = 0u; } __syncthreads(); }
    XcdBarrier xbar = xcd_barrier_post(ctl + 1024, (volatile LAS unsigned*)(lds + LDS_CTL_OFF + 16));
#ifdef PROBE_MASK
    volatile LAS unsigned long long* pst = (volatile LAS unsigned long long*)(lds + LDS_CTL_OFF + 64); int pn = 1;
    if (threadIdx.x == 0) { pst[0] = __builtin_amdgcn_s_memrealtime(); pst[40] = 0; }
#endif

    p0_phase(a, lds, G);
    GRID_SYNC_CG();
    { RowOp op{a.in[0], a.in[2], nullptr, nullptr, nullptr, nullptr, nullptr, 0, CB, a.in[6], MOD, 0, 1, 0, 0, 0}; row_phase(op, G); }
    GRID_SYNC();
    for (int l = 0; l < 2; ++l) {
        const float* MODL = MOD + (size_t)l * 9 * 6144;
        const bfs* Win = (const bfs*)(ws + (l ? WS_WIN1 : WS_WIN0)); const bfs* Wout = (const bfs*)(ws + (l ? WS_WOUT1 : WS_WOUT0));
        const bfs* Wgu = (const bfs*)(ws + (l ? WS_WGU1 : WS_WGU0)); const bfs* Wd = (const bfs*)(ws + (l ? WS_WD1 : WS_WD0));
        const int pitch = l ? NIN1 : PIN0;
        { pg8::Gemm g{CB, Win, ROWS, pitch, DM}; pg8::StaticOrder S; S.init(ROWS, pitch, G, (int)blockIdx.x);
          pg8::EpiStore E{DB, pitch, l, LB};
#ifndef NO_GEMM
          pg8::gemm_phase<pg8::EpiStore, pg8::StaticOrder, true, true>(lds, g, S, E);
#endif
 }
        GRID_SYNC();
        if (l == 0) {
            qk_phase(DB, a.in[14], a.in[15], G);
            GRID_SYNC();
            volatile LAS unsigned* lctl = (volatile LAS unsigned*)(lds + LDS_CTL_OFF);
            float gqm = 0.f, gkm = 0.f;
            for (int i = 0; i < 64; ++i) { gqm = fmaxf(gqm, fabsf(a.in[14][i])); gkm = fmaxf(gkm, fabsf(a.in[15][i])); }
            const bool nomax = 2.f * 11.6f * gqm * gkm < 90.f;
            constexpr int N_GLA = 64, N_ATL = 1024, N_ATC = 64, N_ITEMS = N_GLA + N_ATL + N_ATC;
            for (;;) {
                if (tid == 0) lctl[0] = __hip_atomic_fetch_add(ctl + 64, 1u, __ATOMIC_RELAXED, __HIP_MEMORY_SCOPE_AGENT);
                __syncthreads();
                const int it = (int)lctl[0];
                __syncthreads();
                if (it >= N_ITEMS) break;
                if (it < N_GLA) {
                    const int b = it >> 3, h = (it >> 1) & 3, dir = it & 1;
#ifndef NO_GLA
                    scan::scan_unit<64, false, PIN0, 128>(lds, DB, C_GQ + 64 * h, C_GK + 64 * h, C_GV + 128 * h, C_GZ + 16 * dir, a.in[11] + dir * 16 * 256 + 64 * h, a.in[12] + dir * 256 + 64 * h,
                                               dir ? EB : CB, dir ? EB : CB, 0, dir ? 512 : DM, 128 * h, b, dir, 0.125f);
#endif
                } else if (it < N_GLA + N_ATL) {
                    const int u = it - N_GLA, gq = u & 3, qb = (u >> 2) & 15, kvh = (u >> 6) & 1, b = u >> 7, h = kvh * 4 + gq;
                    const size_t qrow = (size_t)RCTX + (size_t)b * SEQ + (size_t)qb * 256;
#ifndef NO_ATTN
                    if (nomax) attn_body::attn_unit<8, true>(b, 68, (const attn_body::bf16*)(DB + qrow * PIN0 + C_AQ + 64 * h), PIN0, (const attn_body::bf16*)(DB + C_AK + 64 * kvh), (const attn_body::bf16*)(DB + C_AV + 64 * kvh), PIN0,
                                            (attn_body::bf16*)(CB + qrow * DM + 512 + 64 * h), DM, (char*)lds_raw);
                    else attn_body::attn_unit<8, false>(b, 68, (const attn_body::bf16*)(DB + qrow * PIN0 + C_AQ + 64 * h), PIN0, (const attn_body::bf16*)(DB + C_AK + 64 * kvh), (const attn_body::bf16*)(DB + C_AV + 64 * kvh), PIN0,
                                            (attn_body::bf16*)(CB + qrow * DM + 512 + 64 * h), DM, (char*)lds_raw);
#endif
                } else {
                    const int u = it - N_GLA - N_ATL, h = u & 7, b = u >> 3, kvh = h >> 2;
                    const size_t qrow = (size_t)b * NCTX;
#ifndef NO_ATTN2
                    if (nomax) attn_body::attn_unit<8, true>(b, 4, (const attn_body::bf16*)(DB + qrow * PIN0 + C_AQ + 64 * h), PIN0, (const attn_body::bf16*)(DB + C_AK + 64 * kvh), (const attn_body::bf16*)(DB + C_AV + 64 * kvh), PIN0,
                                            (attn_body::bf16*)(CB + qrow * DM + 512 + 64 * h), DM, (char*)lds_raw);
                    else attn_body::attn_unit<8, false>(b, 4, (const attn_body::bf16*)(DB + qrow * PIN0 + C_AQ + 64 * h), PIN0, (const attn_body::bf16*)(DB + C_AK + 64 * kvh), (const attn_body::bf16*)(DB + C_AV + 64 * kvh), PIN0,
                                            (attn_body::bf16*)(CB + qrow * DM + 512 + 64 * h), DM, (char*)lds_raw);
#endif
                }
            }
            if (G >= 256) p0_weights(a, lds, P0_NA, P0_NITEMS, (int)blockIdx.x * NWAVES + (tid >> 6), G * NWAVES);
            GRID_SYNC();
            readout_phase<512>(CB, DM, EB, 512, EB, 0, CB, DB, PIN0, C_GOG, a.in[13], 0, G);
        } else {
            bfs* OA = (bfs*)(ws + 2 * MiB); bfs* OT2 = (bfs*)(ws + WS_D + 340 * MiB) - (size_t)OSPLIT * DM;
            for (int u = blockIdx.x; u < 256; u += G) {
                const int b = u >> 5, hh = (u >> 2) & 7, dir = (u >> 1) & 1, vh = u & 1;
#ifndef NO_HG
                scan::scan_unit<128, true, NIN1, 64>(lds, DB, C_FQ + 128 * hh, C_FF + 1024 * dir + 128 * hh, C_FI + 128 * hh + 64 * vh, 0, nullptr, nullptr,
                                                     dir ? OA : CB, dir ? OT2 : CB, dir ? OSPLIT : 0, DM, 128 * hh + 64 * vh, b, dir, 1.0f);
#endif
            }
            GRID_SYNC();
            readout_phase<1024>(CB, DM, OA, DM, OT2, OSPLIT, CB, DB, NIN1, C_FOG, a.in[19], RCTX, G);
        }
        GRID_SYNC();
        const int row_lo = l ? RCTX : 0; const int Mg = ROWS - row_lo;
#define PANEL_VARS const int nMg = Mg / 256, ncomp = nMg < G / 2 ? nMg : G / 2, nthird = (nMg - ncomp) * 4; \
        const bool third = (G == 256) ? (((int)blockIdx.x & 7) == 0 && 128 + ((int)blockIdx.x >> 5) < nMg) : ((int)blockIdx.x < nthird); \
        const int rrank = !nthird ? (int)blockIdx.x : (G == 256 ? ((int)blockIdx.x - ((int)blockIdx.x >> 3) - 1) : (int)blockIdx.x - nthird)
#define ROWOP_MIX RowOp op{l ? (const void*)(XB1 + (size_t)RCTX * DM) : (const void*)a.in[0], l ? (const void*)XB1 : (const void*)a.in[2], l ? (void*)X2 : (void*)(XB1 + (size_t)RCTX * DM), l ? (void*)nullptr : (void*)XB1, \
                   YB, a.in[7] + l * DM, MODL, 2, CB, a.in[8] + l * DM, MODL, 3, 4, row_lo, l, 1}
        for (int part = 0; part < 2; ++part) {
            { PANEL_VARS; (void)third; (void)rrank; (void)nthird; (void)ncomp;
              pg8::Gemm g{CB + (size_t)row_lo * DM, Wout, Mg, DM, DM}; pg8::EpiStore E{YB + (size_t)row_lo * DM, DM, 0, nullptr};
              pg8::PanelOrder S{nMg, G, (int)blockIdx.x, part ? 2 : 0, part ? 3 : 2};
#ifndef NO_GEMM
              pg8::gemm_phase<pg8::EpiStore, pg8::PanelOrder, true, true>(lds, g, S, E);
#endif
            }
            if (part == 1) { PANEL_VARS; if (!third) { ROWOP_MIX; row_phase(op, G, row_lo, row_lo + ncomp * 256, rrank, G - nthird); } }
            GRID_SYNC();
        }
        { PANEL_VARS; (void)third; (void)rrank; (void)nthird; if (ncomp < nMg) { ROWOP_MIX; row_phase(op, G, row_lo + ncomp * 256, ROWS); GRID_SYNC(); } }
        { pg8::Gemm g{CB + (size_t)row_lo * DM, Wgu, Mg, NGU, DM}; pg8::StaticOrder S; S.init(Mg, NGU, G, (int)blockIdx.x);
          pg8::EpiSwiGLU E{DB + (size_t)row_lo * DFF, DFF};
#ifndef NO_GEMM
          pg8::gemm_phase<pg8::EpiSwiGLU, pg8::StaticOrder, true, true>(lds, g, S, E);
#endif
 }
        GRID_SYNC();
#define ROWOP_FFN RowOp op{l ? (const void*)X2 : (const void*)(XB1 + (size_t)RCTX * DM), l ? (const void*)nullptr : (const void*)XB1, l ? (void*)a.out : (void*)(XB1 + (size_t)RCTX * DM), l ? (void*)nullptr : (void*)XB1, \
                   YB, a.in[9] + l * DM, MODL, 5, l ? (bfs*)nullptr : CB, l ? (const float*)nullptr : a.in[6] + DM, l ? (const float*)nullptr : MOD + (size_t)9 * 6144, 0, l ? 0 : 1, l ? RCTX : 0, 1, l ? 0 : 1}
        for (int part = 0; part < 2; ++part) {
            { PANEL_VARS; (void)third; (void)rrank; (void)nthird; (void)ncomp;
              pg8::Gemm g{DB + (size_t)row_lo * DFF, Wd, Mg, DM, DFF}; pg8::EpiStore E{YB + (size_t)row_lo * DM, DM, 0, nullptr};
              pg8::PanelOrder S{nMg, G, (int)blockIdx.x, part ? 2 : 0, part ? 3 : 2};
#ifndef NO_GEMM
              pg8::gemm_phase<pg8::EpiStore, pg8::PanelOrder, true, true>(lds, g, S, E);
#endif
            }
            if (part == 1) { PANEL_VARS; if (!third) { ROWOP_FFN; row_phase(op, G, row_lo, row_lo + ncomp * 256, rrank, G - nthird); } }
            if (part == 0 || l == 0) GRID_SYNC();
        }
        { PANEL_VARS; (void)third; (void)rrank; (void)nthird; if (ncomp < nMg) { ROWOP_FFN; row_phase(op, G, row_lo + ncomp * 256, ROWS); GRID_SYNC(); } }
    }
#ifdef PROBE_SYNCS
    for (int i = 0; i < PROBE_SYNCS; ++i) xcd_barrier(xbar);
#endif
#ifdef PROBE_MASK
    STAMP();
    if (blockIdx.x == PROBE_BLK && threadIdx.x == 0) {
        unsigned long long extra = 0;
        for (int i = 1; i < pn; ++i) if ((PROBE_MASK >> (i - 1)) & 1u) extra += pst[i] - pst[i - 1];
        extra += pst[40];
        const unsigned long long t0 = __builtin_amdgcn_s_memrealtime();
        while (__builtin_amdgcn_s_memrealtime() - t0 < extra) __builtin_amdgcn_s_sleep(8);
    }
#endif
}

extern "C" void kernel_launch(void* const* d_in, const int* in_sizes, int n_in, void* d_out, int out_size, void* d_ws, size_t ws_size, hipStream_t stream) {
    static int grid = 0;
    if (grid == 0) {
        if (n_in != 24 || ws_size < WS_END) { fprintf(stderr, "kernel_launch: unexpected inputs (n_in %d, ws %zu < %zu)\n", n_in, ws_size, (size_t)WS_END); grid = -1; return; }
        int dev = 0, cus = 0, per_cu = 0;
        hipGetDevice(&dev);
        hipDeviceGetAttribute(&cus, hipDeviceAttributeMultiprocessorCount, dev);
        if (hipFuncSetAttribute((const void*)fwd_megakernel, hipFuncAttributeMaxDynamicSharedMemorySize, LDS_BYTES) != hipSuccess) { fprintf(stderr, "kernel_launch: hipFuncSetAttribute failed\n"); grid = -1; return; }
        if (hipOccupancyMaxActiveBlocksPerMultiprocessor(&per_cu, (const void*)fwd_megakernel, NTHR, LDS_BYTES) != hipSuccess || per_cu < 1) { fprintf(stderr, "kernel_launch: occupancy query gave %d\n", per_cu); per_cu = 1; }
        (void)hipGetLastError();
        grid = cus * 1;
        fprintf(stderr, "kernel_launch: grid %d (cus %d, per_cu %d)\n", grid, cus, per_cu);
    }
    if (grid < 0) return;
    hipMemsetAsync((char*)d_ws + WS_CTL, 0, CTL_BYTES, stream);
    Args a{};
    for (int i = 0; i < 24; ++i) a.in[i] = (const float*)d_in[i];
    a.out = (float*)d_out; a.ws = (unsigned char*)d_ws;
    void* args[] = {&a};
    hipError_t e = hipLaunchCooperativeKernel((const void*)fwd_megakernel, dim3(grid), dim3(NTHR), args, LDS_BYTES, stream);
    if (e != hipSuccess) fprintf(stderr, "cooperative launch failed: %s (grid %d)\n", hipGetErrorString(e), grid);
}
```

```cpp
#include <hip/hip_runtime.h>
#include <hip/hip_cooperative_groups.h>
#include <hip/hip_bf16.h>
#include <cstdio>
#include <cstdint>
#include <cmath>
namespace cg = cooperative_groups;
__device__ __forceinline__ int tid_fresh() { int t = threadIdx.x; asm volatile("" : "+v"(t)); return t; }
namespace pg8 {
#define PG8_LAS __attribute__((address_space(3)))
typedef unsigned short bf16_t;
typedef short bf16x8 __attribute__((ext_vector_type(8)));
typedef float f32x4 __attribute__((ext_vector_type(4)));
typedef unsigned u32x4 __attribute__((ext_vector_type(4)));
constexpr int BM = 256, BK = 64, HALF = 128, HTB = HALF * BK * 2  , STAGE_BYTES = 8 * HTB, NXCD = 8, WGM = 8;

__host__ __device__ __forceinline__ int lds_byte(int r, int c) { const int st = (r >> 4) * 2 + (c >> 5), rr = r & 15, cc = c & 31, ob = rr * 64 + cc * 2; return st * 1024 + (ob ^ (((ob >> 9) & 1) << 5)); }
__host__ __device__ __forceinline__ void stage_rc(int b, int& R, int& C) { const int st = b / 1024, sb = b % 1024, swz = sb ^ (((sb >> 9) & 1) << 5); R = (st >> 1) * 16 + swz / 64; C = (st & 1) * 32 + (swz % 64) / 2; }
__host__ __device__ __forceinline__ int perm32(int rho) { const int n = rho >> 4, i = rho & 15; return 8 * (i >> 2) + 4 * n + (i & 3); }

struct Unit { int pm, pn; };
struct Gemm { const bf16_t* A; const bf16_t* Bt; int M, N, K; };

struct StaticOrder {
    int nM, nN, nwg, G, c;
    __host__ __device__ void init(int M, int N, int G_, int c_) { nM = M / BM; nN = N / BM; nwg = nM * nN; G = G_; c = c_; }
    __host__ __device__ bool next(int i, Unit& u) const {
        const long L = (long)i * G + c; if (L >= nwg) return false;
        int wgid = (int)L; { const int q = nwg / NXCD, r = nwg % NXCD, xcd = wgid % NXCD, off = wgid / NXCD; wgid = (xcd < r ? xcd * (q + 1) : r * (q + 1) + (xcd - r) * q) + off; }
        const int nig = WGM * nN, gid = wgid / nig, fm = gid * WGM, gsz = (nM - fm) < WGM ? (nM - fm) : WGM;
        u.pm = fm + ((wgid % nig) % gsz); u.pn = (wgid % nig) / gsz; return true;
    }
    __device__ __forceinline__ void a_ready(const Unit&) const {}
    __device__ __forceinline__ void done(const Unit&) const {}
};

typedef float f32x2_cv __attribute__((ext_vector_type(2))); typedef __bf16 bf16x2_cv __attribute__((ext_vector_type(2)));
__device__ __forceinline__ unsigned cvt_pk_bf16(float lo, float hi) { f32x2_cv v = {lo, hi}; bf16x2_cv b = __builtin_convertvector(v, bf16x2_cv); return __builtin_bit_cast(unsigned, b); }
typedef float f32x2 __attribute__((ext_vector_type(2)));
struct PanelOrder {
    int nM, G, c, i0, i1;
    __host__ __device__ bool next(int i, Unit& u) const {
        const int r = i + i0; if (r >= i1) return false;
        if (G == 256) { const int x = c & 7, j = c >> 3; u.pm = r * 64 + x * 8 + (j >> 2); u.pn = j & 3; }
        else { const int L = r * G + c; u.pm = L >> 2; u.pn = L & 3; }
        return u.pm < nM;
    }
    __device__ __forceinline__ void a_ready(const Unit&) const {}
    __device__ __forceinline__ void done(const Unit&) const {}
};
typedef float f32x2 __attribute__((ext_vector_type(2)));
struct EpiStore {
    static constexpr bool PERM = true, AFTER_DRAIN = false;
    bf16_t* O; int ldc; int mode; const float* lb;
    __device__ __forceinline__ void operator()(const f32x4 (&acc)[2][2][4][2], const Unit& u, int wr, int wc, int fr, int fq) const {
        const int row0 = u.pm * BM + wr * 64 + fr; const int col0 = u.pn * BM + wc * 32 + 8 * fq;
#pragma unroll
        for (int bj = 0; bj < 2; ++bj) {
            const int col = col0 + bj * HALF;
            int cls = 0; f32x4 l0 = (f32x4){0.f,0.f,0.f,0.f}, l1 = l0;
            if (mode == 1) { if (col < 1024) cls = 1; else if (col < 3072) { cls = 2; l0 = *(const f32x4*)(lb + col - 1024); l1 = *(const f32x4*)(lb + col - 1024 + 4); } }
#pragma unroll
            for (int ai = 0; ai < 2; ++ai)
#pragma unroll
                for (int m = 0; m < 4; ++m) {
                    f32x4 v0 = acc[ai][bj][m][0], v1 = acc[ai][bj][m][1];
                    if (cls == 1) {
#pragma unroll
                        for (int e = 0; e < 4; ++e) { v0[e] = v0[e] * __builtin_amdgcn_rcpf(1.f + __expf(-v0[e])); v1[e] = v1[e] * __builtin_amdgcn_rcpf(1.f + __expf(-v1[e])); }
                    } else if (cls == 2) {
#pragma unroll
                        for (int e = 0; e < 4; ++e) { const float s0 = __builtin_amdgcn_rcpf(1.f + __expf(v0[e])), s1 = __builtin_amdgcn_rcpf(1.f + __expf(v1[e]));
                            v0[e] = (1.f - l0[e]) * s0; v1[e] = (1.f - l1[e]) * s1; }
                    }
                    u32x4 w; w.x = cvt_pk_bf16(v0[0], v0[1]); w.y = cvt_pk_bf16(v0[2], v0[3]); w.z = cvt_pk_bf16(v1[0], v1[1]); w.w = cvt_pk_bf16(v1[2], v1[3]);
                    *(u32x4*)(O + (size_t)(row0 + ai * HALF + m * 16) * ldc + col) = w;
                }
        }
    }
};
struct EpiSwiGLU {
    static constexpr bool PERM = true, AFTER_DRAIN = false;
    bf16_t* O; int ldc;
    __device__ __forceinline__ void operator()(const f32x4 (&acc)[2][2][4][2], const Unit& u, int wr, int wc, int fr, int fq) const {
        const int row0 = u.pm * BM + wr * 64 + fr; const int col = u.pn * HALF + wc * 32 + 8 * fq;
#pragma unroll
        for (int ai = 0; ai < 2; ++ai)
#pragma unroll
            for (int m = 0; m < 4; ++m) {
                f32x4 g0 = acc[ai][0][m][0], g1 = acc[ai][0][m][1]; const f32x4 u0 = acc[ai][1][m][0], u1 = acc[ai][1][m][1];
#pragma unroll
                for (int e = 0; e < 4; ++e) { g0[e] = g0[e] * __builtin_amdgcn_rcpf(1.f + __expf(-g0[e])) * u0[e]; g1[e] = g1[e] * __builtin_amdgcn_rcpf(1.f + __expf(-g1[e])) * u1[e]; }
                u32x4 w; w.x = cvt_pk_bf16(g0[0], g0[1]); w.y = cvt_pk_bf16(g0[2], g0[3]); w.z = cvt_pk_bf16(g1[0], g1[1]); w.w = cvt_pk_bf16(g1[2], g1[3]);
                *(u32x4*)(O + (size_t)(row0 + ai * HALF + m * 16) * ldc + col) = w;
            }
    }
};
template <class Epi, class Sched, bool ALIGN_EPI = false, bool SP2 = false>
__device__ __forceinline__ void gemm_phase(PG8_LAS unsigned char* lds, const Gemm g, const Sched& S, const Epi& E) {
    const int tid = tid_fresh(), wid = __builtin_amdgcn_readfirstlane(tid >> 6), lane = tid & 63, wr = wid >> 2, wc = wid & 3, fr = lane & 15, fq = lane >> 4;
    const int K = g.K, nt = K / BK;
    unsigned voffA[2], voffB[2];
#pragma unroll
    for (int i = 0; i < 2; ++i) { int R, C; stage_rc(tid * 16 + i * 8192, R, C); const int Rb = Epi::PERM ? ((R & ~31) + perm32(R & 31)) : R;
        voffA[i] = (unsigned)(R * K + C) * 2u; voffB[i] = (unsigned)(Rb * K + C) * 2u; }
    const size_t kstep = (size_t)(BK * 2);
    const size_t hstep = (size_t)HALF * K * 2;
    const size_t tstep = 2 * hstep;
    const unsigned ldsw = (unsigned)wid * 1024u;
    const int aoff = lds_byte(wr * 64 + fr, fq * 8), boff = lds_byte(wc * 32 + fr, fq * 8);
#define PG8_SA(b, h) (((b) * 2 + (h)) * HTB)
#define PG8_SB(b, h) ((4 + (b) * 2 + (h)) * HTB)
#define PG8_STAGE(bufoff, gbase, voff) do { _Pragma("unroll") for (int _i = 0; _i < 2; ++_i) \
        __builtin_amdgcn_global_load_lds((const unsigned*)((const char*)(gbase) + (voff)[_i]), (PG8_LAS unsigned*)(lds + (bufoff) + ldsw + _i * 8192), 16, 0, 0); } while (0)
#define PG8_LDA(dst, b, h) do { _Pragma("unroll") for (int m = 0; m < 4; ++m) _Pragma("unroll") for (int k = 0; k < 2; ++k) dst[m][k] = *(const PG8_LAS bf16x8*)(lds + PG8_SA(b, h) + aoff + m * 2048 + k * 1024); } while (0)
#define PG8_LDB(dst, b, h) do { _Pragma("unroll") for (int n = 0; n < 2; ++n) _Pragma("unroll") for (int k = 0; k < 2; ++k) dst[n][k] = *(const PG8_LAS bf16x8*)(lds + PG8_SB(b, h) + boff + n * 2048 + k * 1024); } while (0)
#define PG8_MMA(ai, bj, At, Bt) do { __builtin_amdgcn_s_setprio(1); _Pragma("unroll") for (int m = 0; m < 4; ++m) _Pragma("unroll") for (int n = 0; n < 2; ++n) _Pragma("unroll") for (int k = 0; k < 2; ++k) \
        acc[ai][bj][m][n] = __builtin_amdgcn_mfma_f32_16x16x32_bf16(Bt[n][k], At[m][k], acc[ai][bj][m][n], 0, 0, 0); __builtin_amdgcn_s_setprio(0); } while (0)
#define PG8_WAIT_V(n) asm volatile("s_waitcnt vmcnt(" #n ")" ::: "memory")
#define PG8_WAIT_L(n) asm volatile("s_waitcnt lgkmcnt(" #n ")" ::: "memory")
#define PG8_BAR __builtin_amdgcn_s_barrier()
#define PG8_SCHED __builtin_amdgcn_sched_barrier(0)
    Unit cur, nxt; int ui = 0;
    if (!S.next(0, cur)) return;
    f32x4 acc[2][2][4][2];
#pragma unroll
    for (int a = 0; a < 2; ++a)
#pragma unroll
        for (int b = 0; b < 2; ++b)
#pragma unroll
            for (int m = 0; m < 4; ++m)
#pragma unroll
                for (int n = 0; n < 2; ++n) acc[a][b][m][n] = (f32x4){0.f, 0.f, 0.f, 0.f};
    bf16x8 At[4][2], B0[2][2], B1[2][2];
    const char* cA = (const char*)g.A + (size_t)cur.pm * tstep; const char* cB = (const char*)g.Bt + (size_t)cur.pn * tstep;
    S.a_ready(cur);
    if constexpr (SP2) {
        PG8_STAGE(PG8_SB(0, 0), cB, voffB); PG8_STAGE(PG8_SB(0, 1), cB + hstep, voffB); PG8_STAGE(PG8_SA(0, 0), cA, voffA); PG8_STAGE(PG8_SA(0, 1), cA + hstep, voffA);
        if (wr == 1) PG8_BAR;
        PG8_WAIT_V(2); PG8_BAR;
        PG8_STAGE(PG8_SB(1, 0), cB + kstep, voffB); PG8_STAGE(PG8_SA(1, 0), cA + kstep, voffA); PG8_STAGE(PG8_SB(1, 1), cB + hstep + kstep, voffB);
        PG8_WAIT_V(6); PG8_BAR;
    } else {
        PG8_STAGE(PG8_SB(0, 0), cB, voffB); PG8_STAGE(PG8_SA(0, 0), cA, voffA); PG8_STAGE(PG8_SB(0, 1), cB + hstep, voffB); PG8_STAGE(PG8_SA(0, 1), cA + hstep, voffA);
        if (wr == 1) PG8_BAR;
        PG8_WAIT_V(4); PG8_BAR;
        PG8_STAGE(PG8_SB(1, 0), cB + kstep, voffB); PG8_STAGE(PG8_SA(1, 0), cA + kstep, voffA); PG8_STAGE(PG8_SB(1, 1), cB + hstep + kstep, voffB);
        PG8_WAIT_V(6); PG8_BAR;
    }
    for (;;) {
        const bool has_next = S.next(ui + 1, nxt);
        const char* nA = has_next ? (const char*)g.A + (size_t)nxt.pm * tstep : cA; const char* nB = has_next ? (const char*)g.Bt + (size_t)nxt.pn * tstep : cB;
        for (int t = 0; t < nt; t += 2) {
            const bool last = (t == nt - 2);
            const char* a1 = cA + (size_t)(t + 1) * kstep;
            const char* a2 = last ? nA : cA + (size_t)(t + 2) * kstep; const char* b2 = last ? nB : cB + (size_t)(t + 2) * kstep;
            const char* a3 = a2 + kstep; const char* b3 = b2 + kstep;
            if (last && has_next) S.a_ready(nxt);
            if constexpr (SP2) {
            PG8_LDB(B0, 0, 0); PG8_LDB(B1, 0, 1); PG8_SCHED; PG8_LDA(At, 0, 0); PG8_STAGE(PG8_SA(1, 1), a1 + hstep, voffA);
            PG8_WAIT_V(8); PG8_WAIT_L(0); PG8_BAR; PG8_MMA(0, 0, At, B0); PG8_MMA(0, 1, At, B1); PG8_BAR; PG8_SCHED;
            PG8_LDA(At, 0, 1); PG8_STAGE(PG8_SB(0, 0), b2, voffB); PG8_STAGE(PG8_SB(0, 1), b2 + hstep, voffB); PG8_STAGE(PG8_SA(0, 0), a2, voffA);
            PG8_WAIT_V(8); PG8_WAIT_L(0); PG8_BAR; PG8_MMA(1, 0, At, B0); PG8_MMA(1, 1, At, B1); PG8_BAR; PG8_SCHED;
            PG8_LDB(B0, 1, 0); PG8_LDB(B1, 1, 1); PG8_SCHED; PG8_LDA(At, 1, 0); PG8_STAGE(PG8_SA(0, 1), a2 + hstep, voffA);
            PG8_WAIT_V(8); PG8_WAIT_L(0); PG8_BAR; PG8_MMA(0, 0, At, B0); PG8_MMA(0, 1, At, B1); PG8_BAR; PG8_SCHED;
            PG8_LDA(At, 1, 1); PG8_STAGE(PG8_SB(1, 0), b3, voffB); PG8_STAGE(PG8_SB(1, 1), b3 + hstep, voffB); PG8_STAGE(PG8_SA(1, 0), a3, voffA);
            PG8_WAIT_V(8); PG8_WAIT_L(0); PG8_BAR; PG8_MMA(1, 0, At, B0); PG8_MMA(1, 1, At, B1); PG8_BAR; PG8_SCHED;
            } else {
            PG8_LDB(B0, 0, 0); PG8_SCHED; PG8_LDA(At, 0, 0); PG8_STAGE(PG8_SA(1, 1), a1 + hstep, voffA);
            PG8_WAIT_L(8); PG8_BAR; PG8_WAIT_L(0); PG8_MMA(0, 0, At, B0); PG8_BAR; PG8_SCHED;
            PG8_LDB(B1, 0, 1); PG8_STAGE(PG8_SB(0, 0), b2, voffB);
            PG8_BAR; PG8_WAIT_L(0); PG8_MMA(0, 1, At, B1); PG8_BAR;
            PG8_LDA(At, 0, 1); PG8_STAGE(PG8_SA(0, 0), a2, voffA);
            PG8_BAR; PG8_WAIT_L(0); PG8_MMA(1, 0, At, B0); PG8_BAR; PG8_SCHED;
            PG8_STAGE(PG8_SB(0, 1), b2 + hstep, voffB);
            PG8_WAIT_V(6); PG8_BAR; PG8_MMA(1, 1, At, B1); PG8_BAR;
            PG8_LDB(B0, 1, 0); PG8_SCHED; PG8_LDA(At, 1, 0); PG8_STAGE(PG8_SA(0, 1), a2 + hstep, voffA);
            PG8_WAIT_L(8); PG8_BAR; PG8_WAIT_L(0); PG8_MMA(0, 0, At, B0); PG8_BAR; PG8_SCHED;
            PG8_LDB(B1, 1, 1); PG8_STAGE(PG8_SB(1, 0), b3, voffB);
            PG8_BAR; PG8_WAIT_L(0); PG8_MMA(0, 1, At, B1); PG8_BAR;
            PG8_LDA(At, 1, 1); PG8_STAGE(PG8_SA(1, 0), a3, voffA);
            PG8_BAR; PG8_WAIT_L(0); PG8_MMA(1, 0, At, B0); PG8_BAR; PG8_SCHED;
            PG8_STAGE(PG8_SB(1, 1), b3 + hstep, voffB);
            PG8_WAIT_V(6); PG8_BAR; PG8_MMA(1, 1, At, B1); PG8_BAR;
            }
        }
        if constexpr (ALIGN_EPI) { if (wr == 0) PG8_BAR; }
        if constexpr (!Epi::AFTER_DRAIN) { E(acc, cur, wr, wc, fr, fq); S.done(cur); }
        if (!has_next) break;
#pragma unroll
        for (int a = 0; a < 2; ++a)
#pragma unroll
            for (int b = 0; b < 2; ++b)
#pragma unroll
                for (int m = 0; m < 4; ++m)
#pragma unroll
                    for (int n = 0; n < 2; ++n) acc[a][b][m][n] = (f32x4){0.f, 0.f, 0.f, 0.f};
        cur = nxt; cA = nA; cB = nB; ++ui;
        if constexpr (ALIGN_EPI) { if (wr == 1) PG8_BAR; }
    }
    PG8_WAIT_V(0);
    if constexpr (!ALIGN_EPI) { if (wr == 0) PG8_BAR; }
    PG8_BAR;
    if constexpr (Epi::AFTER_DRAIN) { E.fused(acc, cur, wr, wc, fr, fq, lds, wid, lane); S.done(cur); }
#undef PG8_SA
#undef PG8_SB
#undef PG8_STAGE
#undef PG8_LDA
#undef PG8_LDB
#undef PG8_MMA
#undef PG8_WAIT_V
#undef PG8_WAIT_L
#undef PG8_BAR
#undef PG8_SCHED
}
}
#include <hip/hip_bf16.h>
#include <cmath>
namespace attn_body {
using bf16=__hip_bfloat16;
using bf16x8=__attribute__((ext_vector_type(8)))short;
using s16x4=__attribute__((ext_vector_type(4)))short;
using f32x16=__attribute__((ext_vector_type(16)))float;
using u32x4=__attribute__((ext_vector_type(4)))unsigned;
constexpr int D=64;
constexpr int NW=8,QBLK=32,QB=QBLK*NW,KVBLK=64;
__device__ __forceinline__ int crow(int r,int hi){return (r&3)+8*(r>>2)+4*hi;}
#define SBAR() __builtin_amdgcn_sched_barrier(0)
__device__ __forceinline__ void cmask(f32x16&p0,f32x16&p1,int jb,int qrel,int hi){
  const float NEG=-INFINITY; int kb=64*jb+4*hi;
  #pragma unroll
  for(int r=0;r<16;++r){int kv=kb+(r&3)+8*(r>>2); if(kv>qrel)p0[r]=NEG; if(kv+32>qrel)p1[r]=NEG;}
}

constexpr int NSLOT=3, SLOTB=8192;
constexpr int LDS_K=0, LDS_V=NSLOT*SLOTB, LDS_WS=2*NSLOT*SLOTB, LDS_OST=LDS_WS+NW*64*4, LDS_BYTES=LDS_OST+NW*4096;
constexpr float C2=0.125f*1.4426950408889634f;
__device__ __forceinline__ void glds16(const void*gsrc,unsigned lds_dst){unsigned keep;
  asm volatile("s_mov_b32 %0, m0\n\ts_mov_b32 m0, %2\n\ts_nop 0\n\tglobal_load_lds_dwordx4 %1, off\n\ts_mov_b32 m0, %0":"=&s"(keep):"v"(gsrc),"s"(lds_dst):"memory");}
__device__ __forceinline__ float max3f(float a,float b,float c){float r;asm("v_max3_f32 %0, %1, %2, %3":"=v"(r):"v"(a),"v"(b),"v"(c));return r;}
__device__ __forceinline__ float max2f(float a,float b){float r;asm("v_max_f32_e32 %0, %1, %2":"=v"(r):"v"(a),"v"(b));return r;}
__device__ __forceinline__ float fadd_s(float a,float b){float r;asm("v_add_f32_e32 %0, %1, %2":"=v"(r):"v"(a),"v"(b));return r;}
__device__ __forceinline__ float fsub_s(float a,float b){float r;asm("v_sub_f32_e32 %0, %1, %2":"=v"(r):"v"(a),"v"(b));return r;}
typedef float f32x2_t __attribute__((ext_vector_type(2))); typedef __bf16 bf16x2_t __attribute__((ext_vector_type(2)));
__device__ __forceinline__ unsigned cvtpk_s(float lo,float hi){f32x2_t v={lo,hi};bf16x2_t b=__builtin_convertvector(v,bf16x2_t);return __builtin_bit_cast(unsigned,b);}
#define WAIT_BAR(N) asm volatile("s_waitcnt vmcnt(" #N ") lgkmcnt(0)\n\ts_barrier":::"memory")

__device__ __forceinline__ void qkt(f32x16&p0,f32x16&p1,const char*Kslot,const bf16x8*qr,const f32x16&negm,int r32,int hi){
  const char*kb=Kslot+hi*1024+r32*16;
  #pragma unroll
  for(int d0=0;d0<4;++d0){
    const bf16x8 b0=*reinterpret_cast<const bf16x8*>(kb+d0*2048);
    const bf16x8 b1=*reinterpret_cast<const bf16x8*>(kb+d0*2048+512);
    if(d0==0){p0=__builtin_amdgcn_mfma_f32_32x32x16_bf16(b0,qr[0],negm,0,0,0);p1=__builtin_amdgcn_mfma_f32_32x32x16_bf16(b1,qr[0],negm,0,0,0);}
    else{p0=__builtin_amdgcn_mfma_f32_32x32x16_bf16(b0,qr[d0],p0,0,0,0);p1=__builtin_amdgcn_mfma_f32_32x32x16_bf16(b1,qr[d0],p1,0,0,0);}}
}
typedef __attribute__((address_space(3))) const char* lds_cptr;
typedef short v4i16_t __attribute__((ext_vector_type(4)));
__device__ __forceinline__ void kload8(bf16x8*kf,lds_cptr kp){
  kf[0]=*(const __attribute__((address_space(3))) bf16x8*)(kp);      kf[1]=*(const __attribute__((address_space(3))) bf16x8*)(kp+512);
  kf[2]=*(const __attribute__((address_space(3))) bf16x8*)(kp+2048); kf[3]=*(const __attribute__((address_space(3))) bf16x8*)(kp+2560);
  kf[4]=*(const __attribute__((address_space(3))) bf16x8*)(kp+4096); kf[5]=*(const __attribute__((address_space(3))) bf16x8*)(kp+4608);
  kf[6]=*(const __attribute__((address_space(3))) bf16x8*)(kp+6144); kf[7]=*(const __attribute__((address_space(3))) bf16x8*)(kp+6656);
}
__device__ __forceinline__ void kload2(bf16x8*kf,lds_cptr kp,int j){ kf[2*j]=*(const __attribute__((address_space(3))) bf16x8*)(kp+j*2048); kf[2*j+1]=*(const __attribute__((address_space(3))) bf16x8*)(kp+j*2048+512); }
__device__ __forceinline__ s16x4 vtr(lds_cptr p){ return __builtin_bit_cast(s16x4,__builtin_amdgcn_ds_read_tr16_b64_v4i16((__attribute__((address_space(3))) v4i16_t*)p)); }
__device__ __forceinline__ float rowmax(const f32x16&p0,const f32x16&p1){
  float a=max3f(p0[0],p0[1],p1[0]),b=max3f(p0[2],p0[3],p1[1]);a=max3f(a,p1[2],p1[3]);
  #pragma unroll
  for(int r=4;r<16;r+=4){a=max3f(a,p0[r],p0[r+1]);b=max3f(b,p0[r+2],p0[r+3]);a=max3f(a,p1[r],p1[r+1]);b=max3f(b,p1[r+2],p1[r+3]);}
  const float m=max2f(a,b);
  auto rr=__builtin_amdgcn_permlane32_swap(__float_as_uint(m),__float_as_uint(m),false,false);
  return max2f(__uint_as_float(rr[0]),__uint_as_float(rr[1]));
}
__device__ __forceinline__ void pv(f32x16*o,int vb,bf16x8 pa0,bf16x8 pa1,bf16x8 pa2,bf16x8 pa3){
  #pragma unroll
  for(int d0=0;d0<2;++d0){s16x4 lo[4],hi[4];
    #pragma unroll
    for(int ks=0;ks<4;++ks){
      asm volatile("ds_read_b64_tr_b16 %0,%1 offset:%c2":"=&v"(lo[ks]):"v"(vb),"i"(d0*4096+ks*1024):"memory");
      asm volatile("ds_read_b64_tr_b16 %0,%1 offset:%c2":"=&v"(hi[ks]):"v"(vb),"i"(d0*4096+ks*1024+512):"memory");}
    asm volatile("s_waitcnt lgkmcnt(0)":::"memory");SBAR();
    #define PK(k) (bf16x8){lo[k][0],lo[k][1],lo[k][2],lo[k][3],hi[k][0],hi[k][1],hi[k][2],hi[k][3]}
    o[d0]=__builtin_amdgcn_mfma_f32_32x32x16_bf16(pa0,PK(0),o[d0],0,0,0);
    o[d0]=__builtin_amdgcn_mfma_f32_32x32x16_bf16(pa1,PK(1),o[d0],0,0,0);
    o[d0]=__builtin_amdgcn_mfma_f32_32x32x16_bf16(pa2,PK(2),o[d0],0,0,0);
    o[d0]=__builtin_amdgcn_mfma_f32_32x32x16_bf16(pa3,PK(3),o[d0],0,0,0);
    #undef PK
  }
}

#ifndef ATTN_STORE16
#define ATTN_STORE16(p,v) (*(u32x4*)(p)=(v))
#endif
template<int THRL,bool NOMAX> __device__ __forceinline__ void attn_unit(const int b,const int NT,const bf16*Qw0,const int qpitch,const bf16*__restrict__ Kh,const bf16*__restrict__ Vh,const int kvpitch,bf16*Ow0,const int opitch,char*shm){
  const int tid=tid_fresh(),lane=tid&63,r32=lane&31,hi=lane>>5; const int wid=__builtin_amdgcn_readfirstlane(tid>>6);
  const bf16*Qw=Qw0+(long)(wid*QBLK)*qpitch;
  const unsigned lds0=(unsigned)(uintptr_t)shm;
  float*wsf=(float*)(shm+LDS_WS)+wid*64;
  const bf16*ksrc=Kh+(long)lane*kvpitch+wid*8;
  const bf16*vsrc=Vh+(long)(16*(wid&3)+(lane>>2))*kvpitch+(wid>>2)*32+(lane&3)*8;
  const unsigned kdst=lds0+LDS_K+wid*1024, vdst=lds0+LDS_V+wid*1024;
  #define KROW(t) ((long)((t)<4 ? b*256+64*(t) : 2048+b*4096+64*((t)-4)))
  #define DMA_K(t,slot) glds16(ksrc+KROW(t)*kvpitch,(unsigned)__builtin_amdgcn_readfirstlane(kdst+(slot)))
  #define DMA_V(t,slot) glds16(vsrc+KROW(t)*kvpitch,(unsigned)__builtin_amdgcn_readfirstlane(vdst+(slot)))
  const int vb0=(int)(lds0+LDS_V)+((lane>>4)&1)*32+(lane&3)*8+(4*hi+((lane&15)>>2))*64;
  const char*Kbase=shm+LDS_K; bf16x8 kf[8];
  const lds_cptr shm3=(lds_cptr)shm; const lds_cptr kp0=shm3+LDS_K+hi*1024+r32*16; const lds_cptr vp0=shm3+LDS_V+((lane>>4)&1)*32+(lane&3)*8+(4*hi+((lane&15)>>2))*64;
  DMA_K(0,0);DMA_V(0,0);DMA_K(1,SLOTB);
  bf16x8 qr[4];
  #pragma unroll
  for(int d0=0;d0<4;++d0)qr[d0]=*reinterpret_cast<const bf16x8*>(&Qw[(long)r32*qpitch+d0*16+hi*8]);
  float mhat=0.f,l_reg=0.f;f32x16 o[2];o[0]=f32x16{};o[1]=f32x16{};f32x16 negm=f32x16{};asm volatile("":"+v"(negm));
  #define CMASK(P0,P1,t) do{}while(0)
  bool resc=false;
  #define START(P0,P1) do{ const float rm=rowmax(P0,P1); resc=false; \
    { const float dl=rm; mhat=fadd_s(mhat,dl); \
      _Pragma("unroll") for(int r=0;r<16;++r){P0[r]=fsub_s(P0[r],dl);P1[r]=fsub_s(P1[r],dl);} \
      _Pragma("unroll") for(int r=0;r<16;++r)negm[r]=-mhat; asm volatile("":"+v"(negm)); } \
    _Pragma("unroll") for(int r=0;r<16;++r)P0[r]=__builtin_amdgcn_exp2f(P0[r]); }while(0)
  #define RESC() do{ if(resc){ asm volatile("s_waitcnt lgkmcnt(0)":::"memory"); \
      _Pragma("unroll") for(int d_=0;d_<2;++d_) _Pragma("unroll") for(int r=0;r<16;++r)o[d_][r]*=wsf[crow(r,hi)]; } }while(0)
  f32x16 pA0,pA1,pB0,pB1;
  int sl_prev=0,sl_cur=0,sl_next=SLOTB;
  #define ROT() do{sl_prev=sl_cur;sl_cur=sl_next;sl_next=(sl_next==(NSLOT-1)*SLOTB)?0:sl_next+SLOTB;}while(0)
  DMA_K(2,2*SLOTB);
  WAIT_BAR(3);
  qkt(pA0,pA1,Kbase,qr,negm,r32,hi);asm volatile("s_nop 15\n\ts_nop 7":"+v"(pA0),"+v"(pA1));CMASK(pA0,pA1,0);
  START(pA0,pA1);
  _Pragma("unroll") for(int r=0;r<16;++r)pA1[r]=__builtin_amdgcn_exp2f(pA1[r]);
  WAIT_BAR(0);
  DMA_K(3,0);DMA_V(1,SLOTB);
  ROT();
  kload8(kf,kp0+sl_cur);
  WAIT_BAR(2);
  s16x4 vlo[8],vhi[8]; u32x4 pw0,pw1,pw2,pw3;
  #define PKW(P,B) cvtpk_s(P[B],P[B+1])
  #define PAF(k) __builtin_bit_cast(bf16x8,pw##k)
  #define VFR(i) (bf16x8){vlo[i][0],vlo[i][1],vlo[i][2],vlo[i][3],vhi[i][0],vhi[i][1],vhi[i][2],vhi[i][3]}
  #define PIN(x) asm volatile("":"+v"(x))
  #define MX3(a,b,c) __builtin_fmaxf(__builtin_fmaxf((a),(b)),(c))
  #define GAPA(MF,A0,A1,A2,A3,W0,W1,PW) do{ MF; sacc+=A0; sacc+=A1; sacc+=A2; sacc+=A3; PIN(sacc); W0; W1; PIN(PW); SBAR(); }while(0)
  #define EX(v) __builtin_amdgcn_exp2f(v)
  #define GAPB(MF,X,B) do{ MF; X[B]=EX(X[B]); X[B+1]=EX(X[B+1]); X[B+2]=EX(X[B+2]); X[B+3]=EX(X[B+3]); PIN(X); SBAR(); }while(0)
  #define VRD(i) do{ vlo[i]=vtr(vp_+(((i)>>2)*4096+((i)&3)*1024)); vhi[i]=vtr(vp_+(((i)>>2)*4096+((i)&3)*1024+512)); }while(0)
  #define KRD(G,j) do{ if(G){ kload2(kf,kp0+sl_next,j); SBAR(); } }while(0)
  #define STEP(C0,C1,P0,P1,t,GK,GV,GL) do{ SBAR(); \
    const lds_cptr vp_=vp0+sl_prev; \
    VRD(0); SBAR(); float sacc=(P0[0]+P0[1]); \
    GAPA(C0=__builtin_amdgcn_mfma_f32_32x32x16_bf16(kf[0],qr[0],negm,0,0,0), P0[2],P0[3],P0[4],P0[5],     pw0[0]=PKW(P0,0), pw0[1]=PKW(P0,2), pw0); \
    VRD(4); SBAR(); GAPA(C1=__builtin_amdgcn_mfma_f32_32x32x16_bf16(kf[1],qr[0],negm,0,0,0), P0[6],P0[7],P0[8],P0[9],     pw0[2]=PKW(P0,4), pw0[3]=PKW(P0,6), pw0); \
    VRD(1); SBAR(); GAPA(C0=__builtin_amdgcn_mfma_f32_32x32x16_bf16(kf[2],qr[1],C0,0,0,0),   P0[10],P0[11],P0[12],P0[13], pw1[0]=PKW(P0,8), pw1[1]=PKW(P0,10), pw1); \
    VRD(5); SBAR(); GAPA(C1=__builtin_amdgcn_mfma_f32_32x32x16_bf16(kf[3],qr[1],C1,0,0,0),   P0[14],P0[15],P1[0],P1[1],   pw1[2]=PKW(P0,12),pw1[3]=PKW(P0,14), pw1); \
    VRD(2); SBAR(); GAPA(C0=__builtin_amdgcn_mfma_f32_32x32x16_bf16(kf[4],qr[2],C0,0,0,0),   P1[2],P1[3],P1[4],P1[5],     pw2[0]=PKW(P1,0), pw2[1]=PKW(P1,2), pw2); \
    VRD(6); SBAR(); GAPA(C1=__builtin_amdgcn_mfma_f32_32x32x16_bf16(kf[5],qr[2],C1,0,0,0),   P1[6],P1[7],P1[8],P1[9],     pw2[2]=PKW(P1,4), pw2[3]=PKW(P1,6), pw2); \
    VRD(3); SBAR(); GAPA(C0=__builtin_amdgcn_mfma_f32_32x32x16_bf16(kf[6],qr[3],C0,0,0,0),   P1[10],P1[11],P1[12],P1[13], pw3[0]=PKW(P1,8), pw3[1]=PKW(P1,10), pw3); \
    VRD(7); SBAR(); GAPA(C1=__builtin_amdgcn_mfma_f32_32x32x16_bf16(kf[7],qr[3],C1,0,0,0),   P1[14],P1[15],0.f,0.f,       pw3[2]=PKW(P1,12),pw3[3]=PKW(P1,14), pw3); \
    l_reg+=sacc; \
    if(GK){DMA_K((t)+3,sl_cur);} if(GV){DMA_V((t)+1,sl_next);} \
    CMASK(C0,C1,t); \
    if(NOMAX){ resc=false; } else { float a=MX3(C0[0],C0[1],C1[0]),b=MX3(C0[2],C0[3],C1[1]); a=MX3(a,C1[2],C1[3]); \
      _Pragma("unroll") for(int r=4;r<16;r+=4){a=MX3(a,C0[r],C0[r+1]);b=MX3(b,C0[r+2],C0[r+3]);a=MX3(a,C1[r],C1[r+1]);b=MX3(b,C1[r+2],C1[r+3]);} \
      float rm=__builtin_fmaxf(a,b); { auto rr=__builtin_amdgcn_permlane32_swap(__float_as_uint(rm),__float_as_uint(rm),false,false); rm=__builtin_fmaxf(__uint_as_float(rr[0]),__uint_as_float(rr[1])); } \
      resc=false; \
      if(__builtin_expect(__any(rm>(float)THRL),0)){ const float dl=__builtin_fmaxf(rm,0.f); mhat+=dl; \
        _Pragma("unroll") for(int r=0;r<16;++r){C0[r]-=dl;C1[r]-=dl;} \
        _Pragma("unroll") for(int r=0;r<16;++r)negm[r]=-mhat; asm volatile("":"+v"(negm)); \
        const float f=__builtin_amdgcn_exp2f(-dl); l_reg*=f; if(hi==0)wsf[r32]=f; resc=true; } } \
    SBAR(); \
    GAPB(o[0]=__builtin_amdgcn_mfma_f32_32x32x16_bf16(PAF(0),VFR(0),o[0],0,0,0), C0,0); \
    GAPB(o[1]=__builtin_amdgcn_mfma_f32_32x32x16_bf16(PAF(0),VFR(4),o[1],0,0,0), C0,4); \
    KRD(GL,0); GAPB(o[0]=__builtin_amdgcn_mfma_f32_32x32x16_bf16(PAF(1),VFR(1),o[0],0,0,0), C0,8); \
    KRD(GL,1); GAPB(o[1]=__builtin_amdgcn_mfma_f32_32x32x16_bf16(PAF(1),VFR(5),o[1],0,0,0), C0,12); \
    KRD(GL,2); GAPB(o[0]=__builtin_amdgcn_mfma_f32_32x32x16_bf16(PAF(2),VFR(2),o[0],0,0,0), C1,0); \
    KRD(GL,3); GAPB(o[1]=__builtin_amdgcn_mfma_f32_32x32x16_bf16(PAF(2),VFR(6),o[1],0,0,0), C1,4); \
    GAPB(o[0]=__builtin_amdgcn_mfma_f32_32x32x16_bf16(PAF(3),VFR(3),o[0],0,0,0), C1,8); \
    GAPB(o[1]=__builtin_amdgcn_mfma_f32_32x32x16_bf16(PAF(3),VFR(7),o[1],0,0,0), C1,12); \
    }while(0)
  int t=1;
  #undef CMASK
  #define CMASK(P0,P1,t) do{}while(0)
  for(;t+5<NT;t+=2){
    STEP(pB0,pB1,pA0,pA1,t,true,true,true);     WAIT_BAR(2); RESC(); ROT();
    STEP(pA0,pA1,pB0,pB1,t+1,true,true,true);   WAIT_BAR(2); RESC(); ROT();
  }
  #undef CMASK
  #define CMASK(P0,P1,t) do{}while(0)
  #define ENDW(tt) do{ if((tt)+3<NT){WAIT_BAR(2);} else if((tt)+2<NT){WAIT_BAR(1);} else {WAIT_BAR(0);} }while(0)
  for(;t+1<NT;t+=2){
    STEP(pB0,pB1,pA0,pA1,t,(t+3<NT),(t+1<NT),(t+1<NT));       ENDW(t);   RESC(); ROT();
    STEP(pA0,pA1,pB0,pB1,t+1,(t+4<NT),(t+2<NT),(t+2<NT));     ENDW(t+1); RESC(); ROT();
  }
  STEP(pB0,pB1,pA0,pA1,NT-1,false,false,false); RESC();
  { float sacc=pB0[0]+pB0[1]; _Pragma("unroll") for(int r=2;r<16;++r)sacc+=pB0[r]; _Pragma("unroll") for(int r=0;r<16;++r)sacc+=pB1[r]; l_reg+=sacc;
    pw0=(u32x4){PKW(pB0,0),PKW(pB0,2),PKW(pB0,4),PKW(pB0,6)};pw1=(u32x4){PKW(pB0,8),PKW(pB0,10),PKW(pB0,12),PKW(pB0,14)};pw2=(u32x4){PKW(pB1,0),PKW(pB1,2),PKW(pB1,4),PKW(pB1,6)};pw3=(u32x4){PKW(pB1,8),PKW(pB1,10),PKW(pB1,12),PKW(pB1,14)};
    SBAR(); pv(o,vb0+sl_cur,PAF(0),PAF(1),PAF(2),PAF(3)); }
  #undef PKW
  #undef PAF
  #undef VFR
  #undef PIN
  #undef MX3
  #undef GAPA
  #undef GAPB
  #undef EX
  #undef VRD
  #undef KRD
  #undef STEP
  #undef ENDW
  {auto rr=__builtin_amdgcn_permlane32_swap(__float_as_uint(l_reg),__float_as_uint(l_reg),false,false);l_reg=__uint_as_float(rr[0])+__uint_as_float(rr[1]);}
  if(hi==0)wsf[32+r32]=l_reg;asm volatile("s_waitcnt lgkmcnt(0)":::"memory");
  float rli[16];
  #pragma unroll
  for(int r=0;r<16;++r)rli[r]=__builtin_amdgcn_rcpf(wsf[32+crow(r,hi)]);
  bf16*Ow=Ow0+(long)(wid*QBLK)*opitch;
  { bf16*stg=(bf16*)(shm+LDS_OST)+wid*2048;
    #pragma unroll
    for(int r=0;r<16;++r){const int orow=crow(r,hi);
      #pragma unroll
      for(int d0=0;d0<2;++d0)stg[orow*64+d0*32+r32]=__float2bfloat16(o[d0][r]*rli[r]);}
    asm volatile("s_waitcnt lgkmcnt(0)":::"memory");
    #pragma unroll
    for(int i=0;i<4;++i){const int row=i*8+(lane>>3),ch=lane&7; const u32x4 v=*(const u32x4*)(stg+row*64+ch*8); ATTN_STORE16(Ow+(long)row*opitch+ch*8,v);} }
  asm volatile("s_waitcnt lgkmcnt(0)\n\ts_barrier":::"memory");
  #undef DMA_K
  #undef KROW
  #undef DMA_V
  #undef CMASK
  #undef START
  #undef RESC
  #undef ROT
}
constexpr int ATTN_LDS_BYTES=LDS_BYTES;
#undef SBAR
#undef WAIT_BAR
}
#define LAS __attribute__((address_space(3)))
typedef unsigned short bfs;
typedef float f32x4 __attribute__((ext_vector_type(4)));
typedef float f32x16 __attribute__((ext_vector_type(16)));
typedef unsigned u32x4 __attribute__((ext_vector_type(4)));
typedef unsigned u32x2 __attribute__((ext_vector_type(2)));
typedef short s16x8 __attribute__((ext_vector_type(8)));
constexpr int DM = 1024, NB = 8, SEQ = 4096, NCTX = 256;
constexpr int RCTX = NB * NCTX, RLAT = NB * SEQ, ROWS = RCTX + RLAT;
constexpr int DFF = 2816, NGU = 2 * DFF;
constexpr int NIN0 = 2336, PIN0 = 2560, NIN1 = 5120;
constexpr int C_GQ = 0, C_GK = 256, C_GV = 512, C_GOG = 1024, C_GZ = 1536, C_AQ = 1568, C_AK = 2080, C_AV = 2208;
constexpr int C_FQ = 0, C_FF = 1024, C_FI = 3072, C_FOG = 4096;
constexpr float RMS_EPS = 1e-6f;
constexpr size_t MiB = 1u << 20;
constexpr size_t WS_CTL = 0, CTL_BYTES = 65536;
constexpr size_t WS_MOD = 1 * MiB;
constexpr size_t WS_LB = WS_MOD + 896 * 1024;
constexpr int MODH = 2 * 9 * 6144;
constexpr size_t WS_XCTX = 2 * MiB;
constexpr size_t WS_WIN0 = 10 * MiB, WS_WOUT0 = 15 * MiB, WS_WGU0 = 17 * MiB, WS_WD0 = 28 * MiB;
constexpr size_t WS_WIN1 = 34 * MiB, WS_WOUT1 = 44 * MiB, WS_WGU1 = 46 * MiB, WS_WD1 = 57 * MiB;
constexpr size_t WS_C = 64 * MiB;
constexpr size_t WS_D = 132 * MiB;
constexpr size_t WS_Y = WS_D + 192 * MiB;
constexpr size_t WS_E0 = WS_D + 260 * MiB;
constexpr size_t WS_END = WS_D + 340 * MiB + 40 * MiB;
constexpr int OSPLIT = 16384;
static_assert(WS_WD1 + (size_t)DM * DFF * 2 <= WS_C && WS_C + (size_t)ROWS * DM * 2 <= WS_D && (size_t)ROWS * DFF * 2 <= 192 * MiB && (size_t)ROWS * NIN1 * 2 <= 340 * MiB, "ws map");
constexpr int LDS_CTL_OFF = 153600, LDS_BYTES = 154112;
constexpr int NWAVES = 8, NTHR = 512;

__device__ __forceinline__ float bf2f(unsigned h) { return __uint_as_float(h << 16); }
__device__ __forceinline__ unsigned f2bf(float f) { unsigned u = __float_as_uint(f); return (u + 0x7fffu + ((u >> 16) & 1u)) >> 16; }
__device__ __forceinline__ unsigned pk2(float lo, float hi) { return pg8::cvt_pk_bf16(lo, hi); }
__device__ __forceinline__ float dpp_ror(float x, const int n) {
    switch (n) {
    case 8: return __int_as_float(__builtin_amdgcn_update_dpp(0, __float_as_int(x), 0x128, 0xf, 0xf, false));
    case 4: return __int_as_float(__builtin_amdgcn_update_dpp(0, __float_as_int(x), 0x124, 0xf, 0xf, false));
    case 2: return __int_as_float(__builtin_amdgcn_update_dpp(0, __float_as_int(x), 0x122, 0xf, 0xf, false));
    default: return __int_as_float(__builtin_amdgcn_update_dpp(0, __float_as_int(x), 0x121, 0xf, 0xf, false));
    }
}
__device__ __forceinline__ float wave_sum(float v) {
    v += dpp_ror(v, 8); v += dpp_ror(v, 4); v += dpp_ror(v, 2); v += dpp_ror(v, 1);
    const int vi = __float_as_int(v);
    const float r0 = __int_as_float(__builtin_amdgcn_readlane(vi, 0)), r1 = __int_as_float(__builtin_amdgcn_readlane(vi, 16)), r2 = __int_as_float(__builtin_amdgcn_readlane(vi, 32)), r3 = __int_as_float(__builtin_amdgcn_readlane(vi, 48));
    return (r0 + r1) + (r2 + r3);
}
__device__ __forceinline__ float siluf(float x) { return x * __builtin_amdgcn_rcpf(1.f + __expf(-x)); }

struct Args { const float* in[24]; float* out; unsigned char* ws; };

__device__ __forceinline__ void p0_transpose_item(const float* W, int K, int N, bfs* WT, int k0, int n0, int drow0, LAS float* scr, int lane) {
    float tv[32];
#pragma unroll
    for (int i = 0; i < 32; ++i) tv[i] = W[(size_t)(k0 + 2 * i + (lane >> 5)) * N + n0 + (lane & 31)];
#pragma unroll
    for (int i = 0; i < 32; ++i) scr[(2 * i + (lane >> 5)) * 33 + (lane & 31)] = tv[i];
    asm volatile("s_waitcnt lgkmcnt(0)" ::: "memory");
    const int c = lane & 7;
#pragma unroll
    for (int j = 0; j < 4; ++j) { const int n = (lane >> 3) + 8 * j; const LAS float* s = scr + (8 * c) * 33 + n;
        u32x4 o; o.x = pk2(s[0 * 33], s[1 * 33]); o.y = pk2(s[2 * 33], s[3 * 33]); o.z = pk2(s[4 * 33], s[5 * 33]); o.w = pk2(s[6 * 33], s[7 * 33]);
        *(u32x4*)(WT + (size_t)(drow0 + n) * K + k0 + 8 * c) = o; }
    asm volatile("s_waitcnt lgkmcnt(0)" ::: "memory");
}
__device__ __forceinline__ bool p0_try(int& r, const float* W, int K, int N, bfs* WT, int mode  , LAS float* scr, int lane) {
    const int nblk = N / 32, cnt = (K / 64) * nblk;
    if (r >= cnt) { r -= cnt; return false; }
    const int kb = r / nblk, nb = r % nblk, n0 = 32 * nb;
    const int drow0 = mode == 0 ? n0 : ((n0 >> 7) * 256 + (n0 & 127) + (mode == 2 ? 128 : 0));
    p0_transpose_item(W, K, N, WT, 64 * kb, n0, drow0, scr, lane);
    return true;
}
constexpr int P0_I_IN0 = 16 * (NIN0 / 32), P0_I_SQ = 16 * 32, P0_I_G = 16 * (DFF / 32), P0_I_D = (DFF / 64) * 32, P0_I_IN1 = 16 * (NIN1 / 32);
constexpr int P0_NA = P0_I_IN0 + P0_I_SQ + 2 * P0_I_G + P0_I_D + P0_I_IN1, P0_NITEMS = P0_NA + P0_I_SQ + 2 * P0_I_G + P0_I_D;
__device__ __forceinline__ void p0_weights(const Args& a, LAS unsigned char* lds, int it_lo, int it_hi, int gw, int NGW) {
    const int tid = tid_fresh(), lane = tid & 63, wave = tid >> 6;
    unsigned char* ws = a.ws;
    LAS float* scr = (LAS float*)(lds + wave * 16384);
    for (int it = it_lo + gw; it < it_hi; it += NGW) {
        int r = it;
        if (p0_try(r, a.in[10], 1024, NIN0, (bfs*)(ws + WS_WIN0), 0, scr, lane)) continue;
        if (p0_try(r, a.in[16], 1024, 1024, (bfs*)(ws + WS_WOUT0), 0, scr, lane)) continue;
        if (p0_try(r, a.in[21], 1024, DFF, (bfs*)(ws + WS_WGU0), 1, scr, lane)) continue;
        if (p0_try(r, a.in[22], 1024, DFF, (bfs*)(ws + WS_WGU0), 2, scr, lane)) continue;
        if (p0_try(r, a.in[23], DFF, 1024, (bfs*)(ws + WS_WD0), 0, scr, lane)) continue;
        if (p0_try(r, a.in[17], 1024, NIN1, (bfs*)(ws + WS_WIN1), 0, scr, lane)) continue;
        if (p0_try(r, a.in[20], 1024, 1024, (bfs*)(ws + WS_WOUT1), 0, scr, lane)) continue;
        if (p0_try(r, a.in[21] + (size_t)1024 * DFF, 1024, DFF, (bfs*)(ws + WS_WGU1), 1, scr, lane)) continue;
        if (p0_try(r, a.in[22] + (size_t)1024 * DFF, 1024, DFF, (bfs*)(ws + WS_WGU1), 2, scr, lane)) continue;
        p0_try(r, a.in[23] + (size_t)DFF * 1024, DFF, 1024, (bfs*)(ws + WS_WD1), 0, scr, lane);
    }
}
__device__ __forceinline__ void p0_phase(const Args& a, LAS unsigned char* lds, int G) {
    const int tid = tid_fresh(), lane = tid & 63, wave = tid >> 6;
    unsigned char* ws = a.ws;
    {
        LAS float* sc = (LAS float*)lds;
        LAS float* red = (LAS float*)(lds + 40960);
        for (int i = tid; i < 9 * 1024; i += NTHR) { const float v = i < 8192 ? a.in[1][i] : a.in[3][i - 8192]; sc[i] = siluf(v); }
        __syncthreads();
        float* MOD = (float*)(ws + WS_MOD);
        for (int it = blockIdx.x; it < 96; it += G) {
            const int l = it / 48, rr = it % 48, strip = rr >> 1, kh = rr & 1;
            const int kbase = 512 * kh + 64 * wave;
            const float* w = a.in[4] + (size_t)l * 1024 * 6144 + (size_t)kbase * 6144 + 256 * strip + 4 * lane;
            f32x4 acc[9];
#pragma unroll
            for (int bb = 0; bb < 9; ++bb) acc[bb] = (f32x4){0.f, 0.f, 0.f, 0.f};
            for (int k0 = 0; k0 < 64; k0 += 16) {
                f32x4 wv[16];
#pragma unroll
                for (int j = 0; j < 16; ++j) wv[j] = *(const f32x4*)(w + (size_t)(k0 + j) * 6144);
#pragma unroll
                for (int j = 0; j < 16; ++j)
#pragma unroll
                    for (int bb = 0; bb < 9; ++bb) acc[bb] = acc[bb] + wv[j] * sc[bb * 1024 + kbase + k0 + j];
            }
#pragma unroll
            for (int bb = 0; bb < 9; ++bb) *(LAS f32x4*)(red + (wave * 9 + bb) * 256 + 4 * lane) = acc[bb];
            __syncthreads();
            for (int i = tid; i < 9 * 256; i += NTHR) { float sum = 0.f;
#pragma unroll
                for (int w8 = 0; w8 < 8; ++w8) sum += red[w8 * 2304 + i];
                const int bb = i >> 8, c = 256 * strip + (i & 255);
                MOD[(size_t)kh * MODH + ((size_t)l * 9 + bb) * 6144 + c] = sum + (kh == 0 ? a.in[5][l * 6144 + c] : 0.f); }
            __syncthreads();
        }
        float* LB = (float*)(ws + WS_LB);
        for (int i = blockIdx.x * NTHR + tid; i < 2048; i += G * NTHR) { const int d = i >> 10, f = i & 1023; const float x0 = a.in[18][d * 2048 + f], x1 = a.in[18][d * 2048 + 1024 + f]; LB[i] = 1.f / (1.f + __expf(x0 - x1)); }
        { u32x4* z = (u32x4*)(ws + WS_WIN0 + (size_t)NIN0 * 1024 * 2); const int n16 = (PIN0 - NIN0) * 1024 * 2 / 16;
          for (int i = blockIdx.x * NTHR + tid; i < n16; i += G * NTHR) z[i] = (u32x4){0u, 0u, 0u, 0u}; }
        __syncthreads();
    }
    if (G >= 256) { const int nslot = 96 * NWAVES + (G - 96) * NWAVES * 2;
        if (blockIdx.x < 96) p0_weights(a, lds, 0, P0_NA, blockIdx.x * NWAVES + wave, nslot);
        else { const int s0 = 96 * NWAVES + (((int)blockIdx.x - 96) * NWAVES + wave) * 2; p0_weights(a, lds, 0, P0_NA, s0, nslot); p0_weights(a, lds, 0, P0_NA, s0 + 1, nslot); } }
    else p0_weights(a, lds, 0, P0_NITEMS, blockIdx.x * NWAVES + wave, G * NWAVES);
}

struct RowOp {
    const void* xin_lat; const void* xin_ctx; void* xout_lat; void* xout_ctx;
    const bfs* y; const float* gpost; const float* modg; int gate_idx;
    bfs* h; const float* gpre; const float* modh; int shift_idx, scale_idx;
    int row_lo; int xin_bf, xout_bf;
};
__device__ __forceinline__ void row_phase(const RowOp op, int G, int row_lo_ = -1, int row_hi_ = ROWS, int blk_ = -1, int nblk_ = 0) {
    const int tid_ = tid_fresh(); const int lane = tid_ & 63, wave = tid_ >> 6;
    const int rlo = row_lo_ < 0 ? op.row_lo : row_lo_;
    const int gw = (blk_ < 0 ? (int)blockIdx.x : blk_) * NWAVES + wave, NGW = (blk_ < 0 ? G : nblk_) * NWAVES;
    const int rpw = (row_hi_ - rlo + NGW - 1) / NGW;
    const int r0 = rlo + gw * rpw, r1 = (r0 + rpw < row_hi_) ? r0 + rpw : row_hi_;
    if (r0 >= r1) return;
    f32x4 gp[4], gpre[4], gt[4], sh[4], sc[4];
#pragma unroll
    for (int j = 0; j < 4; ++j) { const int c = 4 * lane + 256 * j; gp[j] = op.y ? *(const f32x4*)(op.gpost + c) : (f32x4){0.f, 0.f, 0.f, 0.f}; gpre[j] = op.h ? *(const f32x4*)(op.gpre + c) : (f32x4){0.f, 0.f, 0.f, 0.f};
        gt[j] = sh[j] = sc[j] = (f32x4){0.f, 0.f, 0.f, 0.f}; }
    int cur_bb = -1;
    f32x4 xn[4]; u32x2 xnb[4], yn[4];
#pragma unroll
    for (int j = 0; j < 4; ++j) { xn[j] = (f32x4){0.f, 0.f, 0.f, 0.f}; xnb[j] = (u32x2){0u, 0u}; }
#define ROW_LOAD(r) do { const bool ic_ = (r) < RCTX; const size_t ro_ = ic_ ? (size_t)(r) * DM : (size_t)((r) - RCTX) * DM; const void* xb_ = ic_ ? op.xin_ctx : op.xin_lat; \
        if (op.xin_bf) { _Pragma("unroll") for (int j = 0; j < 4; ++j) xnb[j] = __builtin_nontemporal_load((const u32x2*)((const bfs*)xb_ + ro_ + 4 * lane + 256 * j)); } \
        else { _Pragma("unroll") for (int j = 0; j < 4; ++j) xn[j] = __builtin_nontemporal_load((const f32x4*)((const float*)xb_ + ro_ + 4 * lane + 256 * j)); } \
        _Pragma("unroll") for (int j = 0; j < 4; ++j) yn[j] = op.y ? __builtin_nontemporal_load((const u32x2*)(op.y + (size_t)(r) * DM + 4 * lane + 256 * j)) : (u32x2){0u, 0u}; } while (0)
    ROW_LOAD(r0);
    for (int r = r0; r < r1; ++r) {
        const bool isctx = r < RCTX; const int bb = isctx ? 8 : (r - RCTX) / SEQ;
        f32x4 v[4]; u32x2 yw[4];
#pragma unroll
        for (int j = 0; j < 4; ++j) { v[j] = op.xin_bf ? (f32x4){bf2f(xnb[j].x & 0xffffu), bf2f(xnb[j].x >> 16), bf2f(xnb[j].y & 0xffffu), bf2f(xnb[j].y >> 16)} : xn[j]; yw[j] = yn[j]; }
        if (r + 1 < r1) ROW_LOAD(r + 1);
        if (bb != cur_bb) { cur_bb = bb;
#pragma unroll
            for (int j = 0; j < 4; ++j) { const int c = 4 * lane + 256 * j;
                if (op.y) gt[j] = *(const f32x4*)(op.modg + (size_t)bb * 6144 + op.gate_idx * 1024 + c) + *(const f32x4*)(op.modg + MODH + (size_t)bb * 6144 + op.gate_idx * 1024 + c);
                if (op.h) { sh[j] = *(const f32x4*)(op.modh + (size_t)bb * 6144 + op.shift_idx * 1024 + c) + *(const f32x4*)(op.modh + MODH + (size_t)bb * 6144 + op.shift_idx * 1024 + c);
                    sc[j] = *(const f32x4*)(op.modh + (size_t)bb * 6144 + op.scale_idx * 1024 + c) + *(const f32x4*)(op.modh + MODH + (size_t)bb * 6144 + op.scale_idx * 1024 + c) + 1.f; } } }
        if (op.y) {
            f32x4 yv[4]; float ss = 0.f;
#pragma unroll
            for (int j = 0; j < 4; ++j) { yv[j] = (f32x4){bf2f(yw[j].x & 0xffffu), bf2f(yw[j].x >> 16), bf2f(yw[j].y & 0xffffu), bf2f(yw[j].y >> 16)};
                ss += (yv[j].x * yv[j].x + yv[j].y * yv[j].y) + (yv[j].z * yv[j].z + yv[j].w * yv[j].w); }
            const float rinv = rsqrtf(wave_sum(ss) * (1.f / DM) + RMS_EPS);
            void* xob = isctx ? op.xout_ctx : op.xout_lat; const size_t xoo = isctx ? (size_t)r * DM : (size_t)(r - RCTX) * DM;
#pragma unroll
            for (int j = 0; j < 4; ++j) { v[j] = v[j] + gt[j] * (yv[j] * rinv * gp[j]);
                if (xob) { if (op.xout_bf) { u32x2 wx; wx.x = pk2(v[j].x, v[j].y); wx.y = pk2(v[j].z, v[j].w); __builtin_nontemporal_store(wx, (u32x2*)((bfs*)xob + xoo + 4 * lane + 256 * j));
                        v[j] = (f32x4){bf2f(wx.x & 0xffffu), bf2f(wx.x >> 16), bf2f(wx.y & 0xffffu), bf2f(wx.y >> 16)}; }
                    else __builtin_nontemporal_store(v[j], (f32x4*)((float*)xob + xoo + 4 * lane + 256 * j)); } }
        }
        if (op.h) {
            float ss = 0.f;
#pragma unroll
            for (int j = 0; j < 4; ++j) ss += (v[j].x * v[j].x + v[j].y * v[j].y) + (v[j].z * v[j].z + v[j].w * v[j].w);
            const float rinv = rsqrtf(wave_sum(ss) * (1.f / DM) + RMS_EPS);
#pragma unroll
            for (int j = 0; j < 4; ++j) { const f32x4 hv = (v[j] * rinv * gpre[j]) * sc[j] + sh[j];
                u32x2 w; w.x = pk2(hv.x, hv.y); w.y = pk2(hv.z, hv.w);
                *(u32x2*)(op.h + (size_t)r * DM + 4 * lane + 256 * j) = w; }
        }
    }
#undef ROW_LOAD
}

__device__ __forceinline__ void qk_phase(bfs* proj, const float* gq, const float* gk, int G) {
    const int tid_ = tid_fresh(); const int lane = tid_ & 63, wave = tid_ >> 6;
    const int gw = blockIdx.x * NWAVES + wave, NGW = G * NWAVES;
    const int sub = lane & 7;
    float gqv[8], gkv[8], inv[4];
#pragma unroll
    for (int e = 0; e < 8; ++e) { gqv[e] = gq[8 * sub + e]; gkv[e] = gk[8 * sub + e]; }
#pragma unroll
    for (int p = 0; p < 4; ++p) { const int pi = (4 * sub + p) & 15; inv[p] = exp2f(-(float)(2 * pi) * (13.287712379549449f / 32.f)); }
    const int rpw = (ROWS + NGW - 1) / NGW; const int r0 = gw * rpw, r1 = (r0 + rpw < ROWS) ? r0 + rpw : ROWS;
    u32x4 qn = (u32x4){0u, 0u, 0u, 0u}, kn = qn;
    if (r0 < r1) { qn = *(const u32x4*)(proj + (size_t)r0 * PIN0 + C_AQ + 8 * lane); kn = *(const u32x4*)(proj + (size_t)r0 * PIN0 + C_AK + 8 * (lane & 15)); }
    for (int r = r0; r < r1; ++r) {
        const bool lat = r >= RCTX; const int t = lat ? (r - RCTX) % SEQ : 0;
        const float pos = (sub < 4) ? (float)(t >> 6) : (float)(t & 63);
        float cs[4], sn[4];
#pragma unroll
        for (int p = 0; p < 4; ++p) { if (lat) { const float ang = pos * inv[p]; cs[p] = __cosf(ang); sn[p] = __sinf(ang);     } else { cs[p] = 1.f; sn[p] = 0.f; } }
        bfs* qp = proj + (size_t)r * PIN0 + C_AQ + 8 * lane;
        bfs* kp = proj + (size_t)r * PIN0 + C_AK + 8 * (lane & 15);
        const u32x4 qw = qn; const u32x4 kw = kn;
        if (r + 1 < r1) { qn = *(const u32x4*)(qp + PIN0); kn = *(const u32x4*)(kp + PIN0); }
        float q[8], k[8]; float sq = 0.f, sk = 0.f;
#pragma unroll
        for (int e = 0; e < 4; ++e) { q[2 * e] = bf2f(qw[e] & 0xffffu); q[2 * e + 1] = bf2f(qw[e] >> 16); k[2 * e] = bf2f(kw[e] & 0xffffu); k[2 * e + 1] = bf2f(kw[e] >> 16); }
#pragma unroll
        for (int e = 0; e < 8; ++e) { sq += q[e] * q[e]; sk += k[e] * k[e]; }
#pragma unroll
        for (int o = 1; o < 8; o <<= 1) { sq += __shfl_xor(sq, o); sk += __shfl_xor(sk, o); }
        const float rq = rsqrtf(sq * (1.f / 64.f) + RMS_EPS) , rk = rsqrtf(sk * (1.f / 64.f) + RMS_EPS);
        const float C2 = 0.125f * 1.4426950408889634f;
        u32x4 qo, ko;
#pragma unroll
        for (int p = 0; p < 4; ++p) {
            const float q0 = q[2 * p] * rq * gqv[2 * p], q1 = q[2 * p + 1] * rq * gqv[2 * p + 1];
            const float k0 = k[2 * p] * rk * gkv[2 * p], k1 = k[2 * p + 1] * rk * gkv[2 * p + 1];
            qo[p] = pk2((q0 * cs[p] - q1 * sn[p]) * C2, (q0 * sn[p] + q1 * cs[p]) * C2);
            ko[p] = pk2(k0 * cs[p] - k1 * sn[p], k0 * sn[p] + k1 * cs[p]);
        }
        *(u32x4*)qp = qo;
        if (lane < 16) *(u32x4*)kp = ko;
    }
}

template <int NCOL> __device__ __forceinline__ void readout_phase(const bfs* of, int pf, const bfs* ob, int pb, const bfs* ob2, int osplit, bfs* out, const bfs* proj, int pitch, int ogcol, const float* gain, int row_lo, int G) {
    constexpr int PL = NCOL / 64;
    constexpr int LPH = 128 / PL;
    const int tid_ = tid_fresh(); const int lane = tid_ & 63, wave = tid_ >> 6;
    const int gw = blockIdx.x * NWAVES + wave, NGW = G * NWAVES;
    float gv[PL];
#pragma unroll
    for (int e = 0; e < PL; ++e) gv[e] = gain[(PL * lane + e) & 127];
    const int rpw = (ROWS - row_lo + NGW - 1) / NGW; const int r0 = row_lo + gw * rpw, r1 = (r0 + rpw < ROWS) ? r0 + rpw : ROWS;
    u32x4 fn[PL / 8], bn[PL / 8], gn[PL / 8];
#define RO_LOAD(r) do { _Pragma("unroll") for (int c = 0; c < PL / 8; ++c) { fn[c] = *(const u32x4*)(of + (size_t)(r) * pf + PL * lane + 8 * c); bn[c] = *(const u32x4*)(((r) >= osplit ? ob2 : ob) + (size_t)(r) * pb + PL * lane + 8 * c); gn[c] = *(const u32x4*)(proj + (size_t)(r) * pitch + ogcol + PL * lane + 8 * c); } } while (0)
    if (r0 < r1) RO_LOAD(r0);
    for (int r = r0; r < r1; ++r) {
        float x[PL], g[PL]; float ss = 0.f;
#pragma unroll
        for (int c = 0; c < PL / 8; ++c) { const u32x4 fw = fn[c], bw = bn[c], gw4 = gn[c];
#pragma unroll
            for (int e = 0; e < 4; ++e) { x[8 * c + 2 * e] = bf2f(fw[e] & 0xffffu) + bf2f(bw[e] & 0xffffu); x[8 * c + 2 * e + 1] = bf2f(fw[e] >> 16) + bf2f(bw[e] >> 16); g[8 * c + 2 * e] = bf2f(gw4[e] & 0xffffu); g[8 * c + 2 * e + 1] = bf2f(gw4[e] >> 16); } }
        if (r + 1 < r1) RO_LOAD(r + 1);
#pragma unroll
        for (int e = 0; e < PL; ++e) ss += x[e] * x[e];
#pragma unroll
        for (int of2 = 1; of2 < LPH; of2 <<= 1) ss += __shfl_xor(ss, of2);
        const float rinv = rsqrtf(ss * (1.f / 128.f) + RMS_EPS);
#pragma unroll
        for (int c = 0; c < PL / 8; ++c) { u32x4 wv;
#pragma unroll
            for (int e = 0; e < 4; ++e) wv[e] = pk2(x[8 * c + 2 * e] * rinv * gv[8 * c + 2 * e] * siluf(g[8 * c + 2 * e]), x[8 * c + 2 * e + 1] * rinv * gv[8 * c + 2 * e + 1] * siluf(g[8 * c + 2 * e + 1]));
            *(u32x4*)(out + (size_t)r * DM + PL * lane + 8 * c) = wv; }
    }
#undef RO_LOAD
}

namespace scan {
#define SC_LBAR() asm volatile("s_waitcnt lgkmcnt(0)\n\ts_barrier" ::: "memory")
template <int PB> __device__ __forceinline__ int swz(int row, int chunk) {
    if (PB == 256) return row * 256 + ((chunk ^ (row & 15) ^ ((row >> 4) & 3)) << 4);
    else return row * 128 + ((chunk ^ (((row >> 1) ^ (row >> 4)) & 7)) << 4);
}
__device__ __forceinline__ int crow(int r, int hi) { return (r & 3) + 8 * (r >> 2) + 4 * hi; }
__device__ __forceinline__ float dpp_shr(float x, float old, const int n) {
    switch (n) {
    case 1: return __int_as_float(__builtin_amdgcn_update_dpp(__float_as_int(old), __float_as_int(x), 0x111, 0xf, 0xf, false));
    case 2: return __int_as_float(__builtin_amdgcn_update_dpp(__float_as_int(old), __float_as_int(x), 0x112, 0xf, 0xf, false));
    case 4: return __int_as_float(__builtin_amdgcn_update_dpp(__float_as_int(old), __float_as_int(x), 0x114, 0xf, 0xf, false));
    default: return __int_as_float(__builtin_amdgcn_update_dpp(__float_as_int(old), __float_as_int(x), 0x118, 0xf, 0xf, false));
    }
}
template <int DK, bool HG, int NV> struct Map {
    static constexpr int PQ = DK * 2;
    static constexpr int O_QG = 0, O_KG = 64 * PQ, O_KGT = 2 * 64 * PQ, O_VT = O_KGT + DK * 128, O_ST = O_VT + NV * 128, O_EGL = O_ST + NV * PQ, O_VR = O_EGL + DK * 4, O_ZB = O_VR + 64 * NV * 2, O_FB = O_ZB + 2048, O_END = HG ? O_ZB : O_FB + 16384;
};
template <int DK, bool HG, int pitch, int NV>
__device__ __forceinline__ void scan_unit(LAS unsigned char* L, const bfs* __restrict__ proj, const int qcol, const int kcol, const int vcol, const int zcol,
                                          const float* __restrict__ wg, const float* __restrict__ bg, bfs* O, bfs* O2, const int osplit, const int opitch, const int ocol, const int b, const int dir, const float qscale) {
    typedef Map<DK, HG, NV> MP;
    constexpr int PQ = MP::PQ, NTG = DK * 4, NVB = NV / 32, NST = (DK / 32) * NVB / 8, WPM = NVB / NST, NPV = NV / 64, VCPR = NV / 8, VPB = NV * 2;
    const int tid = tid_fresh(), lane = tid & 63, r32 = lane & 31, hi = lane >> 5, w = tid >> 6;
    const int c4 = tid >> 4, sg = tid & 15;
    const bool gact = tid < NTG;
    const int mk = w / WPM;
    const int nv0 = (w % WPM) * NST;
    const bool oact = w < 2 * NVB;
    f32x16 S[NST];
#pragma unroll
    for (int i = 0; i < NST; ++i)
#pragma unroll
        for (int r = 0; r < 16; ++r) S[i][r] = 0.f;
    s16x8 wgB = (s16x8){0, 0, 0, 0, 0, 0, 0, 0}; float bias = 0.f;
    if (!HG) {
        const int col = 32 * (w & 1) + r32;
#pragma unroll
        for (int j = 0; j < 8; ++j) wgB[j] = (short)f2bf(wg[(8 * hi + j) * 256 + col]);
        bias = bg[col];
    }
    constexpr int NQ = DK / 64, CPR = DK / 8;
    u32x4 pqA[NQ], pkA[NQ], pvA[NPV]; u32x4 pzA = (u32x4){0u, 0u, 0u, 0u};
#define SC_BASE(s) ({ const int g_ = dir ? ((s) < 4 ? 3 - (s) : 71 - (s)) : (s); (long)(g_ < 4 ? b * 256 + 64 * g_ : 2048 + b * 4096 + 64 * (g_ - 4)); })
#define SC_GROW(base, i) ((base) + (dir ? 63 - (i) : (i)))
#define SC_ISSUE(s) do { const long nb_ = SC_BASE(s); \
        _Pragma("unroll") for (int i = 0; i < NQ; ++i) { const int id = tid + 512 * i, row = id / CPR, c = id % CPR; const bfs* rp = proj + (size_t)SC_GROW(nb_, row) * pitch + 8 * c; pq[i] = *(const u32x4*)(rp + qcol); pk[i] = *(const u32x4*)(rp + kcol); } \
        _Pragma("unroll") for (int i = 0; i < NPV; ++i) { const int id = tid + 512 * i, row = id / VCPR, c = id % VCPR; pv[i] = *(const u32x4*)(proj + (size_t)SC_GROW(nb_, row) * pitch + vcol + 8 * c); } \
        if (!HG) { if (tid < 128) pz = *(const u32x4*)(proj + (size_t)SC_GROW(nb_, tid >> 1) * pitch + zcol + 8 * (tid & 1)); } } while (0)
    { auto& pq = pqA; auto& pk = pkA; auto& pv = pvA; auto& pz = pzA; SC_ISSUE(0); }
    unsigned ost[8]; long pbase = 0;
#pragma unroll
    for (int i = 0; i < 8; ++i) ost[i] = 0u;
#define SC_STORE(bs) do { const int nvt_ = w >> 1, mi_ = w & 1; const int lrow_ = dir ? 63 - (32 * mi_ + 4 * hi) : (32 * mi_ + 4 * hi); const long ostep_ = dir ? -(long)opitch : (long)opitch; \
        bfs* ob_ = (((bs) >= osplit) ? O2 : O) + (size_t)((bs) + lrow_) * opitch + ocol + 32 * nvt_ + r32; \
        _Pragma("unroll") for (int r = 0; r < 16; ++r) ob_[((r & 3) + 8 * (r >> 2)) * ostep_] = (bfs)((r & 1) ? (ost[r >> 1] >> 16) : (ost[r >> 1] & 0xffffu)); } while (0)
    auto body = [&](const int s, u32x4 (&pq)[NQ], u32x4 (&pk)[NQ], u32x4 (&pv)[NPV], u32x4& pz) __attribute__((always_inline)) {
        const long base = SC_BASE(s);
#ifdef PROBE_SEG
        unsigned long long tseg0 = __builtin_amdgcn_s_memrealtime();
#define SEG_MARK(k) do { const unsigned long long tn_ = __builtin_amdgcn_s_memrealtime(); if (HG && blockIdx.x == PROBE_BLK && threadIdx.x == 0 && (PROBE_SEG == (k) || PROBE_SEG == 0)) { volatile LAS unsigned long long* pa_ = (volatile LAS unsigned long long*)(L + 153600 + 64 + 40 * 8); pa_[0] += tn_ - tseg0; } tseg0 = tn_; } while (0)
#else
#define SEG_MARK(k) do {} while (0)
#endif
#pragma unroll
        for (int ti = 0; ti < NST; ++ti) { const int v = 32 * (nv0 + ti) + r32;
#pragma unroll
            for (int r4 = 0; r4 < 4; ++r4) { const int k0 = 32 * mk + 8 * r4 + 4 * hi; u32x2 wv; wv.x = pk2(S[ti][4 * r4], S[ti][4 * r4 + 1]); wv.y = pk2(S[ti][4 * r4 + 2], S[ti][4 * r4 + 3]);
                *(LAS u32x2*)(L + MP::O_ST + swz<PQ>(v, k0 >> 3) + (k0 & 7) * 2) = wv; } }
        if (s > 0 && oact) SC_STORE(pbase);
        pbase = base;
#pragma unroll
        for (int i = 0; i < NQ; ++i) { const int id = tid + 512 * i, row = id / CPR, c = id % CPR;
            *(LAS u32x4*)(L + MP::O_QG + swz<PQ>(row, c)) = pq[i]; *(LAS u32x4*)(L + MP::O_KG + swz<PQ>(row, c)) = pk[i]; }
#pragma unroll
        for (int i = 0; i < NPV; ++i) { const int id = tid + 512 * i, row = id / VCPR, c = id % VCPR; *(LAS u32x4*)(L + MP::O_VR + swz<VPB>(row, c)) = pv[i]; }
        if (!HG) { if (tid < 128) *(LAS u32x4*)(L + MP::O_ZB + (tid >> 1) * 32 + (tid & 1) * 16) = pz; }
        if (s + 1 < 68) SC_ISSUE(s + 1);
        SC_LBAR();
        u32x2 q2[4], k2[4];
#pragma unroll
        for (int r = 0; r < 4; ++r) { q2[r] = (u32x2){0u, 0u}; k2[r] = (u32x2){0u, 0u}; }
        if (gact) {
#pragma unroll
            for (int r = 0; r < 4; ++r) { const int off = swz<PQ>(4 * sg + r, c4 >> 1) + (c4 & 1) * 8; q2[r] = *(const LAS u32x2*)(L + MP::O_QG + off); k2[r] = *(const LAS u32x2*)(L + MP::O_KG + off); } }
        if (c4 < NV / 4) {
            u32x2 v2[4];
#pragma unroll
            for (int r = 0; r < 4; ++r) v2[r] = *(const LAS u32x2*)(L + MP::O_VR + swz<VPB>(4 * sg + r, c4 >> 1) + (c4 & 1) * 8);
            u32x2 t0, t1, t2, t3;
            t0.x = (v2[0].x & 0xffffu) | (v2[1].x << 16); t0.y = (v2[2].x & 0xffffu) | (v2[3].x << 16);
            t1.x = (v2[0].x >> 16) | (v2[1].x & 0xffff0000u); t1.y = (v2[2].x >> 16) | (v2[3].x & 0xffff0000u);
            t2.x = (v2[0].y & 0xffffu) | (v2[1].y << 16); t2.y = (v2[2].y & 0xffffu) | (v2[3].y << 16);
            t3.x = (v2[0].y >> 16) | (v2[1].y & 0xffff0000u); t3.y = (v2[2].y >> 16) | (v2[3].y & 0xffff0000u);
            const int vo = (sg & 1) * 8;
            *(LAS u32x2*)(L + MP::O_VT + swz<128>(4 * c4 + 0, sg >> 1) + vo) = t0; *(LAS u32x2*)(L + MP::O_VT + swz<128>(4 * c4 + 1, sg >> 1) + vo) = t1;
            *(LAS u32x2*)(L + MP::O_VT + swz<128>(4 * c4 + 2, sg >> 1) + vo) = t2; *(LAS u32x2*)(L + MP::O_VT + swz<128>(4 * c4 + 3, sg >> 1) + vo) = t3; }
        float qv[4][4], kv[4][4];
#pragma unroll
        for (int r = 0; r < 4; ++r) { qv[r][0] = bf2f(q2[r].x & 0xffffu); qv[r][1] = bf2f(q2[r].x >> 16); qv[r][2] = bf2f(q2[r].y & 0xffffu); qv[r][3] = bf2f(q2[r].y >> 16);
            kv[r][0] = bf2f(k2[r].x & 0xffffu); kv[r][1] = bf2f(k2[r].x >> 16); kv[r][2] = bf2f(k2[r].y & 0xffffu); kv[r][3] = bf2f(k2[r].y >> 16); }
        if (!HG) {
            if (w < 4) { const int mi = w >> 1, nj = w & 1;
                const s16x8 za = *(const LAS s16x8*)(L + MP::O_ZB + (32 * mi + r32) * 32 + hi * 16);
                f32x16 lg;
#pragma unroll
                for (int r = 0; r < 16; ++r) lg[r] = 0.f;
                lg = __builtin_amdgcn_mfma_f32_32x32x16_bf16(za, wgB, lg, 0, 0, 0);
#pragma unroll
                for (int r = 0; r < 16; ++r) { const float x = lg[r] + bias; const float ls = fminf(x, 0.f) - __logf(1.f + __expf(-fabsf(x)));
                    ((LAS float*)(L + MP::O_FB))[(32 * mi + crow(r, hi)) * 64 + 32 * nj + r32] = __expf(ls * (1.f / 16.f)); } }
            SC_LBAR();
        }
        if (gact) {
            float p[4][4];
#pragma unroll
            for (int r = 0; r < 4; ++r) {
                f32x4 f;
                if (HG) f = (f32x4){1.f - kv[r][0], 1.f - kv[r][1], 1.f - kv[r][2], 1.f - kv[r][3]};
                else f = *(const LAS f32x4*)(L + MP::O_FB + ((4 * sg + r) * 64 + 4 * c4) * 4);
#pragma unroll
                for (int e = 0; e < 4; ++e) p[r][e] = r ? p[r - 1][e] * f[e] : f[e]; }
            float ex[4];
#pragma unroll
            for (int e = 0; e < 4; ++e) { float x = p[3][e];
                x *= dpp_shr(x, 1.f, 1); x *= dpp_shr(x, 1.f, 2); x *= dpp_shr(x, 1.f, 4); x *= dpp_shr(x, 1.f, 8);
                ex[e] = dpp_shr(x, 1.f, 1);
                if (sg == 15) ((LAS float*)(L + MP::O_EGL))[4 * c4 + e] = x; }
            float kg[4][4];
#pragma unroll
            for (int r = 0; r < 4; ++r) { const int row = 4 * sg + r; float qg[4];
#pragma unroll
                for (int e = 0; e < 4; ++e) { const float eG = ex[e] * p[r][e]; qg[e] = qv[r][e] * qscale * eG; kg[r][e] = kv[r][e] * __builtin_amdgcn_rcpf(eG); }
                u32x2 wq, wk; wq.x = pk2(qg[0], qg[1]); wq.y = pk2(qg[2], qg[3]); wk.x = pk2(kg[r][0], kg[r][1]); wk.y = pk2(kg[r][2], kg[r][3]);
                const int off = swz<PQ>(row, c4 >> 1) + (c4 & 1) * 8;
                *(LAS u32x2*)(L + MP::O_QG + off) = wq; *(LAS u32x2*)(L + MP::O_KG + off) = wk; }
#pragma unroll
            for (int e = 0; e < 4; ++e) { u32x2 wt; wt.x = pk2(kg[0][e], kg[1][e]); wt.y = pk2(kg[2][e], kg[3][e]);
                *(LAS u32x2*)(L + MP::O_KGT + swz<128>(4 * c4 + e, sg >> 1) + (sg & 1) * 8) = wt; }
        }
        SC_LBAR();
        SEG_MARK(1);
        f32x16 acc;
#pragma unroll
        for (int r = 0; r < 16; ++r) acc[r] = 0.f;
        { const int mi = (w >> 1) & 1, nj = w & 1;
          if (w < 4 && nj <= mi) {
#pragma unroll
            for (int kk = 0; kk < DK / 16; ++kk) { const s16x8 ka = *(const LAS s16x8*)(L + MP::O_KG + swz<PQ>(32 * nj + r32, 2 * kk + hi)); const s16x8 bq = *(const LAS s16x8*)(L + MP::O_QG + swz<PQ>(32 * mi + r32, 2 * kk + hi));
                acc = __builtin_amdgcn_mfma_f32_32x32x16_bf16(ka, bq, acc, 0, 0, 0); } }
          SC_LBAR();
          if (w < 4) { const int i = 32 * mi + r32;
#pragma unroll
            for (int r4 = 0; r4 < 4; ++r4) { const int j0 = 32 * nj + 8 * r4 + 4 * hi; float pp[4];
#pragma unroll
              for (int e = 0; e < 4; ++e) pp[e] = (j0 + e <= i) ? acc[4 * r4 + e] : 0.f;
              u32x2 wv; wv.x = pk2(pp[0], pp[1]); wv.y = pk2(pp[2], pp[3]);
              *(LAS u32x2*)(L + MP::O_KG + swz<128>(i, j0 >> 3) + (j0 & 7) * 2) = wv; } } }
        SC_LBAR();
        SEG_MARK(2);
        if (oact) { const int nvt = w >> 1, mi = w & 1;
#pragma unroll
          for (int r = 0; r < 16; ++r) acc[r] = 0.f;
#pragma unroll
          for (int kk = 0; kk < 4; ++kk) { const s16x8 va = *(const LAS s16x8*)(L + MP::O_VT + swz<128>(32 * nvt + r32, 2 * kk + hi)); const s16x8 bp = *(const LAS s16x8*)(L + MP::O_KG + swz<128>(32 * mi + r32, 2 * kk + hi));
              acc = __builtin_amdgcn_mfma_f32_32x32x16_bf16(bp, va, acc, 0, 0, 0); }
#pragma unroll
          for (int kk = 0; kk < DK / 16; ++kk) { const s16x8 sa = *(const LAS s16x8*)(L + MP::O_ST + swz<PQ>(32 * nvt + r32, 2 * kk + hi)); const s16x8 bq = *(const LAS s16x8*)(L + MP::O_QG + swz<PQ>(32 * mi + r32, 2 * kk + hi));
              acc = __builtin_amdgcn_mfma_f32_32x32x16_bf16(bq, sa, acc, 0, 0, 0); }
#pragma unroll
          for (int i = 0; i < 8; ++i) ost[i] = pk2(acc[2 * i], acc[2 * i + 1]);
          }
#pragma unroll
        for (int ti = 0; ti < NST; ++ti) {
#pragma unroll
            for (int kk = 0; kk < 4; ++kk) { const s16x8 ka = *(const LAS s16x8*)(L + MP::O_KGT + swz<128>(32 * mk + r32, 2 * kk + hi)); const s16x8 bv = *(const LAS s16x8*)(L + MP::O_VT + swz<128>(32 * (nv0 + ti) + r32, 2 * kk + hi));
                S[ti] = __builtin_amdgcn_mfma_f32_32x32x16_bf16(ka, bv, S[ti], 0, 0, 0); }
#pragma unroll
            for (int r = 0; r < 16; ++r) S[ti][r] *= ((const LAS float*)(L + MP::O_EGL))[32 * mk + crow(r, hi)]; }
        SC_LBAR();
        SEG_MARK(3);
    };
    for (int s2 = 0; s2 < 68; ++s2) body(s2, pqA, pkA, pvA, pzA);
    if (oact) SC_STORE(pbase);
    asm volatile("s_waitcnt vmcnt(0)" ::: "memory");
#undef SC_STORE
#undef SC_BASE
#undef SC_GROW
#undef SC_ISSUE
}
}

#define XB_TMO      128
#define XB_XCNT(j)  (256  + 64 * (j))
#define XB_XSUB(j)  (1280 + 64 * (j))
#define XB_XGEN(j)  (2304 + 64 * (j))
#define XB_TOP      3328
#define XB_TOPGEN   3392
#define XCD_BAR_WORDS 3456
#define XB_SPIN_CAP (1u << 18)

__device__ __forceinline__ unsigned xb_ld(unsigned* p)              { return __hip_atomic_load(p, __ATOMIC_RELAXED, __HIP_MEMORY_SCOPE_AGENT); }
__device__ __forceinline__ unsigned xb_add(unsigned* p, unsigned v) { return __hip_atomic_fetch_add(p, v, __ATOMIC_RELAXED, __HIP_MEMORY_SCOPE_AGENT); }
__device__ __forceinline__ unsigned xb_xcc_id() { return (unsigned)__builtin_amdgcn_s_getreg((3 << 11) | 20) & 0xFu; }
#define XB_SPIN(cond, bar) do { unsigned _sp = 0; while (cond) { __builtin_amdgcn_s_sleep(1); \
    if ((++_sp & 255u) == 0u) { if (xb_ld(&(bar)[XB_TMO])) break; if (_sp > XB_SPIN_CAP) { atomicAdd(&(bar)[XB_TMO], 1u); break; } } } } while (0)

struct XcdBarrier {
    unsigned* bar; unsigned x;
    volatile LAS unsigned* st;
};

__device__ __forceinline__ XcdBarrier xcd_barrier_post(unsigned* bar, volatile LAS unsigned* st) {
    XcdBarrier b; b.bar = bar; b.x = xb_xcc_id(); b.st = st;
    if (threadIdx.x == 0) (void)xb_add(&bar[XB_XCNT(b.x)], 1u);
    return b;
}
__device__ __forceinline__ void xcd_barrier_complete(unsigned* bar, unsigned x, unsigned& nloc, unsigned& nx) {
    const unsigned G = gridDim.x * gridDim.y * gridDim.z;
    unsigned sum, cnt, mine, sp = 0u;
    for (;;) {
        sum = 0u; cnt = 0u; mine = 0u;
#pragma unroll
        for (unsigned j = 0; j < 16; ++j) { const unsigned c = xb_ld(&bar[XB_XCNT(j)]); sum += c; cnt += (c > 0u) ? 1u : 0u; mine = (j == x) ? c : mine; }
        if (sum == G) break;
        __builtin_amdgcn_s_sleep(1);
        if ((++sp & 255u) == 0u) { if (xb_ld(&bar[XB_TMO])) break; if (sp > XB_SPIN_CAP) { atomicAdd(&bar[XB_TMO], 1u); break; } }
    }
    nloc = mine > 0u ? mine : 1u; nx = cnt > 0u ? cnt : 1u;
}

__device__ __forceinline__ void xcd_barrier(const XcdBarrier& b) {
    asm volatile("s_waitcnt vmcnt(0)" ::: "memory");
    __syncthreads();
    if (threadIdx.x == 0) {
        unsigned* bar = b.bar;
        __builtin_amdgcn_s_waitcnt(0);
        unsigned nloc = b.st[0], nx = b.st[1];
        if (nloc == 0u) { xcd_barrier_complete(bar, b.x, nloc, nx); b.st[0] = nloc; b.st[1] = nx; }
        const unsigned old = xb_add(&bar[XB_XSUB(b.x)], 1u);
        const unsigned gen = old / nloc;
        if (old + 1u == (gen + 1u) * nloc) {
            __builtin_amdgcn_fence(__ATOMIC_RELEASE, "agent");
            asm volatile("s_waitcnt vmcnt(0)" ::: "memory");
            const unsigned og = xb_add(&bar[XB_TOP], 1u);
            const unsigned tg = og / nx;
            if (og + 1u == (tg + 1u) * nx) xb_add(&bar[XB_TOPGEN], 1u);
            else XB_SPIN(xb_ld(&bar[XB_TOPGEN]) == tg, bar);
            __builtin_amdgcn_fence(__ATOMIC_ACQUIRE, "agent");
            xb_add(&bar[XB_XGEN(b.x)], 1u);
            asm volatile("s_waitcnt vmcnt(0)" ::: "memory");
        } else {
            XB_SPIN(xb_ld(&bar[XB_XGEN(b.x)]) == gen, bar);
            __builtin_amdgcn_fence(__ATOMIC_ACQUIRE, "agent");
            asm volatile("s_waitcnt vmcnt(0)" ::: "memory");
        }
    }
    __syncthreads();
}

#ifdef PROBE_MASK
#define STAMP() do { if (blockIdx.x == PROBE_BLK && threadIdx.x == 0) { pst[pn] = __builtin_amdgcn_s_memrealtime(); } ++pn; } while (0)
#else
#define STAMP() do {} while (0)
#endif
#define GRID_SYNC() do { xcd_barrier(xbar); STAMP(); } while (0)
#define GRID_SYNC_CG() do { if (a.ws == nullptr) grid.sync(); xcd_barrier(xbar); STAMP(); } while (0)
__global__ void __launch_bounds__(NTHR, 2) fwd_megakernel(Args a) {
    extern __shared__ __attribute__((aligned(16))) unsigned char lds_raw[];
    cg::grid_group grid = cg::this_grid();
    LAS unsigned char* lds = (LAS unsigned char*)lds_raw;
    const int G = gridDim.x, tid = threadIdx.x;
    unsigned char* ws = a.ws;
    float* MOD = (float*)(ws + WS_MOD); const float* LB = (const float*)(ws + WS_LB);
    bfs* XB1 = (bfs*)a.out;
    bfs* X2 = (bfs*)(ws + WS_D + 264 * MiB);
    bfs* CB = (bfs*)(ws + WS_C); bfs* DB = (bfs*)(ws + WS_D); bfs* YB = (bfs*)(ws + WS_Y); bfs* EB = (bfs*)(ws + WS_E0);
    unsigned* ctl = (unsigned*)(ws + WS_CTL);
    { volatile LAS unsigned* st0 = (volatile LAS unsigned*)(lds + LDS_CTL_OFF + 16); if (tid == 0) { st0[0] = 0u; st0[1] = 0u; } __syncthreads(); }
    XcdBarrier xbar = xcd_barrier_post(ctl + 1024, (volatile LAS unsigned*)(lds + LDS_CTL_OFF + 16));
#ifdef PROBE_MASK
    volatile LAS unsigned long long* pst = (volatile LAS unsigned long long*)(lds + LDS_CTL_OFF + 64); int pn = 1;
    if (threadIdx.x == 0) { pst[0] = __builtin_amdgcn_s_memrealtime(); pst[40] = 0; }
#endif

    p0_phase(a, lds, G);
    GRID_SYNC_CG();
    { RowOp op{a.in[0], a.in[2], nullptr, nullptr, nullptr, nullptr, nullptr, 0, CB, a.in[6], MOD, 0, 1, 0, 0, 0}; row_phase(op, G); }
    GRID_SYNC();
    for (int l = 0; l < 2; ++l) {
        const float* MODL = MOD + (size_t)l * 9 * 6144;
        const bfs* Win = (const bfs*)(ws + (l ? WS_WIN1 : WS_WIN0)); const bfs* Wout = (const bfs*)(ws + (l ? WS_WOUT1 : WS_WOUT0));
        const bfs* Wgu = (const bfs*)(ws + (l ? WS_WGU1 : WS_WGU0)); const bfs* Wd = (const bfs*)(ws + (l ? WS_WD1 : WS_WD0));
        const int pitch = l ? NIN1 : PIN0;
        { pg8::Gemm g{CB, Win, ROWS, pitch, DM}; pg8::StaticOrder S; S.init(ROWS, pitch, G, (int)blockIdx.x);
          pg8::EpiStore E{DB, pitch, l, LB};
#ifndef NO_GEMM
          pg8::gemm_phase<pg8::EpiStore, pg8::StaticOrder, true, true>(lds, g, S, E);
#endif
 }
        GRID_SYNC();
        if (l == 0) {
            qk_phase(DB, a.in[14], a.in[15], G);
            GRID_SYNC();
            volatile LAS unsigned* lctl = (volatile LAS unsigned*)(lds + LDS_CTL_OFF);
            float gqm = 0.f, gkm = 0.f;
            for (int i = 0; i < 64; ++i) { gqm = fmaxf(gqm, fabsf(a.in[14][i])); gkm = fmaxf(gkm, fabsf(a.in[15][i])); }
            const bool nomax = 2.f * 11.6f * gqm * gkm < 90.f;
            constexpr int N_GLA = 64, N_ATL = 1024, N_ATC = 64, N_ITEMS = N_GLA + N_ATL + N_ATC;
            for (;;) {
                if (tid == 0) lctl[0] = __hip_atomic_fetch_add(ctl + 64, 1u, __ATOMIC_RELAXED, __HIP_MEMORY_SCOPE_AGENT);
                __syncthreads();
                const int it = (int)lctl[0];
                __syncthreads();
                if (it >= N_ITEMS) break;
                if (it < N_GLA) {
                    const int b = it >> 3, h = (it >> 1) & 3, dir = it & 1;
#ifndef NO_GLA
                    scan::scan_unit<64, false, PIN0, 128>(lds, DB, C_GQ + 64 * h, C_GK + 64 * h, C_GV + 128 * h, C_GZ + 16 * dir, a.in[11] + dir * 16 * 256 + 64 * h, a.in[12] + dir * 256 + 64 * h,
                                               dir ? EB : CB, dir ? EB : CB, 0, dir ? 512 : DM, 128 * h, b, dir, 0.125f);
#endif
                } else if (it < N_GLA + N_ATL) {
                    const int u = it - N_GLA, gq = u & 3, qb = (u >> 2) & 15, kvh = (u >> 6) & 1, b = u >> 7, h = kvh * 4 + gq;
                    const size_t qrow = (size_t)RCTX + (size_t)b * SEQ + (size_t)qb * 256;
#ifndef NO_ATTN
                    if (nomax) attn_body::attn_unit<8, true>(b, 68, (const attn_body::bf16*)(DB + qrow * PIN0 + C_AQ + 64 * h), PIN0, (const attn_body::bf16*)(DB + C_AK + 64 * kvh), (const attn_body::bf16*)(DB + C_AV + 64 * kvh), PIN0,
                                            (attn_body::bf16*)(CB + qrow * DM + 512 + 64 * h), DM, (char*)lds_raw);
                    else attn_body::attn_unit<8, false>(b, 68, (const attn_body::bf16*)(DB + qrow * PIN0 + C_AQ + 64 * h), PIN0, (const attn_body::bf16*)(DB + C_AK + 64 * kvh), (const attn_body::bf16*)(DB + C_AV + 64 * kvh), PIN0,
                                            (attn_body::bf16*)(CB + qrow * DM + 512 + 64 * h), DM, (char*)lds_raw);
#endif
                } else {
                    const int u = it - N_GLA - N_ATL, h = u & 7, b = u >> 3, kvh = h >> 2;
                    const size_t qrow = (size_t)b * NCTX;
#ifndef NO_ATTN2
                    if (nomax) attn_body::attn_unit<8, true>(b, 4, (const attn_body::bf16*)(DB + qrow * PIN0 + C_AQ + 64 * h), PIN0, (const attn_body::bf16*)(DB + C_AK + 64 * kvh), (const attn_body::bf16*)(DB + C_AV + 64 * kvh), PIN0,
                                            (attn_body::bf16*)(CB + qrow * DM + 512 + 64 * h), DM, (char*)lds_raw);
                    else attn_body::attn_unit<8, false>(b, 4, (const attn_body::bf16*)(DB + qrow * PIN0 + C_AQ + 64 * h), PIN0, (const attn_body::bf16*)(DB + C_AK + 64 * kvh), (const attn_body::bf16*)(DB + C_AV + 64 * kvh), PIN0,
                                            (attn_body::bf16*)(CB + qrow * DM + 512 + 64 * h), DM, (char*)lds_raw);
#endif
                }
            }
            if (G >= 256) p0_weights(a, lds, P0_NA, P0_NITEMS, (int)blockIdx.x * NWAVES + (tid >> 6), G * NWAVES);
            GRID_SYNC();
            readout_phase<512>(CB, DM, EB, 512, EB, 0, CB, DB, PIN0, C_GOG, a.in[13], 0, G);
        } else {
            bfs* OA = (bfs*)(ws + 2 * MiB); bfs* OT2 = (bfs*)(ws + WS_D + 340 * MiB) - (size_t)OSPLIT * DM;
            for (int u = blockIdx.x; u < 256; u += G) {
                const int b = u >> 5, hh = (u >> 2) & 7, dir = (u >> 1) & 1, vh = u & 1;
#ifndef NO_HG
                scan::scan_unit<128, true, NIN1, 64>(lds, DB, C_FQ + 128 * hh, C_FF + 1024 * dir + 128 * hh, C_FI + 128 * hh + 64 * vh, 0, nullptr, nullptr,
                                                     dir ? OA : CB, dir ? OT2 : CB, dir ? OSPLIT : 0, DM, 128 * hh + 64 * vh, b, dir, 1.0f);
#endif
            }
            GRID_SYNC();
            readout_phase<1024>(CB, DM, OA, DM, OT2, OSPLIT, CB, DB, NIN1, C_FOG, a.in[19], RCTX, G);
        }
        GRID_SYNC();
        const int row_lo = l ? RCTX : 0; const int Mg = ROWS - row_lo;
#define PANEL_VARS const int nMg = Mg / 256, ncomp = nMg < G / 2 ? nMg : G / 2, nthird = (nMg - ncomp) * 4; \
        const bool third = (G == 256) ? (((int)blockIdx.x & 7) == 0 && 128 + ((int)blockIdx.x >> 5) < nMg) : ((int)blockIdx.x < nthird); \
        const int rrank = !nthird ? (int)blockIdx.x : (G == 256 ? ((int)blockIdx.x - ((int)blockIdx.x >> 3) - 1) : (int)blockIdx.x - nthird)
#define ROWOP_MIX RowOp op{l ? (const void*)(XB1 + (size_t)RCTX * DM) : (const void*)a.in[0], l ? (const void*)XB1 : (const void*)a.in[2], l ? (void*)X2 : (void*)(XB1 + (size_t)RCTX * DM), l ? (void*)nullptr : (void*)XB1, \
                   YB, a.in[7] + l * DM, MODL, 2, CB, a.in[8] + l * DM, MODL, 3, 4, row_lo, l, 1}
        for (int part = 0; part < 2; ++part) {
            { PANEL_VARS; (void)third; (void)rrank; (void)nthird; (void)ncomp;
              pg8::Gemm g{CB + (size_t)row_lo * DM, Wout, Mg, DM, DM}; pg8::EpiStore E{YB + (size_t)row_lo * DM, DM, 0, nullptr};
              pg8::PanelOrder S{nMg, G, (int)blockIdx.x, part ? 2 : 0, part ? 3 : 2};
#ifndef NO_GEMM
              pg8::gemm_phase<pg8::EpiStore, pg8::PanelOrder, true, true>(lds, g, S, E);
#endif
            }
            if (part == 1) { PANEL_VARS; if (!third) { ROWOP_MIX; row_phase(op, G, row_lo, row_lo + ncomp * 256, rrank, G - nthird); } }
            GRID_SYNC();
        }
        { PANEL_VARS; (void)third; (void)rrank; (void)nthird; if (ncomp < nMg) { ROWOP_MIX; row_phase(op, G, row_lo + ncomp * 256, ROWS); GRID_SYNC(); } }
        { pg8::Gemm g{CB + (size_t)row_lo * DM, Wgu, Mg, NGU, DM}; pg8::StaticOrder S; S.init(Mg, NGU, G, (int)blockIdx.x);
          pg8::EpiSwiGLU E{DB + (size_t)row_lo * DFF, DFF};
#ifndef NO_GEMM
          pg8::gemm_phase<pg8::EpiSwiGLU, pg8::StaticOrder, true, true>(lds, g, S, E);
#endif
 }
        GRID_SYNC();
#define ROWOP_FFN RowOp op{l ? (const void*)X2 : (const void*)(XB1 + (size_t)RCTX * DM), l ? (const void*)nullptr : (const void*)XB1, l ? (void*)a.out : (void*)(XB1 + (size_t)RCTX * DM), l ? (void*)nullptr : (void*)XB1, \
                   YB, a.in[9] + l * DM, MODL, 5, l ? (bfs*)nullptr : CB, l ? (const float*)nullptr : a.in[6] + DM, l ? (const float*)nullptr : MOD + (size_t)9 * 6144, 0, l ? 0 : 1, l ? RCTX : 0, 1, l ? 0 : 1}
        for (int part = 0; part < 2; ++part) {
            { PANEL_VARS; (void)third; (void)rrank; (void)nthird; (void)ncomp;
              pg8::Gemm g{DB + (size_t)row_lo * DFF, Wd, Mg, DM, DFF}; pg8::EpiStore E{YB + (size_t)row_lo * DM, DM, 0, nullptr};
              pg8::PanelOrder S{nMg, G, (int)blockIdx.x, part ? 2 : 0, part ? 3 : 2};
#ifndef NO_GEMM
              pg8::gemm_phase<pg8::EpiStore, pg8::PanelOrder, true, true>(lds, g, S, E);
#endif
            }
            if (part == 1) { PANEL_VARS; if (!third) { ROWOP_FFN; row_phase(op, G, row_lo, row_lo + ncomp * 256, rrank, G - nthird); } }
            if (part == 0 || l == 0) GRID_SYNC();
        }
        { PANEL_VARS; (void)third; (void)rrank; (void)nthird; if (ncomp < nMg) { ROWOP_FFN; row_phase(op, G, row_lo + ncomp * 256, ROWS); GRID_SYNC(); } }
    }
#ifdef PROBE_SYNCS
    for (int i = 0; i < PROBE_SYNCS; ++i) xcd_barrier(xbar);
#endif
#ifdef PROBE_MASK
    STAMP();
    if (blockIdx.x == PROBE_BLK && threadIdx.x == 0) {
        unsigned long long extra = 0;
        for (int i = 1; i < pn; ++i) if ((PROBE_MASK >> (i - 1)) & 1u) extra += pst[i] - pst[i - 1];
        extra += pst[40];
        const unsigned long long t0 = __builtin_amdgcn_s_memrealtime();
        while (__builtin_amdgcn_s_memrealtime() - t0 < extra) __builtin_amdgcn_s_sleep(8);
    }
#endif
}

extern "C" void kernel_launch(void* const* d_in, const int* in_sizes, int n_in, void* d_out, int out_size, void* d_ws, size_t ws_size, hipStream_t stream) {
    static int grid = 0;
    if (grid == 0) {
        if (n_in != 24 || ws_size < WS_END) { fprintf(stderr, "kernel_launch: unexpected inputs (n_in %d, ws %zu < %zu)\n", n_in, ws_size, (size_t)WS_END); grid = -1; return; }
        int dev = 0, cus = 0, per_cu = 0;
        hipGetDevice(&dev);
        hipDeviceGetAttribute(&cus, hipDeviceAttributeMultiprocessorCount, dev);
        if (hipFuncSetAttribute((const void*)fwd_megakernel, hipFuncAttributeMaxDynamicSharedMemorySize, LDS_BYTES) != hipSuccess) { fprintf(stderr, "kernel_launch: hipFuncSetAttribute failed\n"); grid = -1; return; }
        if (hipOccupancyMaxActiveBlocksPerMultiprocessor(&per_cu, (const void*)fwd_megakernel, NTHR, LDS_BYTES) != hipSuccess || per_cu < 1) { fprintf(stderr, "kernel_launch: occupancy query gave %d\n", per_cu); per_cu = 1; }
        (void)hipGetLastError();
        grid = cus * 1;
        fprintf(stderr, "kernel_launch: grid %d (cus %d, per_cu %d)\n", grid, cus, per_cu);
    }
    if (grid < 0) return;
    hipMemsetAsync((char*)d_ws + WS_CTL, 0, CTL_BYTES, stream);
    Args a{};
    for (int i = 0; i < 24; ++i) a.in[i] = (const float*)d_in[i];
    a.out = (float*)d_out; a.ws = (unsigned char*)d_ws;
    void* args[] = {&a};
    hipError_t e = hipLaunchCooperativeKernel((const void*)fwd_megakernel, dim3(grid), dim3(NTHR), args, LDS_BYTES, stream);
    if (e != hipSuccess) fprintf(stderr, "cooperative launch failed: %s (grid %d)\n", hipGetErrorString(e), grid);
}
```
